# Optimizing an MI355X kernel written in HIP

```python
import jax, jax.numpy as jnp
from jax import lax
import numpy as np

D_MODEL = 1024
BATCH = 8
SEQ = 4096
DEPTH = 1

GRID_W = 64
CTX_LEN = 256
HGRN_HEADS = 8
HGRN_EXPAND = 128
HGRN_DIM = HGRN_HEADS * HGRN_EXPAND
HGRN_HEAD_V = HGRN_DIM // HGRN_HEADS
CONV_DIM = D_MODEL
CONV_WIDTH = 31
FFN_DIM = 2816
N_MOD = 9
IN_COLS = 5 * HGRN_DIM + 2 * CONV_DIM
EPS = 1e-6

kernel_name = "hybrid_hgrn2_conformer_dit_block"


def rms_norm(x, gain):
    x32 = x.astype(jnp.float32)
    y = x32 * lax.rsqrt(jnp.mean(x32 * x32, axis=-1, keepdims=True) + EPS)
    return y.astype(x.dtype) * gain


def layer_norm(x, gain, bias):
    x32 = x.astype(jnp.float32)
    mu = jnp.mean(x32, axis=-1, keepdims=True)
    var = jnp.mean(jnp.square(x32 - mu), axis=-1, keepdims=True)
    y = (x32 - mu) * lax.rsqrt(var + EPS)
    return y.astype(x.dtype) * gain + bias


def modulate(x, shift, scale):
    return x * (1.0 + scale) + shift


def swiglu(u, w_up, w_down):
    a, b = jnp.split(u @ w_up, 2, axis=-1)
    return (jax.nn.silu(a) * b) @ w_down


def ffn_sublayer(h, gain, w_up, w_down, shift, scale, gate):
    return h + 0.5 * gate * swiglu(modulate(rms_norm(h, gain), shift, scale), w_up, w_down)


def to_heads(t):
    b, n, _ = t.shape
    return t.reshape(b, n, HGRN_HEADS, -1).transpose(0, 2, 1, 3)


def chunk_scan(q, f, v, s0):
    b, nh, n, dk = q.shape
    dv = v.shape[-1]
    rows = n // GRID_W
    k = 1.0 - f
    g = jnp.log(f)

    def chunks(t):
        return jnp.moveaxis(t.reshape(b, nh, rows, GRID_W, t.shape[-1]), 2, 0)

    causal = jnp.tril(jnp.ones((GRID_W, GRID_W), dtype=bool))[:, :, None]

    def step(S, inp):
        qc, kc, vc, gc = inp
        G = jnp.cumsum(gc, axis=-2)
        diff = G[..., :, None, :] - G[..., None, :, :]
        decay = jnp.exp(jnp.where(causal, diff, -jnp.inf))
        A = jnp.einsum('bhtd,bhsd,bhtsd->bhts', qc, kc, decay)
        o = jnp.einsum('bhts,bhse->bhte', A, vc) + jnp.einsum('bhtd,bhde->bhte', qc * jnp.exp(G), S)
        G_end = G[..., -1, :]
        S = jnp.exp(G_end)[..., :, None] * S + jnp.einsum(
            'bhsd,bhse->bhde', kc * jnp.exp(G_end[..., None, :] - G), vc)
        return S, o

    S_fin, o = lax.scan(step, s0, (chunks(q), chunks(k), chunks(v), chunks(g)))
    o = jnp.moveaxis(o, 0, 2).reshape(b, nh, n, dv)
    return o, S_fin


def hgrn2_bidir(q, zf, zb, v, lb_f, lb_b, sf0, sb0):
    qh = to_heads(jax.nn.silu(q)).astype(jnp.float32)
    vh = to_heads(v).astype(jnp.float32)
    lbf = lb_f.reshape(HGRN_HEADS, 1, HGRN_EXPAND)
    lbb = lb_b.reshape(HGRN_HEADS, 1, HGRN_EXPAND)
    ff = lbf + (1.0 - lbf) * jax.nn.sigmoid(to_heads(zf).astype(jnp.float32))
    fb = lbb + (1.0 - lbb) * jax.nn.sigmoid(to_heads(zb).astype(jnp.float32))
    o_f, sf = chunk_scan(qh, ff, vh, sf0)
    flip = lambda t: jnp.flip(t, axis=2)
    o_b, sb = chunk_scan(flip(qh), flip(fb), flip(vh), sb0)
    return o_f + flip(o_b), sf, sb


def mixer_scan(u, w_in, lb_f, lb_b, sf0, sb0):
    proj = u @ w_in
    q, zf, zb, v, gout, glu = jnp.split(
        proj, [HGRN_DIM, 2 * HGRN_DIM, 3 * HGRN_DIM, 4 * HGRN_DIM, 5 * HGRN_DIM], axis=-1)
    o, sf, sb = hgrn2_bidir(q, zf, zb, v, lb_f, lb_b, sf0, sb0)
    return o, gout, glu, sf, sb


def depthwise_conv(x, w, bias):
    pad = CONV_WIDTH // 2
    y = lax.conv_general_dilated(
        x, w[:, None, :].astype(x.dtype), window_strides=(1,), padding=[(pad, pad)],
        dimension_numbers=('NWC', 'WIO', 'NWC'), feature_group_count=x.shape[-1])
    return y + bias


def mixer_merge(u, o, gout, glu, hgrn_norm, w_proj_a, w_dw, b_dw, ln_g, ln_b, w_proj_b, w_gate, b_gate, w_o):
    b, n, _ = u.shape
    oa = rms_norm(o, hgrn_norm).transpose(0, 2, 1, 3).reshape(b, n, HGRN_DIM).astype(u.dtype)
    y_a = (oa * jax.nn.silu(gout)) @ w_proj_a
    ga, gb = jnp.split(glu, 2, axis=-1)
    hb = depthwise_conv(ga * jax.nn.sigmoid(gb), w_dw, b_dw)
    y_b = jax.nn.silu(layer_norm(hb, ln_g, ln_b)) @ w_proj_b
    gate_a, gate_b = jnp.split(jax.nn.sigmoid(u @ w_gate + b_gate), 2, axis=-1)
    return (gate_a * y_a + gate_b * y_b) @ w_o


def setup_inputs(seed: int = 0) -> dict:
    key = jax.random.key(seed)
    ks = jax.random.split(key, 32)
    nrm = lambda k, shape, s: jax.random.normal(k, shape, jnp.float32) * s
    D, L = D_MODEL, DEPTH
    lb_base = jnp.linspace(-1.0, 1.0, L + 1, dtype=jnp.float32)[:, None, None]
    return {
        "x": nrm(ks[0], (BATCH, SEQ, D), 1.0),
        "c": nrm(ks[1], (BATCH, D), 1.0),
        "ctx": nrm(ks[2], (BATCH, CTX_LEN, D), 1.0),
        "c_ctx": nrm(ks[3], (D,), 1.0),
        "w_ada": nrm(ks[4], (L, D, N_MOD * D), D ** -0.5),
        "b_ada": nrm(ks[5], (L, N_MOD * D), 0.02),
        "norm_ffn1": 1.0 + nrm(ks[6], (L, D), 0.05),
        "w_ffn1_up": nrm(ks[7], (L, D, 2 * FFN_DIM), D ** -0.5),
        "w_ffn1_down": nrm(ks[8], (L, FFN_DIM, D), FFN_DIM ** -0.5),
        "norm_mix": 1.0 + nrm(ks[9], (L, D), 0.05),
        "w_in": nrm(ks[10], (L, D, IN_COLS), D ** -0.5),
        "lb_logits": lb_base + nrm(ks[11], (L + 1, 2, HGRN_DIM), 0.1),
        "hgrn_norm": 1.0 + nrm(ks[12], (L, HGRN_HEAD_V), 0.05),
        "w_dw": nrm(ks[13], (L, CONV_WIDTH, CONV_DIM), CONV_WIDTH ** -0.5),
        "b_dw": nrm(ks[14], (L, CONV_DIM), 0.02),
        "conv_ln_g": 1.0 + nrm(ks[15], (L, CONV_DIM), 0.05),
        "conv_ln_b": nrm(ks[16], (L, CONV_DIM), 0.02),
        "w_proj_a": nrm(ks[17], (L, HGRN_DIM, D), HGRN_DIM ** -0.5),
        "w_proj_b": nrm(ks[18], (L, CONV_DIM, D), CONV_DIM ** -0.5),
        "w_gate": nrm(ks[19], (L, D, 2 * D), D ** -0.5),
        "b_gate": nrm(ks[20], (L, 2 * D), 0.02),
        "w_o": nrm(ks[21], (L, D, D), D ** -0.5),
        "norm_ffn2": 1.0 + nrm(ks[22], (L, D), 0.05),
        "w_ffn2_up": nrm(ks[23], (L, D, 2 * FFN_DIM), D ** -0.5),
        "w_ffn2_down": nrm(ks[24], (L, FFN_DIM, D), FFN_DIM ** -0.5),
        "final_norm": 1.0 + nrm(ks[25], (D,), 0.05),
    }


def reference(x, c, ctx, c_ctx, w_ada, b_ada, norm_ffn1, w_ffn1_up, w_ffn1_down, norm_mix, w_in,
              lb_logits, hgrn_norm, w_dw, b_dw, conv_ln_g, conv_ln_b, w_proj_a, w_proj_b, w_gate,
              b_gate, w_o, norm_ffn2, w_ffn2_up, w_ffn2_down, final_norm):
    b = x.shape[0]
    lb_all = jnp.cumsum(jax.nn.softmax(lb_logits.astype(jnp.float32), axis=0), axis=0)
    h, hc = x, ctx
    for l in range(DEPTH):
        last = l == DEPTH - 1
        m = jnp.split((jax.nn.silu(c) @ w_ada[l] + b_ada[l])[:, None, :], N_MOD, axis=-1)
        mc = jnp.split((jax.nn.silu(c_ctx) @ w_ada[l] + b_ada[l])[None, None, :], N_MOD, axis=-1)
        lb_f, lb_b = lb_all[l, 0], lb_all[l, 1]
        mix_w = (hgrn_norm[l], w_proj_a[l], w_dw[l], b_dw[l], conv_ln_g[l], conv_ln_b[l],
                 w_proj_b[l], w_gate[l], b_gate[l], w_o[l])
        h = ffn_sublayer(h, norm_ffn1[l], w_ffn1_up[l], w_ffn1_down[l], m[0], m[1], m[2])
        hc = ffn_sublayer(hc, norm_ffn1[l], w_ffn1_up[l], w_ffn1_down[l], mc[0], mc[1], mc[2])
        u = modulate(rms_norm(h, norm_mix[l]), m[3], m[4])
        uc = modulate(rms_norm(hc, norm_mix[l]), mc[3], mc[4])
        zeros = jnp.zeros((b, HGRN_HEADS, HGRN_EXPAND, HGRN_HEAD_V), jnp.float32)
        oc, goc, gluc, sf, sb = mixer_scan(uc, w_in[l], lb_f, lb_b, zeros, zeros)
        o, go, glu, _, _ = mixer_scan(u, w_in[l], lb_f, lb_b, sf, sb)
        h = h + m[5] * mixer_merge(u, o, go, glu, *mix_w)
        h = ffn_sublayer(h, norm_ffn2[l], w_ffn2_up[l], w_ffn2_down[l], m[6], m[7], m[8])
        if not last:
            hc = hc + mc[5] * mixer_merge(uc, oc, goc, gluc, *mix_w)
            hc = ffn_sublayer(hc, norm_ffn2[l], w_ffn2_up[l], w_ffn2_down[l], mc[6], mc[7], mc[8])
    return rms_norm(h, final_norm)
```

```cpp
#include <hip/hip_runtime.h>
#include <hip/hip_cooperative_groups.h>
#include <cstdio>
namespace cg = cooperative_groups;
#define DBG_NOSCAN 0
namespace pg8 {
#define PG8_LAS __attribute__((address_space(3)))
typedef unsigned short bf16_t;
typedef short bf16x8 __attribute__((ext_vector_type(8)));
typedef float f32x4 __attribute__((ext_vector_type(4)));
typedef unsigned u32x4 __attribute__((ext_vector_type(4)));
constexpr int BM = 256, BK = 64, HALF = 128, HTB = HALF * BK * 2  , STAGE_BYTES = 8 * HTB, NXCD = 8, WGM = 8;

__host__ __device__ __forceinline__ int lds_byte(int r, int c) { const int st = (r >> 4) * 2 + (c >> 5), rr = r & 15, cc = c & 31, ob = rr * 64 + cc * 2; return st * 1024 + (ob ^ (((ob >> 9) & 1) << 5)); }
__host__ __device__ __forceinline__ void stage_rc(int b, int& R, int& C) { const int st = b / 1024, sb = b % 1024, swz = sb ^ (((sb >> 9) & 1) << 5); R = (st >> 1) * 16 + swz / 64; C = (st & 1) * 32 + (swz % 64) / 2; }
__host__ __device__ __forceinline__ int perm32(int rho) { const int n = rho >> 4, i = rho & 15; return 8 * (i >> 2) + 4 * n + (i & 3); }

struct Unit { int pm, pn; };
struct Gemm { const bf16_t* A; const bf16_t* Bt; int M, N, K; };

struct StaticOrder {
    int nM, nN, nwg, G, c;
    __host__ __device__ void init(int M, int N, int G_, int c_) { nM = M / BM; nN = N / BM; nwg = nM * nN; G = G_; c = c_; }
    __host__ __device__ bool next(int i, Unit& u) const {
        const long L = (long)i * G + c; if (L >= nwg) return false;
        int wgid = (int)L; { const int q = nwg / NXCD, r = nwg % NXCD, xcd = wgid % NXCD, off = wgid / NXCD; wgid = (xcd < r ? xcd * (q + 1) : r * (q + 1) + (xcd - r) * q) + off; }
        const int nig = WGM * nN, gid = wgid / nig, fm = gid * WGM, gsz = (nM - fm) < WGM ? (nM - fm) : WGM;
        u.pm = fm + ((wgid % nig) % gsz); u.pn = (wgid % nig) / gsz; return true;
    }
    __device__ __forceinline__ void a_ready(const Unit&) const {}
    __device__ __forceinline__ void done(const Unit&) const {}
};
__device__ __forceinline__ unsigned cvt_pk_bf16(float lo, float hi) { unsigned r; asm volatile("v_cvt_pk_bf16_f32 %0, %1, %2" : "=v"(r) : "v"(lo), "v"(hi)); return r; }
template <class Epi, class Sched, bool STAMP = false>
__device__ __forceinline__ void gemm_phase(PG8_LAS unsigned char* lds, const Gemm g, const Sched& S, const Epi& E, unsigned long long* stamps) {
    const int tid = threadIdx.x, wid = __builtin_amdgcn_readfirstlane(tid >> 6), lane = tid & 63, wr = wid >> 2, wc = wid & 3, fr = lane & 15, fq = lane >> 4;
    const int K = g.K, nt = K / BK;
    int ts_lo = 0, ts_hi = 0, nts = 0; const unsigned long long rt_entry = STAMP ? (unsigned long long)wall_clock64() : 0ull;
#define PG8_STAMP() do { if (STAMP && wid == 0 && nts < 64) { const unsigned long long _c = (unsigned long long)clock64(); \
        ts_lo = (lane == nts) ? (int)(unsigned)_c : ts_lo; ts_hi = (lane == nts) ? (int)(unsigned)(_c >> 32) : ts_hi; ++nts; } } while (0)
    PG8_STAMP();
    unsigned voffA[2], voffB[2];
#pragma unroll
    for (int i = 0; i < 2; ++i) { int R, C; stage_rc(tid * 16 + i * 8192, R, C); const int Rb = Epi::PERM ? ((R & ~31) + perm32(R & 31)) : R;
        voffA[i] = (unsigned)(R * K + C) * 2u; voffB[i] = (unsigned)(Rb * K + C) * 2u; }
    const size_t kstep = (size_t)(BK * 2);
    const size_t hstep = (size_t)HALF * K * 2;
    const size_t tstep = 2 * hstep;
    const unsigned ldsw = (unsigned)wid * 1024u;
    const int aoff = lds_byte(wr * 64 + fr, fq * 8), boff = lds_byte(wc * 32 + fr, fq * 8);
#define PG8_SA(b, h) (((b) * 2 + (h)) * HTB)
#define PG8_SB(b, h) ((4 + (b) * 2 + (h)) * HTB)
#define PG8_STAGE(bufoff, gbase, voff) do { _Pragma("unroll") for (int _i = 0; _i < 2; ++_i) \
        __builtin_amdgcn_global_load_lds((const unsigned*)((const char*)(gbase) + (voff)[_i]), (PG8_LAS unsigned*)(lds + (bufoff) + ldsw + _i * 8192), 16, 0, 0); } while (0)
#define PG8_LDA(dst, b, h) do { _Pragma("unroll") for (int m = 0; m < 4; ++m) _Pragma("unroll") for (int k = 0; k < 2; ++k) dst[m][k] = *(const PG8_LAS bf16x8*)(lds + PG8_SA(b, h) + aoff + m * 2048 + k * 1024); } while (0)
#define PG8_LDB(dst, b, h) do { _Pragma("unroll") for (int n = 0; n < 2; ++n) _Pragma("unroll") for (int k = 0; k < 2; ++k) dst[n][k] = *(const PG8_LAS bf16x8*)(lds + PG8_SB(b, h) + boff + n * 2048 + k * 1024); } while (0)
#define PG8_MMA(ai, bj, At, Bt) do { __builtin_amdgcn_s_setprio(1); _Pragma("unroll") for (int m = 0; m < 4; ++m) _Pragma("unroll") for (int n = 0; n < 2; ++n) _Pragma("unroll") for (int k = 0; k < 2; ++k) \
        acc[ai][bj][m][n] = __builtin_amdgcn_mfma_f32_16x16x32_bf16(Bt[n][k], At[m][k], acc[ai][bj][m][n], 0, 0, 0); __builtin_amdgcn_s_setprio(0); } while (0)
#define PG8_WAIT_V(n) asm volatile("s_waitcnt vmcnt(" #n ")" ::: "memory")
#define PG8_WAIT_L(n) asm volatile("s_waitcnt lgkmcnt(" #n ")" ::: "memory")
#define PG8_BAR __builtin_amdgcn_s_barrier()
#define PG8_SCHED __builtin_amdgcn_sched_barrier(0)
    Unit cur, nxt; int ui = 0;
    if (!S.next(0, cur)) return;
    f32x4 acc[2][2][4][2];
#pragma unroll
    for (int a = 0; a < 2; ++a)
#pragma unroll
        for (int b = 0; b < 2; ++b)
#pragma unroll
            for (int m = 0; m < 4; ++m)
#pragma unroll
                for (int n = 0; n < 2; ++n) acc[a][b][m][n] = (f32x4){0.f, 0.f, 0.f, 0.f};
    bf16x8 At[4][2], B0[2][2], B1[2][2];
    const char* cA = (const char*)g.A + (size_t)cur.pm * tstep; const char* cB = (const char*)g.Bt + (size_t)cur.pn * tstep;
    S.a_ready(cur);
    PG8_STAGE(PG8_SB(0, 0), cB, voffB); PG8_STAGE(PG8_SA(0, 0), cA, voffA); PG8_STAGE(PG8_SB(0, 1), cB + hstep, voffB); PG8_STAGE(PG8_SA(0, 1), cA + hstep, voffA);
    if (wr == 1) PG8_BAR;
    PG8_WAIT_V(4); PG8_BAR;
    PG8_STAGE(PG8_SB(1, 0), cB + kstep, voffB); PG8_STAGE(PG8_SA(1, 0), cA + kstep, voffA); PG8_STAGE(PG8_SB(1, 1), cB + hstep + kstep, voffB);
    PG8_WAIT_V(6); PG8_BAR;
    PG8_STAMP();
    for (;;) {
        const bool has_next = S.next(ui + 1, nxt);
        const char* nA = has_next ? (const char*)g.A + (size_t)nxt.pm * tstep : cA; const char* nB = has_next ? (const char*)g.Bt + (size_t)nxt.pn * tstep : cB;
        for (int t = 0; t < nt; t += 2) {
            const bool last = (t == nt - 2);
            const char* a1 = cA + (size_t)(t + 1) * kstep;
            const char* a2 = last ? nA : cA + (size_t)(t + 2) * kstep; const char* b2 = last ? nB : cB + (size_t)(t + 2) * kstep;
            const char* a3 = a2 + kstep; const char* b3 = b2 + kstep;
            if (last && has_next) S.a_ready(nxt);
            PG8_LDB(B0, 0, 0); PG8_SCHED; PG8_LDA(At, 0, 0); PG8_STAGE(PG8_SA(1, 1), a1 + hstep, voffA);
            PG8_WAIT_L(8); PG8_BAR; PG8_WAIT_L(0); PG8_MMA(0, 0, At, B0); PG8_BAR; PG8_SCHED;
            PG8_LDB(B1, 0, 1); PG8_STAGE(PG8_SB(0, 0), b2, voffB);
            PG8_BAR; PG8_WAIT_L(0); PG8_MMA(0, 1, At, B1); PG8_BAR;
            PG8_LDA(At, 0, 1); PG8_STAGE(PG8_SA(0, 0), a2, voffA);
            PG8_BAR; PG8_WAIT_L(0); PG8_MMA(1, 0, At, B0); PG8_BAR; PG8_SCHED;
            PG8_STAGE(PG8_SB(0, 1), b2 + hstep, voffB);
            PG8_WAIT_V(6); PG8_BAR; PG8_MMA(1, 1, At, B1); PG8_BAR;
            PG8_LDB(B0, 1, 0); PG8_SCHED; PG8_LDA(At, 1, 0); PG8_STAGE(PG8_SA(0, 1), a2 + hstep, voffA);
            PG8_WAIT_L(8); PG8_BAR; PG8_WAIT_L(0); PG8_MMA(0, 0, At, B0); PG8_BAR; PG8_SCHED;
            PG8_LDB(B1, 1, 1); PG8_STAGE(PG8_SB(1, 0), b3, voffB);
            PG8_BAR; PG8_WAIT_L(0); PG8_MMA(0, 1, At, B1); PG8_BAR;
            PG8_LDA(At, 1, 1); PG8_STAGE(PG8_SA(1, 0), a3, voffA);
            PG8_BAR; PG8_WAIT_L(0); PG8_MMA(1, 0, At, B0); PG8_BAR; PG8_SCHED;
            PG8_STAGE(PG8_SB(1, 1), b3 + hstep, voffB);
            PG8_WAIT_V(6); PG8_BAR; PG8_MMA(1, 1, At, B1); PG8_BAR;
        }
        PG8_STAMP();
        if constexpr (!Epi::AFTER_DRAIN) { E(acc, cur, wr, wc, fr, fq); S.done(cur); }
        PG8_STAMP();
        if (!has_next) break;
#pragma unroll
        for (int a = 0; a < 2; ++a)
#pragma unroll
            for (int b = 0; b < 2; ++b)
#pragma unroll
                for (int m = 0; m < 4; ++m)
#pragma unroll
                    for (int n = 0; n < 2; ++n) acc[a][b][m][n] = (f32x4){0.f, 0.f, 0.f, 0.f};
        cur = nxt; cA = nA; cB = nB; ++ui;
    }
    PG8_WAIT_V(0);
    if (wr == 0) PG8_BAR;
    PG8_BAR;
    if constexpr (Epi::AFTER_DRAIN) { E.fused(acc, cur, wr, wc, fr, fq, lds, wid, lane); S.done(cur); }
    PG8_STAMP();
    if (STAMP && wid == 0) { stamps[lane] = lane < nts ? (((unsigned long long)(unsigned)ts_hi << 32) | (unsigned)ts_lo) : 0ull;
        if (lane == 62) stamps[62] = rt_entry; if (lane == 63) stamps[63] = (unsigned long long)wall_clock64(); }
#undef PG8_STAMP
#undef PG8_SA
#undef PG8_SB
#undef PG8_STAGE
#undef PG8_LDA
#undef PG8_LDB
#undef PG8_MMA
#undef PG8_WAIT_V
#undef PG8_WAIT_L
#undef PG8_BAR
#undef PG8_SCHED
}
}

#define LAS __attribute__((address_space(3)))
typedef unsigned short bf16;
typedef _Float16 f16;
typedef pg8::f32x4 f32x4;
typedef pg8::u32x4 u32x4;
typedef pg8::bf16x8 bf16x8;
typedef unsigned u32x2 __attribute__((ext_vector_type(2)));
typedef _Float16 f16x8 __attribute__((ext_vector_type(8)));
typedef _Float16 f16x4 __attribute__((ext_vector_type(4)));

constexpr int D = 1024, NB = 8, SEQ = 4096, CTXL = 256, ML = NB * SEQ, MC = NB * CTXL, MT = ML + MC, FF = 2816, NMODC = 9 * D;
constexpr float EPS = 1e-6f;
constexpr size_t MiB = 1ull << 20;
constexpr size_t WS_WUP = 0, WS_WDN = 11 * MiB, WS_WIN = 17 * MiB, WS_WPA = 35 * MiB, WS_WPB = 37 * MiB, WS_WO = 39 * MiB, WS_MOD = 41 * MiB,
                 WS_U = 42 * MiB, WS_R = 110 * MiB;
constexpr size_t R_H = WS_R, R_HC1 = WS_R + 187 * MiB;
constexpr size_t R_Q = WS_R, R_GF = WS_R + 64 * MiB, R_GB = WS_R + 132 * MiB, R_V = WS_R + 200 * MiB, R_OF = WS_R + 268 * MiB, R_OB = WS_R + 332 * MiB;
constexpr size_t R_SG = WS_R, R_GLU = WS_R + 64 * MiB, R_GATES = WS_R + 128 * MiB;
constexpr size_t WS_NEED = WS_R + 396 * MiB;
constexpr int LDS_BYTES = 131072 + 4096;

struct Params { const float* in[26]; float* out; unsigned char* ws; };
enum { I_X = 0, I_C, I_CTX, I_CCTX, I_WADA, I_BADA, I_NF1, I_W1U, I_W1D, I_NMIX, I_WIN, I_LBL, I_HGN, I_WDW, I_BDW, I_LNG, I_LNB, I_WPA, I_WPB, I_WG, I_BG, I_WO,
       I_NF2, I_W2U, I_W2D, I_FN };

__device__ __forceinline__ float bf2f(unsigned short b) { return __uint_as_float(((unsigned)b) << 16); }
__device__ __forceinline__ float bflo(unsigned w) { return __uint_as_float(w << 16); }
__device__ __forceinline__ float bfhi(unsigned w) { return __uint_as_float(w & 0xffff0000u); }
typedef __bf16 bf2_t __attribute__((ext_vector_type(2)));
__device__ __forceinline__ unsigned pk2(float lo, float hi) { bf2_t v; v.x = (__bf16)lo; v.y = (__bf16)hi; return __builtin_bit_cast(unsigned, v); }
__device__ __forceinline__ float sigmoidf_(float x) { return 1.0f / (1.0f + __expf(-x)); }
__device__ __forceinline__ float siluf_(float x) { return x / (1.0f + __expf(-x)); }

struct EpiSwiglu {
    static constexpr bool PERM = true, AFTER_DRAIN = false;
    bf16* H; int ldh;
    __device__ __forceinline__ void operator()(const f32x4 (&acc)[2][2][4][2], const pg8::Unit& u, int wr, int wc, int fr, int fq) const {
        const int row0 = u.pm * 256 + wr * 64 + fr, col0 = u.pn * 128 + wc * 32 + 8 * fq;
#pragma unroll
        for (int ai = 0; ai < 2; ++ai)
#pragma unroll
            for (int m = 0; m < 4; ++m) {
                bf16* rowp = H + (size_t)(row0 + ai * 128 + m * 16) * ldh + col0;
                float o[8];
#pragma unroll
                for (int n = 0; n < 2; ++n)
#pragma unroll
                    for (int j = 0; j < 4; ++j) o[n * 4 + j] = siluf_(acc[ai][0][m][n][j]) * acc[ai][1][m][n][j];
                u32x4 w; w.x = pk2(o[0], o[1]); w.y = pk2(o[2], o[3]); w.z = pk2(o[4], o[5]); w.w = pk2(o[6], o[7]);
                *(u32x4*)rowp = w;
            }
    }
};

struct EpiRes {
    static constexpr bool PERM = false, AFTER_DRAIN = false;
    const float* baseL; float* outL; const float* baseC; float* outC; const float* mod; int gidx; float coef;
    __device__ __forceinline__ void operator()(const f32x4 (&acc)[2][2][4][2], const pg8::Unit& u, int wr, int wc, int fr, int fq) const {
        const bool lat = u.pm < 128;
        const int prow = (lat ? u.pm : u.pm - 128) * 256 + wr * 64 + fr;
        const float* base = lat ? baseL : baseC; float* out = lat ? outL : outC;
        const float* gate = mod + (size_t)(lat ? (u.pm >> 4) : 8) * NMODC + gidx * D;
        const int col0 = u.pn * 256 + wc * 32 + 4 * fq;
        f32x4 gv[2][2];
#pragma unroll
        for (int bj = 0; bj < 2; ++bj)
#pragma unroll
            for (int n = 0; n < 2; ++n) gv[bj][n] = *(const f32x4*)(gate + col0 + bj * 128 + n * 16) * coef;
#pragma unroll
        for (int ai = 0; ai < 2; ++ai)
#pragma unroll
            for (int m = 0; m < 4; ++m) {
                const size_t off = (size_t)(prow + ai * 128 + m * 16) * D + col0;
#pragma unroll
                for (int bj = 0; bj < 2; ++bj)
#pragma unroll
                    for (int n = 0; n < 2; ++n) {
                        const f32x4 bs = *(const f32x4*)(base + off + bj * 128 + n * 16);
                        *(f32x4*)(out + off + bj * 128 + n * 16) = bs + gv[bj][n] * acc[ai][bj][m][n];
                    }
            }
    }
};

struct EpiMix1 {
    static constexpr bool PERM = true, AFTER_DRAIN = false;
    bf16* Q; f16* GF; f16* GB; bf16* V; const float* lbf; const float* lbb;
    __device__ __forceinline__ void operator()(const f32x4 (&acc)[2][2][4][2], const pg8::Unit& u, int wr, int wc, int fr, int fq) const {
        const int seg = u.pn >> 2;
        const int row0 = u.pm * 256 + wr * 64 + fr, col0 = (u.pn & 3) * 256 + wc * 32 + 8 * fq;
        if (seg == 0) {
            if (u.pm >= 128) return;
#pragma unroll
            for (int ai = 0; ai < 2; ++ai)
#pragma unroll
                for (int m = 0; m < 4; ++m)
#pragma unroll
                    for (int bj = 0; bj < 2; ++bj) {
                        const f32x4 a = acc[ai][bj][m][0], b = acc[ai][bj][m][1];
                        u32x4 w; w.x = pk2(siluf_(a[0]), siluf_(a[1])); w.y = pk2(siluf_(a[2]), siluf_(a[3])); w.z = pk2(siluf_(b[0]), siluf_(b[1])); w.w = pk2(siluf_(b[2]), siluf_(b[3]));
                        *(u32x4*)(Q + (size_t)(row0 + ai * 128 + m * 16) * D + col0 + bj * 128) = w;
                    }
        } else if (seg == 3) {
#pragma unroll
            for (int ai = 0; ai < 2; ++ai)
#pragma unroll
                for (int m = 0; m < 4; ++m)
#pragma unroll
                    for (int bj = 0; bj < 2; ++bj) {
                        const f32x4 a = acc[ai][bj][m][0], b = acc[ai][bj][m][1];
                        u32x4 w; w.x = pk2(a[0], a[1]); w.y = pk2(a[2], a[3]); w.z = pk2(b[0], b[1]); w.w = pk2(b[2], b[3]);
                        *(u32x4*)(V + (size_t)(row0 + ai * 128 + m * 16) * D + col0 + bj * 128) = w;
                    }
        } else {
            const float* lb = (seg == 1) ? lbf : lbb; f16* G = (seg == 1) ? GF : GB;
#pragma unroll
            for (int bj = 0; bj < 2; ++bj) {
                const f32x4 l0 = *(const f32x4*)(lb + col0 + bj * 128), l1 = *(const f32x4*)(lb + col0 + bj * 128 + 4);
#pragma unroll
                for (int ai = 0; ai < 2; ++ai)
#pragma unroll
                    for (int m = 0; m < 4; ++m) {
                        const f32x4 a = acc[ai][bj][m][0], b = acc[ai][bj][m][1];
                        f16x8 w;
#pragma unroll
                        for (int j = 0; j < 4; ++j) {
                            w[j] = (f16)__logf(l0[j] + (1.0f - l0[j]) * sigmoidf_(a[j]));
                            w[4 + j] = (f16)__logf(l1[j] + (1.0f - l1[j]) * sigmoidf_(b[j]));
                        }
                        *(f16x8*)(G + (size_t)(row0 + ai * 128 + m * 16) * D + col0 + bj * 128) = w;
                    }
            }
        }
    }
};

struct EpiMix2 {
    static constexpr bool PERM = true, AFTER_DRAIN = false;
    bf16* SG; bf16* GLU; bf16* GATES; const float* bgate;
    __device__ __forceinline__ void operator()(const f32x4 (&acc)[2][2][4][2], const pg8::Unit& u, int wr, int wc, int fr, int fq) const {
        const int row0 = u.pm * 256 + wr * 64 + fr, cw = wc * 32 + 8 * fq;
        if (u.pn < 4) {
#pragma unroll
            for (int ai = 0; ai < 2; ++ai)
#pragma unroll
                for (int m = 0; m < 4; ++m)
#pragma unroll
                    for (int bj = 0; bj < 2; ++bj) {
                        const f32x4 a = acc[ai][bj][m][0], b = acc[ai][bj][m][1];
                        u32x4 w; w.x = pk2(siluf_(a[0]), siluf_(a[1])); w.y = pk2(siluf_(a[2]), siluf_(a[3])); w.z = pk2(siluf_(b[0]), siluf_(b[1])); w.w = pk2(siluf_(b[2]), siluf_(b[3]));
                        *(u32x4*)(SG + (size_t)(row0 + ai * 128 + m * 16) * D + u.pn * 256 + bj * 128 + cw) = w;
                    }
        } else if (u.pn < 12) {
            const int c0 = (u.pn - 4) * 128 + cw;
#pragma unroll
            for (int ai = 0; ai < 2; ++ai)
#pragma unroll
                for (int m = 0; m < 4; ++m) {
                    float o[8];
#pragma unroll
                    for (int n = 0; n < 2; ++n)
#pragma unroll
                        for (int j = 0; j < 4; ++j) o[n * 4 + j] = acc[ai][0][m][n][j] * sigmoidf_(acc[ai][1][m][n][j]);
                    u32x4 w; w.x = pk2(o[0], o[1]); w.y = pk2(o[2], o[3]); w.z = pk2(o[4], o[5]); w.w = pk2(o[6], o[7]);
                    *(u32x4*)(GLU + (size_t)(row0 + ai * 128 + m * 16) * D + c0) = w;
                }
        } else {
            const int c0 = (u.pn - 12) * 256 + cw;
#pragma unroll
            for (int bj = 0; bj < 2; ++bj) {
                const f32x4 b0 = *(const f32x4*)(bgate + c0 + bj * 128), b1 = *(const f32x4*)(bgate + c0 + bj * 128 + 4);
#pragma unroll
                for (int ai = 0; ai < 2; ++ai)
#pragma unroll
                    for (int m = 0; m < 4; ++m) {
                        const f32x4 a = acc[ai][bj][m][0] + b0, b = acc[ai][bj][m][1] + b1;
                        u32x4 w; w.x = pk2(sigmoidf_(a[0]), sigmoidf_(a[1])); w.y = pk2(sigmoidf_(a[2]), sigmoidf_(a[3])); w.z = pk2(sigmoidf_(b[0]), sigmoidf_(b[1])); w.w = pk2(sigmoidf_(b[2]), sigmoidf_(b[3]));
                        *(u32x4*)(GATES + (size_t)(row0 + ai * 128 + m * 16) * 2048 + c0 + bj * 128) = w;
                    }
            }
        }
    }
};

template <int ADD> struct EpiGate {
    static constexpr bool PERM = true, AFTER_DRAIN = false;
    const bf16* GATES; bf16* T; int goff;
    __device__ __forceinline__ void operator()(const f32x4 (&acc)[2][2][4][2], const pg8::Unit& u, int wr, int wc, int fr, int fq) const {
        const int row0 = u.pm * 256 + wr * 64 + fr, col0 = u.pn * 256 + wc * 32 + 8 * fq;
#pragma unroll
        for (int ai = 0; ai < 2; ++ai)
#pragma unroll
            for (int m = 0; m < 4; ++m)
#pragma unroll
                for (int bj = 0; bj < 2; ++bj) {
                    const size_t r = (size_t)(row0 + ai * 128 + m * 16);
                    const u32x4 g = *(const u32x4*)(GATES + r * 2048 + goff + col0 + bj * 128);
                    bf16* tp = T + r * D + col0 + bj * 128;
                    const f32x4 a = acc[ai][bj][m][0], b = acc[ai][bj][m][1];
                    float o[8];
                    o[0] = bflo(g.x) * a[0]; o[1] = bfhi(g.x) * a[1]; o[2] = bflo(g.y) * a[2]; o[3] = bfhi(g.y) * a[3];
                    o[4] = bflo(g.z) * b[0]; o[5] = bfhi(g.z) * b[1]; o[6] = bflo(g.w) * b[2]; o[7] = bfhi(g.w) * b[3];
                    if (ADD) { const u32x4 t = *(const u32x4*)tp;
                        o[0] += bflo(t.x); o[1] += bfhi(t.x); o[2] += bflo(t.y); o[3] += bfhi(t.y); o[4] += bflo(t.z); o[5] += bfhi(t.z); o[6] += bflo(t.w); o[7] += bfhi(t.w); }
                    u32x4 w; w.x = pk2(o[0], o[1]); w.y = pk2(o[2], o[3]); w.z = pk2(o[4], o[5]); w.w = pk2(o[6], o[7]);
                    *(u32x4*)tp = w;
                }
    }
};

__device__ __forceinline__ void conv_tile(LAS unsigned char* lds, const float* src, int srcN, int k0, int n0, bf16* dst, int dstK, int drow0) {
    LAS float* T = (LAS float*)lds;
    const int tid = threadIdx.x;
#pragma unroll
    for (int i = 0; i < 4; ++i) {
        const int kk = (tid >> 5) + 16 * i, n4 = tid & 31;
        const f32x4 v = *(const f32x4*)(src + (size_t)(k0 + kk) * srcN + n0 + 4 * n4);
#pragma unroll
        for (int j = 0; j < 4; ++j) T[kk * 129 + 4 * n4 + j] = v[j];
    }
    __syncthreads();
    {
        const int nn = tid >> 2, kq = tid & 3;
        float f[16];
#pragma unroll
        for (int j = 0; j < 16; ++j) f[j] = T[(16 * kq + j) * 129 + nn];
        u32x4 w0, w1;
        w0.x = pk2(f[0], f[1]); w0.y = pk2(f[2], f[3]); w0.z = pk2(f[4], f[5]); w0.w = pk2(f[6], f[7]);
        w1.x = pk2(f[8], f[9]); w1.y = pk2(f[10], f[11]); w1.z = pk2(f[12], f[13]); w1.w = pk2(f[14], f[15]);
        bf16* dp = dst + (size_t)(drow0 + nn) * dstK + k0 + 16 * kq;
        *(u32x4*)dp = w0; *(u32x4*)(dp + 8) = w1;
    }
    __syncthreads();
}
__device__ __forceinline__ void conv_job_item(LAS unsigned char* lds, int it, const float* src, int K, int N, bf16* dst, int roff, int pair_from, int NH) {
    const int nt = N / 128; const int kt = it / nt, ntile = it % nt; const int n0 = ntile * 128;
    int drow0;
    if (pair_from < 0 || n0 < pair_from) drow0 = roff + n0;
    else { const int n1 = n0 - pair_from; drow0 = roff + pair_from + ((n1 < NH) ? 256 * (n1 / 128) : 256 * ((n1 - NH) / 128) + 128); }
    conv_tile(lds, src, N, kt * 64, n0, dst, K, drow0);
}

template <bool MODU, bool OUT_BF16>
__device__ __forceinline__ void normmod_phase(const float* srcL, const float* srcC, int nrows, const float* gain, const float* mod, int ishift, int iscale, bf16* ub, float* of) {
    const int lane = threadIdx.x & 63, wv = threadIdx.x >> 6;
    f32x4 gn[4];
#pragma unroll
    for (int j = 0; j < 4; ++j) gn[j] = *(const f32x4*)(gain + 256 * j + 4 * lane);
    for (int row = blockIdx.x * 8 + wv; row < nrows; row += gridDim.x * 8) {
        const float* src = (row < ML) ? srcL + (size_t)row * D : srcC + (size_t)(row - ML) * D;
        f32x4 x[4]; float ss = 0.f;
#pragma unroll
        for (int j = 0; j < 4; ++j) { x[j] = *(const f32x4*)(src + 256 * j + 4 * lane); ss += x[j][0] * x[j][0] + x[j][1] * x[j][1] + x[j][2] * x[j][2] + x[j][3] * x[j][3]; }
#pragma unroll
        for (int o = 32; o >= 1; o >>= 1) ss += __shfl_xor(ss, o);
        const float rinv = rsqrtf(ss * (1.0f / D) + EPS);
        const int mrow = (row < ML) ? (row >> 12) : 8;
#pragma unroll
        for (int j = 0; j < 4; ++j) {
            f32x4 y = x[j] * rinv * gn[j];
            if constexpr (MODU) { const f32x4 sh = *(const f32x4*)(mod + (size_t)mrow * NMODC + ishift * D + 256 * j + 4 * lane), sc = *(const f32x4*)(mod + (size_t)mrow * NMODC + iscale * D + 256 * j + 4 * lane);
                y = y * (sc + 1.0f) + sh; }
            if constexpr (OUT_BF16) { u32x2 w; w.x = pk2(y[0], y[1]); w.y = pk2(y[2], y[3]); *(u32x2*)(ub + (size_t)row * D + 256 * j + 4 * lane) = w; }
            else *(f32x4*)(of + (size_t)row * D + 256 * j + 4 * lane) = y;
        }
    }
}

__device__ __forceinline__ void adaln_item(LAS unsigned char* lds, int item, const float* wada, const float* bada, float* MOD) {
    LAS float* SC = (LAS float*)lds;
    LAS float* RED = (LAS float*)(lds + 36864);
    const int tid = threadIdx.x, col = tid & 63, kg = tid >> 6, n0 = item * 64;
    float acc[9];
#pragma unroll
    for (int r = 0; r < 9; ++r) acc[r] = 0.f;
    for (int k = kg * 128; k < kg * 128 + 128; ++k) {
        const float w = wada[(size_t)k * NMODC + n0 + col];
#pragma unroll
        for (int r = 0; r < 9; ++r) acc[r] += SC[r * 1024 + k] * w;
    }
#pragma unroll
    for (int r = 0; r < 9; ++r) RED[(kg * 9 + r) * 64 + col] = acc[r];
    __syncthreads();
    for (int idx = tid; idx < 576; idx += 512) {
        const int r = idx >> 6, c = idx & 63; float s = bada[n0 + c];
#pragma unroll
        for (int g = 0; g < 8; ++g) s += RED[(g * 9 + r) * 64 + c];
        MOD[(size_t)r * NMODC + n0 + c] = s;
    }
    __syncthreads();
}

__device__ __forceinline__ void aop_rows(int row_begin, int row_end, int row_step, bf16* OF, const bf16* OB, const bf16* SG, const float* hgn) {
    const int lane = threadIdx.x & 63;
    float gn[16];
#pragma unroll
    for (int j = 0; j < 4; ++j) { const f32x4 t = *(const f32x4*)(hgn + (lane & 7) * 16 + 4 * j); gn[4 * j] = t[0]; gn[4 * j + 1] = t[1]; gn[4 * j + 2] = t[2]; gn[4 * j + 3] = t[3]; }
    for (int row = row_begin; row < row_end; row += row_step) {
        const size_t off = (size_t)row * D + 16 * lane;
        const u32x4 f0 = *(const u32x4*)(OF + off), f1 = *(const u32x4*)(OF + off + 8);
        const u32x4 b0 = *(const u32x4*)(OB + off), b1 = *(const u32x4*)(OB + off + 8);
        const u32x4 s0 = *(const u32x4*)(SG + off), s1 = *(const u32x4*)(SG + off + 8);
        float o[16], sg[16];
#pragma unroll
        for (int j = 0; j < 4; ++j) {
            o[2 * j] = bflo(f0[j]) + bflo(b0[j]); o[2 * j + 1] = bfhi(f0[j]) + bfhi(b0[j]);
            o[8 + 2 * j] = bflo(f1[j]) + bflo(b1[j]); o[8 + 2 * j + 1] = bfhi(f1[j]) + bfhi(b1[j]);
            sg[2 * j] = bflo(s0[j]); sg[2 * j + 1] = bfhi(s0[j]); sg[8 + 2 * j] = bflo(s1[j]); sg[8 + 2 * j + 1] = bfhi(s1[j]);
        }
        float ss = 0.f;
#pragma unroll
        for (int j = 0; j < 16; ++j) ss += o[j] * o[j];
        ss += __shfl_xor(ss, 1); ss += __shfl_xor(ss, 2); ss += __shfl_xor(ss, 4);
        const float rinv = rsqrtf(ss * (1.0f / 128.0f) + EPS);
        float a[16];
#pragma unroll
        for (int j = 0; j < 16; ++j) a[j] = o[j] * rinv * gn[j] * sg[j];
        u32x4 w0, w1;
        w0.x = pk2(a[0], a[1]); w0.y = pk2(a[2], a[3]); w0.z = pk2(a[4], a[5]); w0.w = pk2(a[6], a[7]);
        w1.x = pk2(a[8], a[9]); w1.y = pk2(a[10], a[11]); w1.z = pk2(a[12], a[13]); w1.w = pk2(a[14], a[15]);
        *(u32x4*)(OF + off) = w0; *(u32x4*)(OF + off + 8) = w1;
    }
}

__device__ __forceinline__ void conv_items(LAS unsigned char* lds, int item_begin, int item_end, int item_step, const bf16* GLU, const float* wdw, const float* bdw, const float* lng, const float* lnb, bf16* BOP) {
    constexpr int TT = 16;
    LAS float* P1 = (LAS float*)lds;
    LAS float* P2 = (LAS float*)(lds + 65536);
    LAS float* ST = (LAS float*)(lds + 131072);
    const int tid = threadIdx.x, c = 2 * tid;
    float w[31][2];
#pragma unroll
    for (int j = 0; j < 31; ++j) { w[j][0] = wdw[j * D + c]; w[j][1] = wdw[j * D + c + 1]; }
    const float bd0 = bdw[c], bd1 = bdw[c + 1], g0 = lng[c], g1 = lng[c + 1], b0 = lnb[c], b1 = lnb[c + 1];
    for (int item = item_begin; item < item_end; item += item_step) {
        const int b = item / (SEQ / TT), t0 = (item % (SEQ / TT)) * TT;
        float y[TT][2];
        unsigned xw[TT + 30];
#pragma unroll
        for (int r = 0; r < TT + 30; ++r) {
            const int pos = t0 - 15 + r;
            xw[r] = 0u;
            if (pos >= 0 && pos < SEQ) xw[r] = *(const unsigned*)(GLU + (size_t)(b * SEQ + pos) * D + c);
        }
#pragma unroll
        for (int t = 0; t < TT; ++t) {
            float a0 = bd0, a1 = bd1;
#pragma unroll
            for (int j = 0; j < 31; ++j) { a0 += bflo(xw[t + j]) * w[j][0]; a1 += bfhi(xw[t + j]) * w[j][1]; }
            y[t][0] = a0; y[t][1] = a1;
        }
#pragma unroll
        for (int t = 0; t < TT; ++t) { P1[t * 512 + tid] = y[t][0] + y[t][1]; P2[t * 512 + tid] = y[t][0] * y[t][0] + y[t][1] * y[t][1]; }
        __syncthreads();
        {
            const int t = tid >> 5, part = tid & 31; float s = 0.f, q = 0.f;
#pragma unroll
            for (int j = 0; j < 4; ++j) { const f32x4 a = *(const LAS f32x4*)(P1 + t * 512 + part * 16 + 4 * j), bq = *(const LAS f32x4*)(P2 + t * 512 + part * 16 + 4 * j);
                s += (a[0] + a[1]) + (a[2] + a[3]); q += (bq[0] + bq[1]) + (bq[2] + bq[3]); }
#pragma unroll
            for (int o = 16; o >= 1; o >>= 1) { s += __shfl_xor(s, o); q += __shfl_xor(q, o); }
            if (part == 0) { const float mean = s * (1.0f / D); const float var = fmaxf(q * (1.0f / D) - mean * mean, 0.f); ST[2 * t] = mean; ST[2 * t + 1] = rsqrtf(var + EPS); }
        }
        __syncthreads();
#pragma unroll
        for (int t = 0; t < TT; ++t) {
            const float mean = ST[2 * t], rstd = ST[2 * t + 1];
            const float v0 = (y[t][0] - mean) * rstd * g0 + b0, v1 = (y[t][1] - mean) * rstd * g1 + b1;
            *(unsigned*)(BOP + (size_t)(b * SEQ + t0 + t) * D + c) = pk2(siluf_(v0), siluf_(v1));
        }
        __syncthreads();
    }
}

__device__ __forceinline__ size_t scan_rowbase(int ci, int t, int dir, int b) {
    const bool ctx = ci < 8; const int lc = ctx ? ci : ci - 8, nch = ctx ? 8 : 128;
    const int p0 = dir ? (nch - 1 - lc) * 32 : lc * 32; const int pos = dir ? p0 + 31 - t : p0 + t;
    return ctx ? (size_t)(ML + b * CTXL + pos) : (size_t)(b * SEQ + pos);
}
constexpr int SC_QS = 0, SC_KS = 17408, SC_KET = 34816, SC_VT = 55296, SC_DEC = 65536, SC_WTOT = 66560, SC_AS = 74752, SC_ST = 77312;
constexpr int QROW = 272, SROW = 80;
__device__ __forceinline__ void scan_item(LAS unsigned char* lds, int item, const bf16* Q, const f16* GF, const f16* GB, const bf16* V, bf16* OF, bf16* OB) {
    const int tid = threadIdx.x, lane = tid & 63, w = __builtin_amdgcn_readfirstlane(tid >> 6), l15 = lane & 15, q4 = lane >> 4;
    const int dvh = item & 1, dir = (item >> 1) & 1, h = (item >> 2) & 7, b = item >> 5;
    const f16* G = dir ? GB : GF; bf16* O = dir ? OB : OF;
    const int tau = tid >> 4, p = tid & 15;
    const int tv = (tid >> 3) & 31, pv = tid & 7;
    for (int i = tid; i < (2560 + 17408) / 4; i += 512) ((LAS unsigned*)(lds + SC_AS))[i] = 0u;
    f32x4 accS[4];
#pragma unroll
    for (int i = 0; i < 4; ++i) accS[i] = (f32x4){0.f, 0.f, 0.f, 0.f};
    __syncthreads();

#define rowbase(ci_, t_) scan_rowbase((ci_), (t_), dir, b)
    u32x4 qreg = (u32x4){0u, 0u, 0u, 0u}, greg, vreg = (u32x4){0u, 0u, 0u, 0u};
    {
        const size_t r = rowbase(0, tau);
        greg = *(const u32x4*)(G + r * D + h * 128 + 8 * p);
        if (tid < 256) vreg = *(const u32x4*)(V + rowbase(0, tv) * D + h * 128 + dvh * 64 + 8 * pv);
    }
    for (int ci = 0; ci < 136; ++ci) {
        const bool lat = ci >= 8; const int buf = ci & 1;
        const u32x4 qc = qreg, gc = greg, vc = vreg;
        if (ci + 1 < 136) {
            const size_t r = rowbase(ci + 1, tau);
            greg = *(const u32x4*)(G + r * D + h * 128 + 8 * p);
            if (ci + 1 >= 8) qreg = *(const u32x4*)(Q + r * D + h * 128 + 8 * p);
            if (tid < 256) vreg = *(const u32x4*)(V + rowbase(ci + 1, tv) * D + h * 128 + dvh * 64 + 8 * pv);
        }
        float g[8], x[8];
        { const f16x8 gh = __builtin_bit_cast(f16x8, gc);
#pragma unroll
          for (int j = 0; j < 8; ++j) { g[j] = (float)gh[j]; x[j] = g[j]; } }
#pragma unroll
        for (int j = 0; j < 8; ++j) { const float t = __shfl_up(x[j], 16); if (q4 >= 1) x[j] += t; }
#pragma unroll
        for (int j = 0; j < 8; ++j) { const float t = __shfl_up(x[j], 32); if (q4 >= 2) x[j] += t; }
        LAS float* WT = (LAS float*)(lds + SC_WTOT + buf * 4096);
        if (q4 == 3) { *(LAS f32x4*)(WT + w * 128 + 8 * p) = (f32x4){x[0], x[1], x[2], x[3]}; *(LAS f32x4*)(WT + w * 128 + 8 * p + 4) = (f32x4){x[4], x[5], x[6], x[7]}; }
        __syncthreads();
        float pre[8], tot[8];
#pragma unroll
        for (int j = 0; j < 8; ++j) { pre[j] = 0.f; tot[j] = 0.f; }
#pragma unroll
        for (int ww = 0; ww < 8; ++ww) {
            const f32x4 a = *(const LAS f32x4*)(WT + ww * 128 + 8 * p), c4 = *(const LAS f32x4*)(WT + ww * 128 + 8 * p + 4);
#pragma unroll
            for (int j = 0; j < 4; ++j) { tot[j] += a[j]; tot[4 + j] += c4[j]; if (ww < w) { pre[j] += a[j]; pre[4 + j] += c4[j]; } }
        }
        {
            float kt[8], ke[8], qg[8];
            const unsigned qw[4] = {qc.x, qc.y, qc.z, qc.w};
#pragma unroll
            for (int j = 0; j < 8; ++j) {
                const float Gc = pre[j] + x[j];
                const float k = 1.0f - __expf(g[j]);
                kt[j] = k * __expf(-Gc);
                ke[j] = k * __expf(tot[j] - Gc);
                const float qv = (j & 1) ? bfhi(qw[j >> 1]) : bflo(qw[j >> 1]);
                qg[j] = qv * __expf(Gc);
            }
            u32x4 wk; wk.x = pk2(kt[0], kt[1]); wk.y = pk2(kt[2], kt[3]); wk.z = pk2(kt[4], kt[5]); wk.w = pk2(kt[6], kt[7]);
            *(LAS u32x4*)(lds + SC_KS + buf * 8704 + tau * QROW + 16 * p) = wk;
            if (lat) { u32x4 wq; wq.x = pk2(qg[0], qg[1]); wq.y = pk2(qg[2], qg[3]); wq.z = pk2(qg[4], qg[5]); wq.w = pk2(qg[6], qg[7]);
                *(LAS u32x4*)(lds + SC_QS + buf * 8704 + tau * QROW + 16 * p) = wq; }
#pragma unroll
            for (int j = 0; j < 8; j += 2) { const unsigned pw = pk2(ke[j], ke[j + 1]);
                *(LAS unsigned short*)(lds + SC_KET + buf * 10240 + (8 * p + j) * SROW + tau * 2) = (unsigned short)(pw & 0xffffu);
                *(LAS unsigned short*)(lds + SC_KET + buf * 10240 + (8 * p + j + 1) * SROW + tau * 2) = (unsigned short)(pw >> 16); }
            if (tau == 0) { LAS float* DC = (LAS float*)(lds + SC_DEC + buf * 512);
#pragma unroll
                for (int j = 0; j < 8; ++j) DC[8 * p + j] = __expf(tot[j]); }
            if (tid < 256) { const unsigned vw[4] = {vc.x, vc.y, vc.z, vc.w};
#pragma unroll
                for (int j = 0; j < 4; ++j) {
                    *(LAS unsigned short*)(lds + SC_VT + buf * 5120 + (8 * pv + 2 * j) * SROW + tv * 2) = (unsigned short)(vw[j] & 0xffffu);
                    *(LAS unsigned short*)(lds + SC_VT + buf * 5120 + (8 * pv + 2 * j + 1) * SROW + tv * 2) = (unsigned short)(vw[j] >> 16); } }
        }
        __syncthreads();
        const LAS unsigned char* QS = lds + SC_QS + buf * 8704; const LAS unsigned char* KS = lds + SC_KS + buf * 8704;
        const LAS unsigned char* KET = lds + SC_KET + buf * 10240; const LAS unsigned char* VT = lds + SC_VT + buf * 5120;
        const int tt = w >> 2, et = w & 3;
        f32x4 acco = (f32x4){0.f, 0.f, 0.f, 0.f};
        if (lat) {
            if (w < 3) {
                const int ti = (w == 0) ? 0 : 1, sj = (w == 2) ? 1 : 0;
                f32x4 a4 = (f32x4){0.f, 0.f, 0.f, 0.f};
#pragma unroll
                for (int kk = 0; kk < 4; ++kk) {
                    const bf16x8 xa = *(const LAS bf16x8*)(KS + (sj * 16 + l15) * QROW + kk * 64 + q4 * 16);
                    const bf16x8 yb = *(const LAS bf16x8*)(QS + (ti * 16 + l15) * QROW + kk * 64 + q4 * 16);
                    a4 = __builtin_amdgcn_mfma_f32_16x16x32_bf16(xa, yb, a4, 0, 0, 0);
                }
                const int t = ti * 16 + l15, s0 = sj * 16 + 4 * q4;
                float m0 = (s0 <= t) ? a4[0] : 0.f, m1 = (s0 + 1 <= t) ? a4[1] : 0.f, m2 = (s0 + 2 <= t) ? a4[2] : 0.f, m3 = (s0 + 3 <= t) ? a4[3] : 0.f;
                u32x2 wa; wa.x = pk2(m0, m1); wa.y = pk2(m2, m3);
                *(LAS u32x2*)(lds + SC_AS + t * SROW + s0 * 2) = wa;
            }
#pragma unroll
            for (int kk = 0; kk < 4; ++kk) {
                const bf16x8 xa = *(const LAS bf16x8*)(lds + SC_ST + (et * 16 + l15) * QROW + kk * 64 + q4 * 16);
                const bf16x8 yb = *(const LAS bf16x8*)(QS + (tt * 16 + l15) * QROW + kk * 64 + q4 * 16);
                acco = __builtin_amdgcn_mfma_f32_16x16x32_bf16(xa, yb, acco, 0, 0, 0);
            }
        }
        {
            const f32x4 dc = *(const LAS f32x4*)(lds + SC_DEC + buf * 512 + (16 * w + 4 * q4) * 4);
            const bf16x8 xa = *(const LAS bf16x8*)(KET + (16 * w + l15) * SROW + q4 * 16);
#pragma unroll
            for (int i = 0; i < 4; ++i) {
                const bf16x8 yb = *(const LAS bf16x8*)(VT + (16 * i + l15) * SROW + q4 * 16);
                accS[i] = __builtin_amdgcn_mfma_f32_16x16x32_bf16(xa, yb, accS[i] * dc, 0, 0, 0);
            }
        }
        __syncthreads();
        if (lat) {
            const bf16x8 xa = *(const LAS bf16x8*)(VT + (et * 16 + l15) * SROW + q4 * 16);
            const bf16x8 yb = *(const LAS bf16x8*)(lds + SC_AS + (tt * 16 + l15) * SROW + q4 * 16);
            acco = __builtin_amdgcn_mfma_f32_16x16x32_bf16(xa, yb, acco, 0, 0, 0);
            const size_t r = rowbase(ci, tt * 16 + l15);
            u32x2 wo; wo.x = pk2(acco[0], acco[1]); wo.y = pk2(acco[2], acco[3]);
            *(u32x2*)(O + r * D + h * 128 + dvh * 64 + et * 16 + 4 * q4) = wo;
        }
#pragma unroll
        for (int i = 0; i < 4; ++i) {
            u32x2 ws_; ws_.x = pk2(accS[i][0], accS[i][1]); ws_.y = pk2(accS[i][2], accS[i][3]);
            *(LAS u32x2*)(lds + SC_ST + (16 * i + l15) * QROW + (16 * w + 4 * q4) * 2) = ws_;
        }
    }
    __syncthreads();
#undef rowbase
}

__global__ void __launch_bounds__(512, 2) mega(Params P) {
    extern __shared__ __attribute__((aligned(16))) unsigned char lds_raw[];
    LAS unsigned char* lds = (LAS unsigned char*)lds_raw;
    cg::grid_group grid = cg::this_grid();
#define GRID_SYNC() do { asm volatile("s_waitcnt vmcnt(0) lgkmcnt(0)" ::: "memory"); grid.sync(); } while (0)
    const int tid = threadIdx.x, G = gridDim.x, bid = blockIdx.x;
    unsigned char* ws = P.ws;
    bf16* WUP = (bf16*)(ws + WS_WUP); bf16* WDN = (bf16*)(ws + WS_WDN); bf16* WIN = (bf16*)(ws + WS_WIN);
    bf16* WPA = (bf16*)(ws + WS_WPA); bf16* WPB = (bf16*)(ws + WS_WPB); bf16* WO = (bf16*)(ws + WS_WO);
    float* MOD = (float*)(ws + WS_MOD); float* LBF = MOD + 9 * NMODC; float* LBB = LBF + 1024;
    bf16* U = (bf16*)(ws + WS_U);
    bf16* H = (bf16*)(ws + R_H); float* HC1 = (float*)(ws + R_HC1);
    bf16* Qb = (bf16*)(ws + R_Q); f16* GFb = (f16*)(ws + R_GF); f16* GBb = (f16*)(ws + R_GB); bf16* Vb = (bf16*)(ws + R_V);
    bf16* OFb = (bf16*)(ws + R_OF); bf16* OBb = (bf16*)(ws + R_OB);
    bf16* SGb = (bf16*)(ws + R_SG); bf16* GLUb = (bf16*)(ws + R_GLU); bf16* GATESb = (bf16*)(ws + R_GATES);
    bf16* BOP = U; bf16* Tb = OBb;
    float* OUT = P.out;

    {
        if (bid < 144) {
            LAS float* SC = (LAS float*)lds;
            for (int i = tid; i < 9 * 1024; i += 512) { const float v = (i < 8192) ? P.in[I_C][i] : P.in[I_CCTX][i - 8192]; SC[i] = siluf_(v); }
            __syncthreads();
            adaln_item(lds, bid, P.in[I_WADA], P.in[I_BADA], MOD);
        }
        if (bid == G - 1) {
            const float* l = P.in[I_LBL];
            for (int d = tid; d < 1024; d += 512) { LBF[d] = 1.0f / (1.0f + __expf(l[2048 + d] - l[d])); LBB[d] = 1.0f / (1.0f + __expf(l[3072 + d] - l[1024 + d])); }
        }
        for (int it = (bid + 112) % G; it < 2592; it += G) {
            if (it < 704) conv_job_item(lds, it, P.in[I_W1U], 1024, 5632, WUP, 0, 0, 2816);
            else if (it < 1056) conv_job_item(lds, it - 704, P.in[I_W1D], 2816, 1024, WDN, 0, -1, 0);
            else if (it < 1952) conv_job_item(lds, it - 1056, P.in[I_WIN], 1024, 7168, WIN, 0, 5120, 1024);
            else if (it < 2208) conv_job_item(lds, it - 1952, P.in[I_WG], 1024, 2048, WIN, 7168, -1, 0);
            else if (it < 2336) conv_job_item(lds, it - 2208, P.in[I_WPA], 1024, 1024, WPA, 0, -1, 0);
            else if (it < 2464) conv_job_item(lds, it - 2336, P.in[I_WPB], 1024, 1024, WPB, 0, -1, 0);
            else conv_job_item(lds, it - 2464, P.in[I_WO], 1024, 1024, WO, 0, -1, 0);
        }
    }
    GRID_SYNC();
    normmod_phase<true, true>(P.in[I_X], P.in[I_CTX], MT, P.in[I_NF1], MOD, 0, 1, U, OUT);
    GRID_SYNC();
    { pg8::Gemm g{U, WUP, MT, 2 * FF, D}; pg8::StaticOrder S; S.init(MT, 2 * FF, G, bid); EpiSwiglu E{H, FF}; pg8::gemm_phase<EpiSwiglu, pg8::StaticOrder>(lds, g, S, E, nullptr); }
    GRID_SYNC();
    { pg8::Gemm g{H, WDN, MT, D, FF}; pg8::StaticOrder S; S.init(MT, D, G, bid); EpiRes E{P.in[I_X], OUT, P.in[I_CTX], HC1, MOD, 2, 0.5f}; pg8::gemm_phase<EpiRes, pg8::StaticOrder>(lds, g, S, E, nullptr); }
    GRID_SYNC();
    normmod_phase<true, true>(OUT, HC1, MT, P.in[I_NMIX], MOD, 3, 4, U, OUT);
    GRID_SYNC();
    { pg8::Gemm g{U, WIN, MT, 4096, D}; pg8::StaticOrder S; S.init(MT, 4096, G, bid); EpiMix1 E{Qb, GFb, GBb, Vb, LBF, LBB}; pg8::gemm_phase<EpiMix1, pg8::StaticOrder>(lds, g, S, E, nullptr); }
    GRID_SYNC();
#if DBG_NOSCAN
    { u32x4* z = (u32x4*)OFb; const size_t n = (size_t)2 * ML * D * 2 / 16; for (size_t i = (size_t)bid * 512 + tid; i < n; i += (size_t)G * 512) z[i] = (u32x4){0u, 0u, 0u, 0u}; }
#else
    for (int item = bid; item < 256; item += G) scan_item(lds, item, Qb, GFb, GBb, Vb, OFb, OBb);
#endif
    GRID_SYNC();
    { pg8::Gemm g{U, WIN + (size_t)4096 * D, ML, 5120, D}; pg8::StaticOrder S; S.init(ML, 5120, G, bid); EpiMix2 E{SGb, GLUb, GATESb, P.in[I_BG]}; pg8::gemm_phase<EpiMix2, pg8::StaticOrder>(lds, g, S, E, nullptr); }
    GRID_SYNC();
    {
        conv_items(lds, bid, 2048, G, GLUb, P.in[I_WDW], P.in[I_BDW], P.in[I_LNG], P.in[I_LNB], BOP);
        aop_rows(bid * 8 + (tid >> 6), ML, G * 8, OFb, OBb, SGb, P.in[I_HGN]);
        for (int it = bid; it < 1056; it += G) {
            if (it < 704) conv_job_item(lds, it, P.in[I_W2U], 1024, 5632, WUP, 0, 0, 2816);
            else conv_job_item(lds, it - 704, P.in[I_W2D], 2816, 1024, WDN, 0, -1, 0);
        }
    }
    GRID_SYNC();
    { pg8::Gemm g{OFb, WPA, ML, D, D}; pg8::StaticOrder S; S.init(ML, D, G, bid); EpiGate<0> E{GATESb, Tb, 0}; pg8::gemm_phase<EpiGate<0>, pg8::StaticOrder>(lds, g, S, E, nullptr); }
    GRID_SYNC();
    { pg8::Gemm g{BOP, WPB, ML, D, D}; pg8::StaticOrder S; S.init(ML, D, G, bid); EpiGate<1> E{GATESb, Tb, 1024}; pg8::gemm_phase<EpiGate<1>, pg8::StaticOrder>(lds, g, S, E, nullptr); }
    GRID_SYNC();
    { pg8::Gemm g{Tb, WO, ML, D, D}; pg8::StaticOrder S; S.init(ML, D, G, bid); EpiRes E{OUT, OUT, nullptr, nullptr, MOD, 5, 1.0f}; pg8::gemm_phase<EpiRes, pg8::StaticOrder>(lds, g, S, E, nullptr); }
    GRID_SYNC();
    normmod_phase<true, true>(OUT, HC1, ML, P.in[I_NF2], MOD, 6, 7, U, OUT);
    GRID_SYNC();
    { pg8::Gemm g{U, WUP, ML, 2 * FF, D}; pg8::StaticOrder S; S.init(ML, 2 * FF, G, bid); EpiSwiglu E{H, FF}; pg8::gemm_phase<EpiSwiglu, pg8::StaticOrder>(lds, g, S, E, nullptr); }
    GRID_SYNC();
    { pg8::Gemm g{H, WDN, ML, D, FF}; pg8::StaticOrder S; S.init(ML, D, G, bid); EpiRes E{OUT, OUT, nullptr, nullptr, MOD, 8, 0.5f}; pg8::gemm_phase<EpiRes, pg8::StaticOrder>(lds, g, S, E, nullptr); }
    GRID_SYNC();
    normmod_phase<false, false>(OUT, HC1, ML, P.in[I_FN], MOD, 0, 0, U, OUT);
}

extern "C" void kernel_launch(void* const* d_in, const int* in_sizes, int n_in, void* d_out, int out_size, void* d_ws, size_t ws_size, hipStream_t stream) {
    static int grid = 0;
    if (grid == 0) {
        if (n_in != 26 || ws_size < WS_NEED) { fprintf(stderr, "kernel_launch: n_in %d ws %zu (need %zu)\n", n_in, ws_size, (size_t)WS_NEED); grid = -1; return; }
        int dev = 0, cus = 0, per_cu = 0;
        hipGetDevice(&dev); hipDeviceGetAttribute(&cus, hipDeviceAttributeMultiprocessorCount, dev);
        if (hipFuncSetAttribute((const void*)mega, hipFuncAttributeMaxDynamicSharedMemorySize, LDS_BYTES) != hipSuccess) { fprintf(stderr, "hipFuncSetAttribute failed\n"); grid = -1; return; }
        if (hipOccupancyMaxActiveBlocksPerMultiprocessor(&per_cu, (const void*)mega, 512, LDS_BYTES) != hipSuccess || per_cu < 1) { fprintf(stderr, "occupancy query: %d\n", per_cu); grid = -1; return; }
        grid = cus;
    }
    if (grid < 0) return;
    Params p{};
    for (int i = 0; i < 26; ++i) p.in[i] = (const float*)d_in[i];
    p.out = (float*)d_out; p.ws = (unsigned char*)d_ws;
    void* args[] = {&p};
    hipError_t e = hipLaunchCooperativeKernel((const void*)mega, dim3(grid), dim3(512), args, LDS_BYTES, stream);
    if (e != hipSuccess) fprintf(stderr, "cooperative launch failed: %s (grid %d)\n", hipGetErrorString(e), grid);
}
```

```cpp
#include <hip/hip_runtime.h>
#include <cstdio>
#define GEMM_ALIGN true
#define GEMM_SP2 true
namespace pg8 {
#define PG8_LAS __attribute__((address_space(3)))
typedef unsigned short bf16_t;
typedef short bf16x8 __attribute__((ext_vector_type(8)));
typedef float f32x4 __attribute__((ext_vector_type(4)));
typedef unsigned u32x4 __attribute__((ext_vector_type(4)));
constexpr int BM = 256, BK = 64, HALF = 128, HTB = HALF * BK * 2  , STAGE_BYTES = 8 * HTB, NXCD = 8, WGM = 8;

__host__ __device__ __forceinline__ int lds_byte(int r, int c) { const int st = (r >> 4) * 2 + (c >> 5), rr = r & 15, cc = c & 31, ob = rr * 64 + cc * 2; return st * 1024 + (ob ^ (((ob >> 9) & 1) << 5)); }
__host__ __device__ __forceinline__ void stage_rc(int b, int& R, int& C) { const int st = b / 1024, sb = b % 1024, swz = sb ^ (((sb >> 9) & 1) << 5); R = (st >> 1) * 16 + swz / 64; C = (st & 1) * 32 + (swz % 64) / 2; }
__host__ __device__ __forceinline__ int perm32(int rho) { const int n = rho >> 4, i = rho & 15; return 8 * (i >> 2) + 4 * n + (i & 3); }

struct Unit { int pm, pn, pk; };
struct Gemm { const bf16_t* A; const bf16_t* Bt; int M, N, K, Kp; };

struct StaticOrder {
    int nM, nN, nwg, G, c;
    __host__ __device__ void init(int M, int N, int G_, int c_) { nM = M / BM; nN = N / BM; nwg = nM * nN; G = G_; c = c_; }
    __host__ __device__ bool next(int i, Unit& u) const {
        const long L = (long)i * G + c; if (L >= nwg) return false;
        int wgid = (int)L; { const int q = nwg / NXCD, r = nwg % NXCD, xcd = wgid % NXCD, off = wgid / NXCD; wgid = (xcd < r ? xcd * (q + 1) : r * (q + 1) + (xcd - r) * q) + off; }
        const int nig = WGM * nN, gid = wgid / nig, fm = gid * WGM, gsz = (nM - fm) < WGM ? (nM - fm) : WGM;
        u.pm = fm + ((wgid % nig) % gsz); u.pn = (wgid % nig) / gsz; u.pk = 0; return true;
    }
    __device__ __forceinline__ void a_ready(const Unit&) const {}
    __device__ __forceinline__ void done(const Unit&) const {}
};
__device__ __forceinline__ unsigned cvt_pk_bf16(float lo, float hi) { unsigned r; asm volatile("v_cvt_pk_bf16_f32 %0, %1, %2" : "=v"(r) : "v"(lo), "v"(hi)); return r; }
template <class Epi, class Sched, bool ALIGN_EPI = false, bool SP2 = false, bool STAMP = false>
__device__ __forceinline__ void gemm_phase(PG8_LAS unsigned char* lds, const Gemm g, const Sched& S, const Epi& E, unsigned long long* stamps) {
    int tid_ = threadIdx.x; asm volatile("" : "+v"(tid_));
    const int tid = tid_, wid = __builtin_amdgcn_readfirstlane(tid >> 6), lane = tid & 63, wr = wid >> 2, wc = wid & 3, fr = lane & 15, fq = lane >> 4;
    const int K = g.Kp, nt = g.K / BK;
    int ts_lo = 0, ts_hi = 0, nts = 0; const unsigned long long rt_entry = STAMP ? (unsigned long long)wall_clock64() : 0ull;
#define PG8_STAMP() do { if (STAMP && wid == 0 && nts < 64) { const unsigned long long _c = (unsigned long long)clock64(); \
        ts_lo = (lane == nts) ? (int)(unsigned)_c : ts_lo; ts_hi = (lane == nts) ? (int)(unsigned)(_c >> 32) : ts_hi; ++nts; } } while (0)
    PG8_STAMP();
    unsigned voffA[2], voffB[2];
#pragma unroll
    for (int i = 0; i < 2; ++i) { int R, C; stage_rc(tid * 16 + i * 8192, R, C); const int Rb = Epi::PERM ? ((R & ~31) + perm32(R & 31)) : R;
        voffA[i] = (unsigned)(R * K + C) * 2u; voffB[i] = (unsigned)(Rb * K + C) * 2u; }
    const size_t kstep = (size_t)(BK * 2);
    const size_t hstep = (size_t)HALF * K * 2;
    const size_t tstep = 2 * hstep;
    const unsigned ldsw = (unsigned)wid * 1024u;
    const int aoff = lds_byte(wr * 64 + fr, fq * 8), boff = lds_byte(wc * 32 + fr, fq * 8);
#define PG8_SA(b, h) (((b) * 2 + (h)) * HTB)
#define PG8_SB(b, h) ((4 + (b) * 2 + (h)) * HTB)
#define PG8_STAGE(bufoff, gbase, voff) do { _Pragma("unroll") for (int _i = 0; _i < 2; ++_i) \
        __builtin_amdgcn_global_load_lds((const unsigned*)((const char*)(gbase) + (voff)[_i]), (PG8_LAS unsigned*)(lds + (bufoff) + ldsw + _i * 8192), 16, 0, 0); } while (0)
#define PG8_LDA(dst, b, h) do { _Pragma("unroll") for (int m = 0; m < 4; ++m) _Pragma("unroll") for (int k = 0; k < 2; ++k) dst[m][k] = *(const PG8_LAS bf16x8*)(lds + PG8_SA(b, h) + aoff + m * 2048 + k * 1024); } while (0)
#define PG8_LDB(dst, b, h) do { _Pragma("unroll") for (int n = 0; n < 2; ++n) _Pragma("unroll") for (int k = 0; k < 2; ++k) dst[n][k] = *(const PG8_LAS bf16x8*)(lds + PG8_SB(b, h) + boff + n * 2048 + k * 1024); } while (0)
#define PG8_MMA(ai, bj, At, Bt) do { __builtin_amdgcn_s_setprio(1); _Pragma("unroll") for (int m = 0; m < 4; ++m) _Pragma("unroll") for (int n = 0; n < 2; ++n) _Pragma("unroll") for (int k = 0; k < 2; ++k) \
        acc[ai][bj][m][n] = __builtin_amdgcn_mfma_f32_16x16x32_bf16(Bt[n][k], At[m][k], acc[ai][bj][m][n], 0, 0, 0); __builtin_amdgcn_s_setprio(0); } while (0)
#define PG8_WAIT_V(n) asm volatile("s_waitcnt vmcnt(" #n ")" ::: "memory")
#define PG8_WAIT_L(n) asm volatile("s_waitcnt lgkmcnt(" #n ")" ::: "memory")
#define PG8_BAR __builtin_amdgcn_s_barrier()
#define PG8_SCHED __builtin_amdgcn_sched_barrier(0)
    Unit cur, nxt; int ui = 0;
    if (!S.next(0, cur)) return;
    f32x4 acc[2][2][4][2];
#pragma unroll
    for (int a = 0; a < 2; ++a)
#pragma unroll
        for (int b = 0; b < 2; ++b)
#pragma unroll
            for (int m = 0; m < 4; ++m)
#pragma unroll
                for (int n = 0; n < 2; ++n) acc[a][b][m][n] = (f32x4){0.f, 0.f, 0.f, 0.f};
    bf16x8 At[4][2], B0[2][2], B1[2][2];
    const size_t pstep = (size_t)g.K * 2;
    const char* cA = (const char*)g.A + (size_t)cur.pm * tstep + (size_t)cur.pk * pstep; const char* cB = (const char*)g.Bt + (size_t)cur.pn * tstep + (size_t)cur.pk * pstep;
    S.a_ready(cur);
    if constexpr (SP2) {
        PG8_STAGE(PG8_SB(0, 0), cB, voffB); PG8_STAGE(PG8_SB(0, 1), cB + hstep, voffB); PG8_STAGE(PG8_SA(0, 0), cA, voffA); PG8_STAGE(PG8_SA(0, 1), cA + hstep, voffA);
        if (wr == 1) PG8_BAR;
        PG8_WAIT_V(2); PG8_BAR;
    } else {
        PG8_STAGE(PG8_SB(0, 0), cB, voffB); PG8_STAGE(PG8_SA(0, 0), cA, voffA); PG8_STAGE(PG8_SB(0, 1), cB + hstep, voffB); PG8_STAGE(PG8_SA(0, 1), cA + hstep, voffA);
        if (wr == 1) PG8_BAR;
        PG8_WAIT_V(4); PG8_BAR;
    }
    PG8_STAGE(PG8_SB(1, 0), cB + kstep, voffB); PG8_STAGE(PG8_SA(1, 0), cA + kstep, voffA); PG8_STAGE(PG8_SB(1, 1), cB + hstep + kstep, voffB);
    PG8_WAIT_V(6); PG8_BAR;
    PG8_STAMP();
    for (;;) {
        const bool has_next = S.next(ui + 1, nxt);
        const char* nA = has_next ? (const char*)g.A + (size_t)nxt.pm * tstep + (size_t)nxt.pk * pstep : cA; const char* nB = has_next ? (const char*)g.Bt + (size_t)nxt.pn * tstep + (size_t)nxt.pk * pstep : cB;
        for (int t = 0; t < nt; t += 2) {
            const bool last = (t == nt - 2);
            const char* a1 = cA + (size_t)(t + 1) * kstep;
            const char* a2 = last ? nA : cA + (size_t)(t + 2) * kstep; const char* b2 = last ? nB : cB + (size_t)(t + 2) * kstep;
            const char* a3 = a2 + kstep; const char* b3 = b2 + kstep;
            if (last && has_next) S.a_ready(nxt);
            if constexpr (SP2) {
            PG8_LDB(B0, 0, 0); PG8_LDB(B1, 0, 1); PG8_SCHED; PG8_LDA(At, 0, 0); PG8_STAGE(PG8_SA(1, 1), a1 + hstep, voffA);
            PG8_WAIT_V(8); PG8_WAIT_L(0); PG8_BAR; PG8_MMA(0, 0, At, B0); PG8_MMA(0, 1, At, B1); PG8_BAR; PG8_SCHED;
            PG8_LDA(At, 0, 1); PG8_STAGE(PG8_SB(0, 0), b2, voffB); PG8_STAGE(PG8_SB(0, 1), b2 + hstep, voffB); PG8_STAGE(PG8_SA(0, 0), a2, voffA);
            PG8_WAIT_V(8); PG8_WAIT_L(0); PG8_BAR; PG8_MMA(1, 0, At, B0); PG8_MMA(1, 1, At, B1); PG8_BAR; PG8_SCHED;
            PG8_LDB(B0, 1, 0); PG8_LDB(B1, 1, 1); PG8_SCHED; PG8_LDA(At, 1, 0); PG8_STAGE(PG8_SA(0, 1), a2 + hstep, voffA);
            PG8_WAIT_V(8); PG8_WAIT_L(0); PG8_BAR; PG8_MMA(0, 0, At, B0); PG8_MMA(0, 1, At, B1); PG8_BAR; PG8_SCHED;
            PG8_LDA(At, 1, 1); PG8_STAGE(PG8_SB(1, 0), b3, voffB); PG8_STAGE(PG8_SB(1, 1), b3 + hstep, voffB); PG8_STAGE(PG8_SA(1, 0), a3, voffA);
            PG8_WAIT_V(8); PG8_WAIT_L(0); PG8_BAR; PG8_MMA(1, 0, At, B0); PG8_MMA(1, 1, At, B1); PG8_BAR; PG8_SCHED;
            } else {
            PG8_LDB(B0, 0, 0); PG8_SCHED; PG8_LDA(At, 0, 0); PG8_STAGE(PG8_SA(1, 1), a1 + hstep, voffA);
            PG8_WAIT_L(8); PG8_BAR; PG8_WAIT_L(0); PG8_MMA(0, 0, At, B0); PG8_BAR; PG8_SCHED;
            PG8_LDB(B1, 0, 1); PG8_STAGE(PG8_SB(0, 0), b2, voffB);
            PG8_BAR; PG8_WAIT_L(0); PG8_MMA(0, 1, At, B1); PG8_BAR;
            PG8_LDA(At, 0, 1); PG8_STAGE(PG8_SA(0, 0), a2, voffA);
            PG8_BAR; PG8_WAIT_L(0); PG8_MMA(1, 0, At, B0); PG8_BAR; PG8_SCHED;
            PG8_STAGE(PG8_SB(0, 1), b2 + hstep, voffB);
            PG8_WAIT_V(6); PG8_BAR; PG8_MMA(1, 1, At, B1); PG8_BAR;
            PG8_LDB(B0, 1, 0); PG8_SCHED; PG8_LDA(At, 1, 0); PG8_STAGE(PG8_SA(0, 1), a2 + hstep, voffA);
            PG8_WAIT_L(8); PG8_BAR; PG8_WAIT_L(0); PG8_MMA(0, 0, At, B0); PG8_BAR; PG8_SCHED;
            PG8_LDB(B1, 1, 1); PG8_STAGE(PG8_SB(1, 0), b3, voffB);
            PG8_BAR; PG8_WAIT_L(0); PG8_MMA(0, 1, At, B1); PG8_BAR;
            PG8_LDA(At, 1, 1); PG8_STAGE(PG8_SA(1, 0), a3, voffA);
            PG8_BAR; PG8_WAIT_L(0); PG8_MMA(1, 0, At, B0); PG8_BAR; PG8_SCHED;
            PG8_STAGE(PG8_SB(1, 1), b3 + hstep, voffB);
            PG8_WAIT_V(6); PG8_BAR; PG8_MMA(1, 1, At, B1); PG8_BAR;
            }
        }
        PG8_STAMP();
        if constexpr (ALIGN_EPI) { if (wr == 0) PG8_BAR; }
        if constexpr (!Epi::AFTER_DRAIN) { E(acc, cur, wr, wc, fr, fq); S.done(cur); }
        PG8_STAMP();
        if (!has_next) break;
#pragma unroll
        for (int a = 0; a < 2; ++a)
#pragma unroll
            for (int b = 0; b < 2; ++b)
#pragma unroll
                for (int m = 0; m < 4; ++m)
#pragma unroll
                    for (int n = 0; n < 2; ++n) acc[a][b][m][n] = (f32x4){0.f, 0.f, 0.f, 0.f};
        cur = nxt; cA = nA; cB = nB; ++ui;
        if constexpr (ALIGN_EPI) { if (wr == 1) PG8_BAR; }
    }
    PG8_WAIT_V(0);
    if constexpr (!ALIGN_EPI) { if (wr == 0) PG8_BAR; }
    PG8_BAR;
    if constexpr (Epi::AFTER_DRAIN) { E.fused(acc, cur, wr, wc, fr, fq, lds, wid, lane); S.done(cur); }
    PG8_STAMP();
    if (STAMP && wid == 0) { stamps[lane] = lane < nts ? (((unsigned long long)(unsigned)ts_hi << 32) | (unsigned)ts_lo) : 0ull;
        if (lane == 62) stamps[62] = rt_entry; if (lane == 63) stamps[63] = (unsigned long long)wall_clock64(); }
#undef PG8_STAMP
#undef PG8_SA
#undef PG8_SB
#undef PG8_STAGE
#undef PG8_LDA
#undef PG8_LDB
#undef PG8_MMA
#undef PG8_WAIT_V
#undef PG8_WAIT_L
#undef PG8_BAR
#undef PG8_SCHED
}
}

#define LAS __attribute__((address_space(3)))
typedef unsigned short bf16;
typedef _Float16 f16;
typedef pg8::f32x4 f32x4;
typedef pg8::u32x4 u32x4;
typedef pg8::bf16x8 bf16x8;
typedef unsigned u32x2 __attribute__((ext_vector_type(2)));
typedef _Float16 f16x8 __attribute__((ext_vector_type(8)));
typedef _Float16 f16x4 __attribute__((ext_vector_type(4)));

constexpr int D = 1024, NB = 8, SEQ = 4096, CTXL = 256, ML = NB * SEQ, MC = NB * CTXL, MT = ML + MC, FF = 2816, NMODC = 9 * D;
constexpr float EPS = 1e-6f;
constexpr size_t MiB = 1ull << 20;
constexpr size_t WS_WUP = 0, WS_WDN = 11 * MiB, WS_WIN = 17 * MiB, WS_WPA = 35 * MiB, WS_WPB = 37 * MiB, WS_WO = 39 * MiB, WS_MOD = 41 * MiB,
                 WS_U = 42 * MiB, WS_R = 110 * MiB, WS_BAR = 41 * MiB + 512 * 1024;
constexpr size_t R_H = WS_R, R_HC1 = WS_R + 187 * MiB;
constexpr size_t R_Q = WS_R, R_GF = WS_R + 64 * MiB, R_GB = WS_R + 132 * MiB, R_V = WS_R + 200 * MiB, R_OF = WS_R + 268 * MiB, R_OB = WS_R + 332 * MiB;
constexpr size_t R_SG = WS_R, R_GLU = WS_R + 64 * MiB, R_GATES = WS_R + 128 * MiB;
constexpr size_t WS_NEED = WS_R + 396 * MiB;
constexpr int LDS_BYTES = 131072 + 4096;

struct Params { const float* in[26]; float* out; unsigned char* ws; };
enum { I_X = 0, I_C, I_CTX, I_CCTX, I_WADA, I_BADA, I_NF1, I_W1U, I_W1D, I_NMIX, I_WIN, I_LBL, I_HGN, I_WDW, I_BDW, I_LNG, I_LNB, I_WPA, I_WPB, I_WG, I_BG, I_WO,
       I_NF2, I_W2U, I_W2D, I_FN };

__device__ __forceinline__ int tid_opaque() { int t = threadIdx.x; asm volatile("" : "+v"(t)); return t; }
__device__ __forceinline__ float bf2f(unsigned short b) { return __uint_as_float(((unsigned)b) << 16); }
__device__ __forceinline__ float bflo(unsigned w) { return __uint_as_float(w << 16); }
__device__ __forceinline__ float bfhi(unsigned w) { return __uint_as_float(w & 0xffff0000u); }
typedef __bf16 bf2_t __attribute__((ext_vector_type(2)));
__device__ __forceinline__ unsigned pk2(float lo, float hi) { bf2_t v; v.x = (__bf16)lo; v.y = (__bf16)hi; return __builtin_bit_cast(unsigned, v); }
__device__ __forceinline__ float sigmoidf_(float x) { return __builtin_amdgcn_rcpf(1.0f + __expf(-x)); }
__device__ __forceinline__ float siluf_(float x) { return x * __builtin_amdgcn_rcpf(1.0f + __expf(-x)); }
typedef float f32x2 __attribute__((ext_vector_type(2)));
__device__ __forceinline__ f32x2 sig2_(f32x2 x) { const f32x2 t = x * (-1.44269504f); f32x2 e; e.x = __builtin_amdgcn_exp2f(t.x); e.y = __builtin_amdgcn_exp2f(t.y); const f32x2 d = e + 1.0f; f32x2 r; r.x = __builtin_amdgcn_rcpf(d.x); r.y = __builtin_amdgcn_rcpf(d.y); return r; }
__device__ __forceinline__ f32x4 sig4_(f32x4 x) { const f32x2 lo = sig2_(__builtin_shufflevector(x, x, 0, 1)), hi = sig2_(__builtin_shufflevector(x, x, 2, 3)); return (f32x4){lo.x, lo.y, hi.x, hi.y}; }
__device__ __forceinline__ f32x4 silu4_(f32x4 x) { return x * sig4_(x); }
__device__ __forceinline__ u32x2 pk4(f32x4 v) { u32x2 w; w.x = pk2(v[0], v[1]); w.y = pk2(v[2], v[3]); return w; }

struct EpiSwiglu {
    static constexpr bool PERM = true, AFTER_DRAIN = false;
    bf16* H; int ldh;
    __device__ __forceinline__ void operator()(const f32x4 (&acc)[2][2][4][2], const pg8::Unit& u, int wr, int wc, int fr, int fq) const {
        const int row0 = u.pm * 256 + wr * 64 + fr, col0 = u.pn * 128 + wc * 32 + 8 * fq;
#pragma unroll
        for (int ai = 0; ai < 2; ++ai)
#pragma unroll
            for (int m = 0; m < 4; ++m) {
                bf16* rowp = H + (size_t)(row0 + ai * 128 + m * 16) * ldh + col0;
                const u32x2 w0 = pk4(silu4_(acc[ai][0][m][0]) * acc[ai][1][m][0]), w1 = pk4(silu4_(acc[ai][0][m][1]) * acc[ai][1][m][1]);
                *(u32x4*)rowp = (u32x4){w0.x, w0.y, w1.x, w1.y};
            }
    }
};

struct EpiRes {
    static constexpr bool PERM = false, AFTER_DRAIN = false;
    const float* baseL; float* outL; const float* baseC; float* outC; const float* mod; int gidx; float coef;
    __device__ __forceinline__ void operator()(const f32x4 (&acc)[2][2][4][2], const pg8::Unit& u, int wr, int wc, int fr, int fq) const {
        const bool lat = u.pm < 128;
        const int prow = (lat ? u.pm : u.pm - 128) * 256 + wr * 64 + fr;
        const float* base = lat ? baseL : baseC; float* out = lat ? outL : outC;
        const float* gate = mod + (size_t)(lat ? (u.pm >> 4) : 8) * NMODC + gidx * D;
        const int col0 = u.pn * 256 + wc * 32 + 4 * fq;
        f32x4 gv[2][2];
#pragma unroll
        for (int bj = 0; bj < 2; ++bj)
#pragma unroll
            for (int n = 0; n < 2; ++n) gv[bj][n] = *(const f32x4*)(gate + col0 + bj * 128 + n * 16) * coef;
#pragma unroll
        for (int ai = 0; ai < 2; ++ai)
#pragma unroll
            for (int m = 0; m < 4; ++m) {
                const size_t off = (size_t)(prow + ai * 128 + m * 16) * D + col0;
#pragma unroll
                for (int bj = 0; bj < 2; ++bj)
#pragma unroll
                    for (int n = 0; n < 2; ++n) {
                        const f32x4 bs = *(const f32x4*)(base + off + bj * 128 + n * 16);
                        *(f32x4*)(out + off + bj * 128 + n * 16) = bs + gv[bj][n] * acc[ai][bj][m][n];
                    }
            }
    }
};

struct EpiMix1 {
    static constexpr bool PERM = true, AFTER_DRAIN = false;
    bf16* Q; f16* GF; f16* GB; bf16* V; const float* lbf; const float* lbb;
    __device__ __forceinline__ void operator()(const f32x4 (&acc)[2][2][4][2], const pg8::Unit& u, int wr, int wc, int fr, int fq) const {
        const int seg = u.pn >> 2;
        const int row0 = u.pm * 256 + wr * 64 + fr, col0 = (u.pn & 3) * 256 + wc * 32 + 8 * fq;
        if (seg == 0) {
            if (u.pm >= 128) return;
#pragma unroll
            for (int ai = 0; ai < 2; ++ai)
#pragma unroll
                for (int m = 0; m < 4; ++m)
#pragma unroll
                    for (int bj = 0; bj < 2; ++bj) {
                        const f32x4 a = acc[ai][bj][m][0], b = acc[ai][bj][m][1];
                        const u32x2 w0 = pk4(silu4_(a)), w1 = pk4(silu4_(b)); const u32x4 w = (u32x4){w0.x, w0.y, w1.x, w1.y};
                        *(u32x4*)(Q + (size_t)(row0 + ai * 128 + m * 16) * D + col0 + bj * 128) = w;
                    }
        } else if (seg == 3) {
#pragma unroll
            for (int ai = 0; ai < 2; ++ai)
#pragma unroll
                for (int m = 0; m < 4; ++m)
#pragma unroll
                    for (int bj = 0; bj < 2; ++bj) {
                        const f32x4 a = acc[ai][bj][m][0], b = acc[ai][bj][m][1];
                        u32x4 w; w.x = pk2(a[0], a[1]); w.y = pk2(a[2], a[3]); w.z = pk2(b[0], b[1]); w.w = pk2(b[2], b[3]);
                        *(u32x4*)(V + (size_t)(row0 + ai * 128 + m * 16) * D + col0 + bj * 128) = w;
                    }
        } else {
            const float* lb = (seg == 1) ? lbf : lbb; f16* G = (seg == 1) ? GF : GB;
#pragma unroll
            for (int bj = 0; bj < 2; ++bj) {
                const f32x4 l0 = *(const f32x4*)(lb + col0 + bj * 128), l1 = *(const f32x4*)(lb + col0 + bj * 128 + 4);
#pragma unroll
                for (int ai = 0; ai < 2; ++ai)
#pragma unroll
                    for (int m = 0; m < 4; ++m) {
                        const f32x4 a = acc[ai][bj][m][0], b = acc[ai][bj][m][1];
                        f16x8 w;
                        const f32x4 fa = l0 + (1.0f - l0) * sig4_(a), fb = l1 + (1.0f - l1) * sig4_(b);
#pragma unroll
                        for (int j = 0; j < 4; ++j) { w[j] = (f16)__builtin_amdgcn_logf(fa[j]); w[4 + j] = (f16)__builtin_amdgcn_logf(fb[j]); }
                        *(f16x8*)(G + (size_t)(row0 + ai * 128 + m * 16) * D + col0 + bj * 128) = w;
                    }
            }
        }
    }
};

struct EpiMix2 {
    static constexpr bool PERM = true, AFTER_DRAIN = false;
    bf16* SG; bf16* GLU; bf16* GATES; const float* bgate;
    __device__ __forceinline__ void operator()(const f32x4 (&acc)[2][2][4][2], const pg8::Unit& u, int wr, int wc, int fr, int fq) const {
        const int row0 = u.pm * 256 + wr * 64 + fr, cw = wc * 32 + 8 * fq;
        if (u.pn < 4) {
#pragma unroll
            for (int ai = 0; ai < 2; ++ai)
#pragma unroll
                for (int m = 0; m < 4; ++m)
#pragma unroll
                    for (int bj = 0; bj < 2; ++bj) {
                        const f32x4 a = acc[ai][bj][m][0], b = acc[ai][bj][m][1];
                        const u32x2 w0 = pk4(silu4_(a)), w1 = pk4(silu4_(b)); const u32x4 w = (u32x4){w0.x, w0.y, w1.x, w1.y};
                        *(u32x4*)(SG + (size_t)(row0 + ai * 128 + m * 16) * D + u.pn * 256 + bj * 128 + cw) = w;
                    }
        } else if (u.pn < 12) {
            const int c0 = (u.pn - 4) * 128 + cw;
#pragma unroll
            for (int ai = 0; ai < 2; ++ai)
#pragma unroll
                for (int m = 0; m < 4; ++m) {
                    const u32x2 w0 = pk4(acc[ai][0][m][0] * sig4_(acc[ai][1][m][0])), w1 = pk4(acc[ai][0][m][1] * sig4_(acc[ai][1][m][1])); const u32x4 w = (u32x4){w0.x, w0.y, w1.x, w1.y};
                    *(u32x4*)(GLU + (size_t)(row0 + ai * 128 + m * 16) * D + c0) = w;
                }
        } else {
            const int c0 = (u.pn - 12) * 256 + cw;
#pragma unroll
            for (int bj = 0; bj < 2; ++bj) {
                const f32x4 b0 = *(const f32x4*)(bgate + c0 + bj * 128), b1 = *(const f32x4*)(bgate + c0 + bj * 128 + 4);
#pragma unroll
                for (int ai = 0; ai < 2; ++ai)
#pragma unroll
                    for (int m = 0; m < 4; ++m) {
                        const f32x4 a = acc[ai][bj][m][0] + b0, b = acc[ai][bj][m][1] + b1;
                        const u32x2 w0 = pk4(sig4_(a)), w1 = pk4(sig4_(b)); const u32x4 w = (u32x4){w0.x, w0.y, w1.x, w1.y};
                        *(u32x4*)(GATES + (size_t)(row0 + ai * 128 + m * 16) * 2048 + c0 + bj * 128) = w;
                    }
            }
        }
    }
};

template <int ADD> struct EpiGate {
    static constexpr bool PERM = true, AFTER_DRAIN = false;
    const bf16* GATES; bf16* T; int goff;
    __device__ __forceinline__ void operator()(const f32x4 (&acc)[2][2][4][2], const pg8::Unit& u, int wr, int wc, int fr, int fq) const {
        const int row0 = u.pm * 256 + wr * 64 + fr, col0 = u.pn * 256 + wc * 32 + 8 * fq;
#pragma unroll
        for (int ai = 0; ai < 2; ++ai)
#pragma unroll
            for (int m = 0; m < 4; ++m)
#pragma unroll
                for (int bj = 0; bj < 2; ++bj) {
                    const size_t r = (size_t)(row0 + ai * 128 + m * 16);
                    const u32x4 g = *(const u32x4*)(GATES + r * 2048 + goff + col0 + bj * 128);
                    bf16* tp = T + r * D + col0 + bj * 128;
                    const f32x4 a = acc[ai][bj][m][0], b = acc[ai][bj][m][1];
                    float o[8];
                    o[0] = bflo(g.x) * a[0]; o[1] = bfhi(g.x) * a[1]; o[2] = bflo(g.y) * a[2]; o[3] = bfhi(g.y) * a[3];
                    o[4] = bflo(g.z) * b[0]; o[5] = bfhi(g.z) * b[1]; o[6] = bflo(g.w) * b[2]; o[7] = bfhi(g.w) * b[3];
                    if (ADD) { const u32x4 t = *(const u32x4*)tp;
                        o[0] += bflo(t.x); o[1] += bfhi(t.x); o[2] += bflo(t.y); o[3] += bfhi(t.y); o[4] += bflo(t.z); o[5] += bfhi(t.z); o[6] += bflo(t.w); o[7] += bfhi(t.w); }
                    u32x4 w; w.x = pk2(o[0], o[1]); w.y = pk2(o[2], o[3]); w.z = pk2(o[4], o[5]); w.w = pk2(o[6], o[7]);
                    *(u32x4*)tp = w;
                }
    }
};


struct KSplitOrder {
    int G, c;
    __device__ bool next(int i, pg8::Unit& u) const { const int L = i * G + c; if (L >= 352) return false; u.pk = L >> 5; u.pm = 128 + ((L & 31) >> 2); u.pn = L & 3; return true; }
    __device__ __forceinline__ void a_ready(const pg8::Unit&) const {}
    __device__ __forceinline__ void done(const pg8::Unit&) const {}
};
struct EpiPart {
    static constexpr bool PERM = false, AFTER_DRAIN = false;
    float* part;
    __device__ __forceinline__ void operator()(const f32x4 (&acc)[2][2][4][2], const pg8::Unit& u, int wr, int wc, int fr, int fq) const {
        const int prow = (u.pm - 128) * 256 + wr * 64 + fr, col0 = u.pn * 256 + wc * 32 + 4 * fq;
        float* base = part + ((size_t)u.pk * MC + prow) * D + col0;
#pragma unroll
        for (int ai = 0; ai < 2; ++ai)
#pragma unroll
            for (int m = 0; m < 4; ++m)
#pragma unroll
                for (int bj = 0; bj < 2; ++bj)
#pragma unroll
                    for (int n = 0; n < 2; ++n) *(f32x4*)(base + (size_t)(ai * 128 + m * 16) * D + bj * 128 + n * 16) = acc[ai][bj][m][n];
    }
};

__device__ __forceinline__ void conv_tile(LAS unsigned char* lds, const float* src, int srcN, int k0, int n0, bf16* dst, int dstK, int drow0) {
    LAS float* T = (LAS float*)lds;
    const int tid = tid_opaque();
#pragma unroll
    for (int i = 0; i < 4; ++i) {
        const int kk = (tid >> 5) + 16 * i, n4 = tid & 31;
        const f32x4 v = *(const f32x4*)(src + (size_t)(k0 + kk) * srcN + n0 + 4 * n4);
#pragma unroll
        for (int j = 0; j < 4; ++j) T[kk * 129 + 4 * n4 + j] = v[j];
    }
    __syncthreads();
    {
        const int nn = tid >> 2, kq = tid & 3;
        float f[16];
#pragma unroll
        for (int j = 0; j < 16; ++j) f[j] = T[(16 * kq + j) * 129 + nn];
        u32x4 w0, w1;
        w0.x = pk2(f[0], f[1]); w0.y = pk2(f[2], f[3]); w0.z = pk2(f[4], f[5]); w0.w = pk2(f[6], f[7]);
        w1.x = pk2(f[8], f[9]); w1.y = pk2(f[10], f[11]); w1.z = pk2(f[12], f[13]); w1.w = pk2(f[14], f[15]);
        bf16* dp = dst + (size_t)(drow0 + nn) * dstK + k0 + 16 * kq;
        *(u32x4*)dp = w0; *(u32x4*)(dp + 8) = w1;
    }
    __syncthreads();
}
__device__ __forceinline__ void conv_job_item(LAS unsigned char* lds, int it, const float* src, int K, int N, bf16* dst, int roff, int pair_from, int NH) {
    const int nt = N / 128; const int kt = it / nt, ntile = it % nt; const int n0 = ntile * 128;
    int drow0;
    if (pair_from < 0 || n0 < pair_from) drow0 = roff + n0;
    else { const int n1 = n0 - pair_from; drow0 = roff + pair_from + ((n1 < NH) ? 256 * (n1 / 128) : 256 * ((n1 - NH) / 128) + 128); }
    conv_tile(lds, src, N, kt * 64, n0, dst, K, drow0);
}

template <bool MODU, bool OUT_BF16, bool CPART = false>
__device__ __forceinline__ void normmod_phase(const float* srcL, const float* srcC, int nrows, const float* gain, const float* mod, int ishift, int iscale, bf16* ub, float* of, const float* part = nullptr, int igate = 0) {
    const int tido = tid_opaque(); const int lane = tido & 63, wv = tido >> 6;
    f32x4 gn[4];
#pragma unroll
    for (int j = 0; j < 4; ++j) gn[j] = *(const f32x4*)(gain + 256 * j + 4 * lane);
    for (int row = blockIdx.x * 8 + wv; row < nrows; row += gridDim.x * 8) {
        const float* src = (row < ML) ? srcL + (size_t)row * D : srcC + (size_t)(row - ML) * D;
        f32x4 x[4]; float ss = 0.f;
#pragma unroll
        for (int j = 0; j < 4; ++j) {
            x[j] = *(const f32x4*)(src + 256 * j + 4 * lane);
            if constexpr (CPART) { if (row >= ML) {
                f32x4 sp = *(const f32x4*)(part + (size_t)(row - ML) * D + 256 * j + 4 * lane);
#pragma unroll
                for (int pk = 1; pk < 11; ++pk) sp += *(const f32x4*)(part + ((size_t)pk * MC + (row - ML)) * D + 256 * j + 4 * lane);
                x[j] += sp * (*(const f32x4*)(mod + (size_t)8 * NMODC + igate * D + 256 * j + 4 * lane) * 0.5f); } }
            ss += x[j][0] * x[j][0] + x[j][1] * x[j][1] + x[j][2] * x[j][2] + x[j][3] * x[j][3]; }
#pragma unroll
        for (int o = 32; o >= 1; o >>= 1) ss += __shfl_xor(ss, o);
        const float rinv = rsqrtf(ss * (1.0f / D) + EPS);
        const int mrow = (row < ML) ? (row >> 12) : 8;
#pragma unroll
        for (int j = 0; j < 4; ++j) {
            f32x4 y = x[j] * rinv * gn[j];
            if constexpr (MODU) { const f32x4 sh = *(const f32x4*)(mod + (size_t)mrow * NMODC + ishift * D + 256 * j + 4 * lane), sc = *(const f32x4*)(mod + (size_t)mrow * NMODC + iscale * D + 256 * j + 4 * lane);
                y = y * (sc + 1.0f) + sh; }
            if constexpr (OUT_BF16) { u32x2 w; w.x = pk2(y[0], y[1]); w.y = pk2(y[2], y[3]); *(u32x2*)(ub + (size_t)row * D + 256 * j + 4 * lane) = w; }
            else *(f32x4*)(of + (size_t)row * D + 256 * j + 4 * lane) = y;
        }
    }
}

__device__ __forceinline__ void adaln_item(LAS unsigned char* lds, int item, const float* wada, const float* bada, float* MOD) {
    LAS float* SC = (LAS float*)lds;
    LAS float* RED = (LAS float*)(lds + 36864);
    const int tid = threadIdx.x, col = tid & 63, kg = tid >> 6, n0 = item * 64;
    float acc[9];
#pragma unroll
    for (int r = 0; r < 9; ++r) acc[r] = 0.f;
    for (int k = kg * 128; k < kg * 128 + 128; ++k) {
        const float w = wada[(size_t)k * NMODC + n0 + col];
#pragma unroll
        for (int r = 0; r < 9; ++r) acc[r] += SC[r * 1024 + k] * w;
    }
#pragma unroll
    for (int r = 0; r < 9; ++r) RED[(kg * 9 + r) * 64 + col] = acc[r];
    __syncthreads();
    for (int idx = tid; idx < 576; idx += 512) {
        const int r = idx >> 6, c = idx & 63; float s = bada[n0 + c];
#pragma unroll
        for (int g = 0; g < 8; ++g) s += RED[(g * 9 + r) * 64 + c];
        MOD[(size_t)r * NMODC + n0 + c] = s;
    }
    __syncthreads();
}

__device__ __forceinline__ void aop_rows(int row_begin, int row_end, int row_step, bf16* OF, const bf16* OB, const bf16* SG, const float* hgn) {
    const int lane = tid_opaque() & 63;
    float gn[16];
#pragma unroll
    for (int j = 0; j < 4; ++j) { const f32x4 t = *(const f32x4*)(hgn + (lane & 7) * 16 + 4 * j); gn[4 * j] = t[0]; gn[4 * j + 1] = t[1]; gn[4 * j + 2] = t[2]; gn[4 * j + 3] = t[3]; }
    for (int row = row_begin; row < row_end; row += row_step) {
        const size_t off = (size_t)row * D + 16 * lane;
        const u32x4 f0 = *(const u32x4*)(OF + off), f1 = *(const u32x4*)(OF + off + 8);
        const u32x4 b0 = *(const u32x4*)(OB + off), b1 = *(const u32x4*)(OB + off + 8);
        const u32x4 s0 = *(const u32x4*)(SG + off), s1 = *(const u32x4*)(SG + off + 8);
        float o[16], sg[16];
#pragma unroll
        for (int j = 0; j < 4; ++j) {
            o[2 * j] = bflo(f0[j]) + bflo(b0[j]); o[2 * j + 1] = bfhi(f0[j]) + bfhi(b0[j]);
            o[8 + 2 * j] = bflo(f1[j]) + bflo(b1[j]); o[8 + 2 * j + 1] = bfhi(f1[j]) + bfhi(b1[j]);
            sg[2 * j] = bflo(s0[j]); sg[2 * j + 1] = bfhi(s0[j]); sg[8 + 2 * j] = bflo(s1[j]); sg[8 + 2 * j + 1] = bfhi(s1[j]);
        }
        float ss = 0.f;
#pragma unroll
        for (int j = 0; j < 16; ++j) ss += o[j] * o[j];
        ss += __shfl_xor(ss, 1); ss += __shfl_xor(ss, 2); ss += __shfl_xor(ss, 4);
        const float rinv = rsqrtf(ss * (1.0f / 128.0f) + EPS);
        float a[16];
#pragma unroll
        for (int j = 0; j < 16; ++j) a[j] = o[j] * rinv * gn[j] * sg[j];
        u32x4 w0, w1;
        w0.x = pk2(a[0], a[1]); w0.y = pk2(a[2], a[3]); w0.z = pk2(a[4], a[5]); w0.w = pk2(a[6], a[7]);
        w1.x = pk2(a[8], a[9]); w1.y = pk2(a[10], a[11]); w1.z = pk2(a[12], a[13]); w1.w = pk2(a[14], a[15]);
        *(u32x4*)(OF + off) = w0; *(u32x4*)(OF + off + 8) = w1;
    }
}

__device__ __forceinline__ void conv_items(LAS unsigned char* lds, int item_begin, int item_end, int item_step, const bf16* GLU, const float* wdw, const float* bdw, const float* lng, const float* lnb, bf16* BOP) {
    constexpr int TT = 16;
    LAS float* P1 = (LAS float*)lds;
    LAS float* P2 = (LAS float*)(lds + 65536);
    LAS float* ST = (LAS float*)(lds + 131072);
    const int tid = tid_opaque(), c = 2 * tid;
    f32x2 w2[31];
#pragma unroll
    for (int j = 0; j < 31; ++j) w2[j] = *(const f32x2*)(wdw + j * D + c);
    const f32x2 bd = *(const f32x2*)(bdw + c), g2 = *(const f32x2*)(lng + c), b2 = *(const f32x2*)(lnb + c);
    unsigned xw[TT + 30];
#define CONV_ISSUE(item_) do { const int b_ = (item_) / (SEQ / TT), t0_ = ((item_) % (SEQ / TT)) * TT; _Pragma("unroll") for (int r = 0; r < TT + 30; ++r) { \
        const int pos = t0_ - 15 + r; xw[r] = 0u; if (pos >= 0 && pos < SEQ) xw[r] = *(const unsigned*)(GLU + (size_t)(b_ * SEQ + pos) * D + c); } } while (0)
    if (item_begin < item_end) CONV_ISSUE(item_begin);
    for (int item = item_begin; item < item_end; item += item_step) {
        const int b = item / (SEQ / TT), t0 = (item % (SEQ / TT)) * TT;
        f32x2 xf[TT + 30];
#pragma unroll
        for (int r = 0; r < TT + 30; ++r) { xf[r].x = bflo(xw[r]); xf[r].y = bfhi(xw[r]); }
        if (item + item_step < item_end) CONV_ISSUE(item + item_step);
        f32x2 y[TT];
#pragma unroll
        for (int t = 0; t < TT; ++t) {
            f32x2 a2 = bd;
#pragma unroll
            for (int j = 0; j < 31; ++j) a2 = __builtin_elementwise_fma(xf[t + j], w2[j], a2);
            y[t] = a2;
        }
#pragma unroll
        for (int t = 0; t < TT; ++t) { const f32x2 q = y[t] * y[t]; P1[t * 512 + tid] = y[t].x + y[t].y; P2[t * 512 + tid] = q.x + q.y; }
        __syncthreads();
        {
            const int t = tid >> 5, part = tid & 31; float sm = 0.f, q = 0.f;
#pragma unroll
            for (int j = 0; j < 4; ++j) { const f32x4 a = *(const LAS f32x4*)(P1 + t * 512 + part * 16 + 4 * j), bq = *(const LAS f32x4*)(P2 + t * 512 + part * 16 + 4 * j);
                sm += (a[0] + a[1]) + (a[2] + a[3]); q += (bq[0] + bq[1]) + (bq[2] + bq[3]); }
#pragma unroll
            for (int o = 16; o >= 1; o >>= 1) { sm += __shfl_xor(sm, o); q += __shfl_xor(q, o); }
            if (part == 0) { const float mean = sm * (1.0f / D); const float var = fmaxf(q * (1.0f / D) - mean * mean, 0.f); ST[2 * t] = mean; ST[2 * t + 1] = rsqrtf(var + EPS); }
        }
        __syncthreads();
#pragma unroll
        for (int t = 0; t < TT; ++t) {
            const float mean = ST[2 * t], rstd = ST[2 * t + 1];
            const f32x2 v = (y[t] - mean) * (g2 * rstd) + b2;
            const f32x2 o = v * sig2_(v);
            *(unsigned*)(BOP + (size_t)(b * SEQ + t0 + t) * D + c) = pk2(o.x, o.y);
        }
        __syncthreads();
    }
#undef CONV_ISSUE
}

__device__ __forceinline__ size_t scan_rowbase(int ci, int t, int dir, int b) {
    const bool ctx = ci < 8; const int lc = ctx ? ci : ci - 8, nch = ctx ? 8 : 128;
    const int p0 = dir ? (nch - 1 - lc) * 32 : lc * 32; const int pos = dir ? p0 + 31 - t : p0 + t;
    return ctx ? (size_t)(ML + b * CTXL + pos) : (size_t)(b * SEQ + pos);
}
constexpr int S2_QS = 0, S2_KS = 26112, S2_KET = 43520, S2_VT = 74240, S2_DEC = 89600, S2_AS = 91136, S2_ST = 96256;
constexpr int QROW = 272, SROW = 80;
struct ScanRegs { u32x4 q, g, v; };
struct ScanCtx { const bf16* Q; const f16* G; const bf16* V; bf16* O; int b, h, dvh, dir, w, lane, l15, q4, tau, cg; };

__device__ __forceinline__ void scan_issue(const ScanCtx& c, int ci, ScanRegs& r) {
    const size_t row = scan_rowbase(ci, c.tau, c.dir, c.b);
    const size_t qrow = (ci >= 8) ? row : (size_t)(c.b * SEQ + c.tau);
    const int d0 = 16 * c.w + 8 * c.cg;
    r.g = *(const u32x4*)(c.G + row * D + c.h * 128 + d0);
    r.q = *(const u32x4*)(c.Q + qrow * D + c.h * 128 + d0);
    r.v = *(const u32x4*)(c.V + row * D + c.h * 128 + c.dvh * 64 + 8 * c.w);
}
template <int CTRL, int ROWMASK> __device__ __forceinline__ float dpp_mul_(float x) {
    const int y = __builtin_amdgcn_update_dpp(0x3f800000, __float_as_int(x), CTRL, ROWMASK, 0xF, false);
    return x * __int_as_float(y);
}
__device__ __forceinline__ void scan_E(LAS unsigned char* lds, const ScanCtx& c, int ci, const ScanRegs& r) {
    const bool lat = ci >= 8; const int s3 = ci % 3, s2 = ci & 1; const int tau = c.tau, d0 = 16 * c.w + 8 * c.cg;
    float f[8], P[8];
    { const f16x8 gh = __builtin_bit_cast(f16x8, r.g);
#pragma unroll
      for (int j = 0; j < 8; ++j) { P[j] = __builtin_amdgcn_exp2f((float)gh[j]); f[j] = 1.0f - P[j]; } }
#define DPP8(ctrl) "v_mul_f32_dpp %0, %0, %0 " ctrl "\n\tv_mul_f32_dpp %1, %1, %1 " ctrl "\n\tv_mul_f32_dpp %2, %2, %2 " ctrl "\n\tv_mul_f32_dpp %3, %3, %3 " ctrl "\n\t" \
                   "v_mul_f32_dpp %4, %4, %4 " ctrl "\n\tv_mul_f32_dpp %5, %5, %5 " ctrl "\n\tv_mul_f32_dpp %6, %6, %6 " ctrl "\n\tv_mul_f32_dpp %7, %7, %7 " ctrl "\n\t"
    asm volatile("s_nop 1\n\t"
                 DPP8("row_shr:1 row_mask:0xf bank_mask:0xf") DPP8("row_shr:2 row_mask:0xf bank_mask:0xf") DPP8("row_shr:4 row_mask:0xf bank_mask:0xf")
                 DPP8("row_shr:8 row_mask:0xf bank_mask:0xf") DPP8("row_bcast:15 row_mask:0xa bank_mask:0xf") "s_nop 1"
                 : "+v"(P[0]), "+v"(P[1]), "+v"(P[2]), "+v"(P[3]), "+v"(P[4]), "+v"(P[5]), "+v"(P[6]), "+v"(P[7]));
#undef DPP8
    float kt[8], qg[8];
    const unsigned qw[4] = {r.q.x, r.q.y, r.q.z, r.q.w};
#pragma unroll
    for (int j = 0; j < 8; ++j) {
        const float k = f[j];
        float pc; asm("v_max_f32 %0, %1, %2" : "=v"(pc) : "v"(P[j]), "v"(1e-30f));
        kt[j] = k * __builtin_amdgcn_rcpf(pc);
        const float qv = (j & 1) ? bfhi(qw[j >> 1]) : bflo(qw[j >> 1]);
        qg[j] = qv * P[j];
    }
    u32x4 wk; wk.x = pk2(kt[0], kt[1]); wk.y = pk2(kt[2], kt[3]); wk.z = pk2(kt[4], kt[5]); wk.w = pk2(kt[6], kt[7]);
    *(LAS u32x4*)(lds + S2_KS + s2 * 8704 + tau * QROW + d0 * 2) = wk;
    if (lat) { u32x4 wq; wq.x = pk2(qg[0], qg[1]); wq.y = pk2(qg[2], qg[3]); wq.z = pk2(qg[4], qg[5]); wq.w = pk2(qg[6], qg[7]);
        *(LAS u32x4*)(lds + S2_QS + s3 * 8704 + tau * QROW + d0 * 2) = wq; }
    { const unsigned kw[4] = {wk.x, wk.y, wk.z, wk.w};
#pragma unroll
      for (int j = 0; j < 4; ++j) {
        *(LAS unsigned short*)(lds + S2_KET + s3 * 10240 + (d0 + 2 * j) * SROW + tau * 2) = (unsigned short)(kw[j] & 0xffffu);
        *(LAS unsigned short*)(lds + S2_KET + s3 * 10240 + (d0 + 2 * j + 1) * SROW + tau * 2) = (unsigned short)(kw[j] >> 16); } }
    if (tau == 31) { LAS float* DC = (LAS float*)(lds + S2_DEC + s3 * 512);
        *(LAS f32x4*)(DC + d0) = (f32x4){P[0], P[1], P[2], P[3]};
        *(LAS f32x4*)(DC + d0 + 4) = (f32x4){P[4], P[5], P[6], P[7]}; }
    if (c.lane < 32) { const unsigned vw[4] = {r.v.x, r.v.y, r.v.z, r.v.w};
#pragma unroll
        for (int j = 0; j < 4; ++j) {
            *(LAS unsigned short*)(lds + S2_VT + s3 * 5120 + (8 * c.w + 2 * j) * SROW + tau * 2) = (unsigned short)(vw[j] & 0xffffu);
            *(LAS unsigned short*)(lds + S2_VT + s3 * 5120 + (8 * c.w + 2 * j + 1) * SROW + tau * 2) = (unsigned short)(vw[j] >> 16); } }
}
__device__ __forceinline__ void scan_A(LAS unsigned char* lds, const ScanCtx& c, int ci) {
    if (c.w >= 3) return;
    const int s3 = ci % 3, s2 = ci & 1; const int l15 = c.l15, q4 = c.q4;
    const LAS unsigned char* QS = lds + S2_QS + s3 * 8704; const LAS unsigned char* KS = lds + S2_KS + s2 * 8704;
    const int ti = (c.w == 0) ? 0 : 1, sj = (c.w == 2) ? 1 : 0;
    f32x4 a4 = (f32x4){0.f, 0.f, 0.f, 0.f};
#pragma unroll
    for (int kk = 0; kk < 4; ++kk) {
        const bf16x8 xa = *(const LAS bf16x8*)(KS + (sj * 16 + l15) * QROW + kk * 64 + q4 * 16);
        const bf16x8 yb = *(const LAS bf16x8*)(QS + (ti * 16 + l15) * QROW + kk * 64 + q4 * 16);
        a4 = __builtin_amdgcn_mfma_f32_16x16x32_bf16(xa, yb, a4, 0, 0, 0);
    }
    const int t = ti * 16 + l15, s0 = sj * 16 + 4 * q4;
    const float m0 = (s0 <= t) ? a4[0] : 0.f, m1 = (s0 + 1 <= t) ? a4[1] : 0.f, m2 = (s0 + 2 <= t) ? a4[2] : 0.f, m3 = (s0 + 3 <= t) ? a4[3] : 0.f;
    u32x2 wa; wa.x = pk2(m0, m1); wa.y = pk2(m2, m3);
    *(LAS u32x2*)(lds + S2_AS + s2 * 2560 + t * SROW + s0 * 2) = wa;
}
__device__ __forceinline__ void scan_M(LAS unsigned char* lds, const ScanCtx& c, int ci, f32x4 (&accS)[4]) {
    const bool lat = ci >= 8; const int s3 = ci % 3, s2 = ci & 1; const int l15 = c.l15, q4 = c.q4, w = c.w;
    const LAS unsigned char* QS = lds + S2_QS + s3 * 8704; const LAS unsigned char* KET = lds + S2_KET + s3 * 10240; const LAS unsigned char* VT = lds + S2_VT + s3 * 5120;
    const LAS unsigned char* STr = lds + S2_ST + s2 * 17408; LAS unsigned char* STw = lds + S2_ST + (s2 ^ 1) * 17408;
    const int tt = w >> 2, et = w & 3;
    if (lat) {
        f32x4 acco = (f32x4){0.f, 0.f, 0.f, 0.f};
#pragma unroll
        for (int kk = 0; kk < 4; ++kk) {
            const bf16x8 xa = *(const LAS bf16x8*)(STr + (et * 16 + l15) * QROW + kk * 64 + q4 * 16);
            const bf16x8 yb = *(const LAS bf16x8*)(QS + (tt * 16 + l15) * QROW + kk * 64 + q4 * 16);
            acco = __builtin_amdgcn_mfma_f32_16x16x32_bf16(xa, yb, acco, 0, 0, 0);
        }
        {
            const bf16x8 xa = *(const LAS bf16x8*)(VT + (et * 16 + l15) * SROW + q4 * 16);
            const bf16x8 yb = *(const LAS bf16x8*)(lds + S2_AS + s2 * 2560 + (tt * 16 + l15) * SROW + q4 * 16);
            acco = __builtin_amdgcn_mfma_f32_16x16x32_bf16(xa, yb, acco, 0, 0, 0);
        }
        const size_t r = scan_rowbase(ci, tt * 16 + l15, c.dir, c.b);
        u32x2 wo; wo.x = pk2(acco[0], acco[1]); wo.y = pk2(acco[2], acco[3]);
        { bf16* op = c.O + r * D + c.h * 128 + c.dvh * 64 + et * 16 + 4 * q4;
          asm volatile("global_store_dwordx2 %0, %1, off" :: "v"(op), "v"(wo) : "memory"); }
    }
    {
        const f32x4 dc = *(const LAS f32x4*)(lds + S2_DEC + s3 * 512 + (16 * w + 4 * q4) * 4);
        const bf16x8 xa = *(const LAS bf16x8*)(KET + (16 * w + l15) * SROW + q4 * 16);
#pragma unroll
        for (int i = 0; i < 4; ++i) {
            const bf16x8 yb = *(const LAS bf16x8*)(VT + (16 * i + l15) * SROW + q4 * 16);
            accS[i] = __builtin_amdgcn_mfma_f32_16x16x32_bf16(xa, yb, accS[i], 0, 0, 0) * dc;
        }
#pragma unroll
        for (int i = 0; i < 4; ++i) {
            u32x2 ws_; ws_.x = pk2(accS[i][0], accS[i][1]); ws_.y = pk2(accS[i][2], accS[i][3]);
            *(LAS u32x2*)(STw + (16 * i + l15) * QROW + (16 * w + 4 * q4) * 2) = ws_;
        }
    }
}
__device__ __forceinline__ void scan_item(LAS unsigned char* lds, int item, const bf16* Q, const f16* GF, const f16* GB, const bf16* V, bf16* OF, bf16* OB) {
    const int tid = tid_opaque(), lane = tid & 63;
    ScanCtx c;
    c.dvh = item & 1; c.dir = (item >> 1) & 1; c.h = (item >> 2) & 7; c.b = item >> 5;
    c.Q = Q; c.G = c.dir ? GB : GF; c.V = V; c.O = c.dir ? OB : OF;
    c.w = __builtin_amdgcn_readfirstlane(tid >> 6); c.lane = lane; c.l15 = lane & 15; c.q4 = lane >> 4; c.tau = lane & 31; c.cg = lane >> 5;
    for (int i = tid; i < (5120 + 34816) / 4; i += 512) ((LAS unsigned*)(lds + S2_AS))[i] = 0u;
    f32x4 accS[4];
#pragma unroll
    for (int i = 0; i < 4; ++i) accS[i] = (f32x4){0.f, 0.f, 0.f, 0.f};
    ScanRegs r0, r1, r2, r3;
    r0.q = r1.q = r2.q = r3.q = (u32x4){0u, 0u, 0u, 0u}; r0.v = r1.v = r2.v = r3.v = (u32x4){0u, 0u, 0u, 0u};
    scan_issue(c, 0, r0); scan_issue(c, 1, r1); scan_issue(c, 2, r2); scan_issue(c, 3, r3);
    __syncthreads();
#define SCAN_STEP(T_, R_) do { const int T = (T_); \
        __builtin_amdgcn_s_setprio(2); if (T >= 2) scan_M(lds, c, T - 2, accS); __builtin_amdgcn_s_setprio(0); \
        if (T >= 9) scan_A(lds, c, T - 1); \
        scan_E(lds, c, T, R_); { const int nx = (T + 4 < 136) ? T + 4 : 135; scan_issue(c, nx, R_); } \
        __syncthreads(); } while (0)
    for (int T0 = 0; T0 < 136; T0 += 4) { SCAN_STEP(T0, r0); SCAN_STEP(T0 + 1, r1); SCAN_STEP(T0 + 2, r2); SCAN_STEP(T0 + 3, r3); }
    scan_M(lds, c, 134, accS); scan_A(lds, c, 135); __syncthreads();
    scan_M(lds, c, 135, accS); __syncthreads();
    asm volatile("s_waitcnt vmcnt(0)" ::: "memory");
#undef SCAN_STEP
}

#define XB_TMO      128
#define XB_XCNT(j)  (256  + 64 * (j))
#define XB_XSUB(j)  (1280 + 64 * (j))
#define XB_XGEN(j)  (2304 + 64 * (j))
#define XB_TOP      3328
#define XB_TOPGEN   3392
#define XCD_BAR_WORDS 3456
#define XB_SPIN_CAP (1u << 18)

__device__ __forceinline__ unsigned xb_ld(unsigned* p)              { return __hip_atomic_load(p, __ATOMIC_RELAXED, __HIP_MEMORY_SCOPE_AGENT); }
__device__ __forceinline__ unsigned xb_add(unsigned* p, unsigned v) { return __hip_atomic_fetch_add(p, v, __ATOMIC_RELAXED, __HIP_MEMORY_SCOPE_AGENT); }
__device__ __forceinline__ unsigned xb_xcc_id() { return (unsigned)__builtin_amdgcn_s_getreg((3 << 11) | 20) & 0xFu; }
#define XB_SPIN(cond, bar) do { unsigned _sp = 0; while (cond) { __builtin_amdgcn_s_sleep(1); \
    if ((++_sp & 255u) == 0u) { if (xb_ld(&(bar)[XB_TMO])) break; if (_sp > XB_SPIN_CAP) { atomicAdd(&(bar)[XB_TMO], 1u); break; } } } } while (0)

struct XcdBarrier {
    unsigned* bar; unsigned x;
    volatile LAS unsigned* st;
};

__device__ __forceinline__ XcdBarrier xcd_barrier_post(unsigned* bar, volatile LAS unsigned* st) {
    XcdBarrier b; b.bar = bar; b.x = xb_xcc_id(); b.st = st;
    if (threadIdx.x == 0) (void)xb_add(&bar[XB_XCNT(b.x)], 1u);
    return b;
}
__device__ __forceinline__ void xcd_barrier_complete(unsigned* bar, unsigned x, unsigned& nloc, unsigned& nx) {
    const unsigned G = gridDim.x * gridDim.y * gridDim.z;
    unsigned sum, cnt, mine, sp = 0u;
    for (;;) {
        sum = 0u; cnt = 0u; mine = 0u;
#pragma unroll
        for (unsigned j = 0; j < 16; ++j) { const unsigned c = xb_ld(&bar[XB_XCNT(j)]); sum += c; cnt += (c > 0u) ? 1u : 0u; mine = (j == x) ? c : mine; }
        if (sum == G) break;
        __builtin_amdgcn_s_sleep(1);
        if ((++sp & 255u) == 0u) { if (xb_ld(&bar[XB_TMO])) break; if (sp > XB_SPIN_CAP) { atomicAdd(&bar[XB_TMO], 1u); break; } }
    }
    nloc = mine > 0u ? mine : 1u; nx = cnt > 0u ? cnt : 1u;
}

__device__ __forceinline__ void xcd_barrier(const XcdBarrier& b) {
    asm volatile("s_waitcnt vmcnt(0)" ::: "memory");
    __syncthreads();
    if (threadIdx.x == 0) {
        unsigned* bar = b.bar;
        __builtin_amdgcn_s_waitcnt(0);
        unsigned nloc = b.st[0], nx = b.st[1];
        if (nloc == 0u) { xcd_barrier_complete(bar, b.x, nloc, nx); b.st[0] = nloc; b.st[1] = nx; }
        const unsigned old = xb_add(&bar[XB_XSUB(b.x)], 1u);
        const unsigned gen = old / nloc;
        if (old + 1u == (gen + 1u) * nloc) {
            __builtin_amdgcn_fence(__ATOMIC_RELEASE, "agent");
            asm volatile("s_waitcnt vmcnt(0)" ::: "memory");
            const unsigned og = xb_add(&bar[XB_TOP], 1u);
            const unsigned tg = og / nx;
            if (og + 1u == (tg + 1u) * nx) xb_add(&bar[XB_TOPGEN], 1u);
            else XB_SPIN(xb_ld(&bar[XB_TOPGEN]) == tg, bar);
            __builtin_amdgcn_fence(__ATOMIC_ACQUIRE, "agent");
            xb_add(&bar[XB_XGEN(b.x)], 1u);
            asm volatile("s_waitcnt vmcnt(0)" ::: "memory");
        } else {
            XB_SPIN(xb_ld(&bar[XB_XGEN(b.x)]) == gen, bar);
            __builtin_amdgcn_fence(__ATOMIC_ACQUIRE, "agent");
            asm volatile("s_waitcnt vmcnt(0)" ::: "memory");
        }
    }
    __syncthreads();
}

__global__ void __launch_bounds__(512, 2) mega(Params P) {
    extern __shared__ __attribute__((aligned(16))) unsigned char lds_raw[];
    LAS unsigned char* lds = (LAS unsigned char*)lds_raw;
#define GRID_SYNC() xcd_barrier(xbar)
    if (threadIdx.x < 2) ((volatile LAS unsigned*)(lds + 131072 + 1024))[threadIdx.x] = 0u;
    __syncthreads();
    XcdBarrier xbar = xcd_barrier_post((unsigned*)(P.ws + WS_BAR), (volatile LAS unsigned*)(lds + 131072 + 1024));
    const int tid = threadIdx.x, G = gridDim.x, bid = blockIdx.x;
    unsigned char* ws = P.ws;
    bf16* WUP = (bf16*)(ws + WS_WUP); bf16* WDN = (bf16*)(ws + WS_WDN); bf16* WIN = (bf16*)(ws + WS_WIN);
    bf16* WPA = (bf16*)(ws + WS_WPA); bf16* WPB = (bf16*)(ws + WS_WPB); bf16* WO = (bf16*)(ws + WS_WO);
    float* MOD = (float*)(ws + WS_MOD); float* LBF = MOD + 9 * NMODC; float* LBB = LBF + 1024;
    bf16* U = (bf16*)(ws + WS_U);
    bf16* H = (bf16*)(ws + R_H); float* HC1 = (float*)(ws + R_HC1);
    bf16* Qb = (bf16*)(ws + R_Q); f16* GFb = (f16*)(ws + R_GF); f16* GBb = (f16*)(ws + R_GB); bf16* Vb = (bf16*)(ws + R_V);
    bf16* OFb = (bf16*)(ws + R_OF); bf16* OBb = (bf16*)(ws + R_OB);
    bf16* SGb = (bf16*)(ws + R_SG); bf16* GLUb = (bf16*)(ws + R_GLU); bf16* GATESb = (bf16*)(ws + R_GATES);
    bf16* BOP = U; bf16* Tb = OBb;
    float* PART = (float*)(ws + WS_R + 192 * MiB);
    float* OUT = P.out;

    {
        if (bid < 144) {
            LAS float* SC = (LAS float*)lds;
            for (int i = tid; i < 9 * 1024; i += 512) { const float v = (i < 8192) ? P.in[I_C][i] : P.in[I_CCTX][i - 8192]; SC[i] = siluf_(v); }
            __syncthreads();
            for (int item = bid; item < 144; item += G) adaln_item(lds, item, P.in[I_WADA], P.in[I_BADA], MOD);
        }
        if (bid == G - 1) {
            const float* l = P.in[I_LBL];
            for (int d = tid; d < 1024; d += 512) { LBF[d] = 1.0f / (1.0f + __expf(l[2048 + d] - l[d])); LBB[d] = 1.0f / (1.0f + __expf(l[3072 + d] - l[1024 + d])); }
        }
        for (int it = (bid + 112) % G; it < 2592; it += G) {
            if (it < 704) conv_job_item(lds, it, P.in[I_W1U], 1024, 5632, WUP, 0, 0, 2816);
            else if (it < 1056) conv_job_item(lds, it - 704, P.in[I_W1D], 2816, 1024, WDN, 0, -1, 0);
            else if (it < 1952) conv_job_item(lds, it - 1056, P.in[I_WIN], 1024, 7168, WIN, 0, 5120, 1024);
            else if (it < 2208) conv_job_item(lds, it - 1952, P.in[I_WG], 1024, 2048, WIN, 7168, -1, 0);
            else if (it < 2336) conv_job_item(lds, it - 2208, P.in[I_WPA], 1024, 1024, WPA, 0, -1, 0);
            else if (it < 2464) conv_job_item(lds, it - 2336, P.in[I_WPB], 1024, 1024, WPB, 0, -1, 0);
            else conv_job_item(lds, it - 2464, P.in[I_WO], 1024, 1024, WO, 0, -1, 0);
        }
    }
    GRID_SYNC();
    normmod_phase<true, true>(P.in[I_X], P.in[I_CTX], MT, P.in[I_NF1], MOD, 0, 1, U, OUT);
    GRID_SYNC();
    { pg8::Gemm g{U, WUP, MT, 2 * FF, D, D}; pg8::StaticOrder S; S.init(MT, 2 * FF, G, bid); EpiSwiglu E{H, FF}; pg8::gemm_phase<EpiSwiglu, pg8::StaticOrder, GEMM_ALIGN, GEMM_SP2>(lds, g, S, E, nullptr); }
    GRID_SYNC();
    { pg8::Gemm g{H, WDN, ML, D, FF, FF}; pg8::StaticOrder S; S.init(ML, D, G, bid); EpiRes E{P.in[I_X], OUT, P.in[I_CTX], HC1, MOD, 2, 0.5f}; pg8::gemm_phase<EpiRes, pg8::StaticOrder, GEMM_ALIGN, GEMM_SP2>(lds, g, S, E, nullptr); }
    { pg8::Gemm g{H, WDN, MT, D, 256, FF}; KSplitOrder S{G, bid}; EpiPart E{PART}; pg8::gemm_phase<EpiPart, KSplitOrder, GEMM_ALIGN, GEMM_SP2>(lds, g, S, E, nullptr); }
    GRID_SYNC();
    normmod_phase<true, true, true>(OUT, P.in[I_CTX], MT, P.in[I_NMIX], MOD, 3, 4, U, OUT, PART, 2);
    GRID_SYNC();
    { pg8::Gemm g{U, WIN, MT, 4096, D, D}; pg8::StaticOrder S; S.init(MT, 4096, G, bid); EpiMix1 E{Qb, GFb, GBb, Vb, LBF, LBB}; pg8::gemm_phase<EpiMix1, pg8::StaticOrder, GEMM_ALIGN, GEMM_SP2>(lds, g, S, E, nullptr); }
    GRID_SYNC();
    for (int item = bid; item < 256; item += G) scan_item(lds, item, Qb, GFb, GBb, Vb, OFb, OBb);
    GRID_SYNC();
    { pg8::Gemm g{U, WIN + (size_t)4096 * D, ML, 5120, D, D}; pg8::StaticOrder S; S.init(ML, 5120, G, bid); EpiMix2 E{SGb, GLUb, GATESb, P.in[I_BG]}; pg8::gemm_phase<EpiMix2, pg8::StaticOrder, GEMM_ALIGN, GEMM_SP2>(lds, g, S, E, nullptr); }
    GRID_SYNC();
    {
        conv_items(lds, bid, 2048, G, GLUb, P.in[I_WDW], P.in[I_BDW], P.in[I_LNG], P.in[I_LNB], BOP);
        aop_rows(bid * 8 + (tid >> 6), ML, G * 8, OFb, OBb, SGb, P.in[I_HGN]);
        for (int it = bid; it < 1056; it += G) {
            if (it < 704) conv_job_item(lds, it, P.in[I_W2U], 1024, 5632, WUP, 0, 0, 2816);
            else conv_job_item(lds, it - 704, P.in[I_W2D], 2816, 1024, WDN, 0, -1, 0);
        }
    }
    GRID_SYNC();
    { pg8::Gemm g{OFb, WPA, ML, D, D, D}; pg8::StaticOrder S; S.init(ML, D, G, bid); EpiGate<0> E{GATESb, Tb, 0}; pg8::gemm_phase<EpiGate<0>, pg8::StaticOrder, GEMM_ALIGN, GEMM_SP2>(lds, g, S, E, nullptr); }
    GRID_SYNC();
    { pg8::Gemm g{BOP, WPB, ML, D, D, D}; pg8::StaticOrder S; S.init(ML, D, G, bid); EpiGate<1> E{GATESb, Tb, 1024}; pg8::gemm_phase<EpiGate<1>, pg8::StaticOrder, GEMM_ALIGN, GEMM_SP2>(lds, g, S, E, nullptr); }
    GRID_SYNC();
    { pg8::Gemm g{Tb, WO, ML, D, D, D}; pg8::StaticOrder S; S.init(ML, D, G, bid); EpiRes E{OUT, OUT, nullptr, nullptr, MOD, 5, 1.0f}; pg8::gemm_phase<EpiRes, pg8::StaticOrder, GEMM_ALIGN, GEMM_SP2>(lds, g, S, E, nullptr); }
    GRID_SYNC();
    normmod_phase<true, true>(OUT, HC1, ML, P.in[I_NF2], MOD, 6, 7, U, OUT);
    GRID_SYNC();
    { pg8::Gemm g{U, WUP, ML, 2 * FF, D, D}; pg8::StaticOrder S; S.init(ML, 2 * FF, G, bid); EpiSwiglu E{H, FF}; pg8::gemm_phase<EpiSwiglu, pg8::StaticOrder, GEMM_ALIGN, GEMM_SP2>(lds, g, S, E, nullptr); }
    GRID_SYNC();
    { pg8::Gemm g{H, WDN, ML, D, FF, FF}; pg8::StaticOrder S; S.init(ML, D, G, bid); EpiRes E{OUT, OUT, nullptr, nullptr, MOD, 8, 0.5f}; pg8::gemm_phase<EpiRes, pg8::StaticOrder, GEMM_ALIGN, GEMM_SP2>(lds, g, S, E, nullptr); }
    GRID_SYNC();
    normmod_phase<false, false>(OUT, HC1, ML, P.in[I_FN], MOD, 0, 0, U, OUT);
}

extern "C" void kernel_launch(void* const* d_in, const int* in_sizes, int n_in, void* d_out, int out_size, void* d_ws, size_t ws_size, hipStream_t stream) {
    static int grid = 0;
    if (grid == 0) {
        if (n_in != 26 || ws_size < WS_NEED) { fprintf(stderr, "kernel_launch: n_in %d ws %zu (need %zu)\n", n_in, ws_size, (size_t)WS_NEED); grid = -1; return; }
        int dev = 0, cus = 0, per_cu = 0;
        hipGetDevice(&dev); hipDeviceGetAttribute(&cus, hipDeviceAttributeMultiprocessorCount, dev);
        if (hipFuncSetAttribute((const void*)mega, hipFuncAttributeMaxDynamicSharedMemorySize, LDS_BYTES) != hipSuccess) { fprintf(stderr, "hipFuncSetAttribute failed\n"); grid = -1; return; }
        if (hipOccupancyMaxActiveBlocksPerMultiprocessor(&per_cu, (const void*)mega, 512, LDS_BYTES) != hipSuccess || per_cu < 1) { fprintf(stderr, "occupancy query: %d\n", per_cu); grid = -1; return; }
        grid = cus;
    }
    if (grid < 0) return;
    if (hipMemsetAsync((char*)d_ws + WS_BAR, 0, XCD_BAR_WORDS * sizeof(unsigned), stream) != hipSuccess) { fprintf(stderr, "memset failed\n"); return; }
    Params p{};
    for (int i = 0; i < 26; ++i) p.in[i] = (const float*)d_in[i];
    p.out = (float*)d_out; p.ws = (unsigned char*)d_ws;
    void* args[] = {&p};
    hipError_t e = hipLaunchCooperativeKernel((const void*)mega, dim3(grid), dim3(512), args, LDS_BYTES, stream);
    if (e != hipSuccess) fprintf(stderr, "cooperative launch failed: %s (grid %d)\n", hipGetErrorString(e), grid);
}
```

```cpp
#include <hip/hip_runtime.h>
#include <cstdio>
#define GEMM_ALIGN true
#define GEMM_SP2 true
namespace pg8 {
#define PG8_LAS __attribute__((address_space(3)))
typedef unsigned short bf16_t;
typedef short bf16x8 __attribute__((ext_vector_type(8)));
typedef float f32x4 __attribute__((ext_vector_type(4)));
typedef unsigned u32x4 __attribute__((ext_vector_type(4)));
constexpr int BM = 256, BK = 64, HALF = 128, HTB = HALF * BK * 2  , STAGE_BYTES = 8 * HTB, NXCD = 8, WGM = 8;

__host__ __device__ __forceinline__ int lds_byte(int r, int c) { const int st = (r >> 4) * 2 + (c >> 5), rr = r & 15, cc = c & 31, ob = rr * 64 + cc * 2; return st * 1024 + (ob ^ (((ob >> 9) & 1) << 5)); }
__host__ __device__ __forceinline__ void stage_rc(int b, int& R, int& C) { const int st = b / 1024, sb = b % 1024, swz = sb ^ (((sb >> 9) & 1) << 5); R = (st >> 1) * 16 + swz / 64; C = (st & 1) * 32 + (swz % 64) / 2; }
__host__ __device__ __forceinline__ int perm32(int rho) { const int n = rho >> 4, i = rho & 15; return 8 * (i >> 2) + 4 * n + (i & 3); }

struct Unit { int pm, pn, pk; };
struct Gemm { const bf16_t* A; const bf16_t* Bt; int M, N, K, Kp; };

struct StaticOrder {
    int nM, nN, nwg, G, c;
    __host__ __device__ void init(int M, int N, int G_, int c_) { nM = M / BM; nN = N / BM; nwg = nM * nN; G = G_; c = c_; }
    __host__ __device__ bool next(int i, Unit& u) const {
        const long L = (long)i * G + c; if (L >= nwg) return false;
        int wgid = (int)L; { const int q = nwg / NXCD, r = nwg % NXCD, xcd = wgid % NXCD, off = wgid / NXCD; wgid = (xcd < r ? xcd * (q + 1) : r * (q + 1) + (xcd - r) * q) + off; }
        const int nig = WGM * nN, gid = wgid / nig, fm = gid * WGM, gsz = (nM - fm) < WGM ? (nM - fm) : WGM;
        u.pm = fm + ((wgid % nig) % gsz); u.pn = (wgid % nig) / gsz; u.pk = 0; return true;
    }
    __device__ __forceinline__ void a_ready(const Unit&) const {}
    __device__ __forceinline__ void done(const Unit&) const {}
};
__device__ __forceinline__ unsigned cvt_pk_bf16(float lo, float hi) { unsigned r; asm volatile("v_cvt_pk_bf16_f32 %0, %1, %2" : "=v"(r) : "v"(lo), "v"(hi)); return r; }
template <class Epi, class Sched, bool ALIGN_EPI = false, bool SP2 = false, bool STAMP = false>
__device__ __forceinline__ void gemm_phase(PG8_LAS unsigned char* lds, const Gemm g, const Sched& S, const Epi& E, unsigned long long* stamps) {
    int tid_ = threadIdx.x; asm volatile("" : "+v"(tid_));
    const int tid = tid_, wid = __builtin_amdgcn_readfirstlane(tid >> 6), lane = tid & 63, wr = wid >> 2, wc = wid & 3, fr = lane & 15, fq = lane >> 4;
    const int K = g.Kp, nt = g.K / BK;
    int ts_lo = 0, ts_hi = 0, nts = 0; const unsigned long long rt_entry = STAMP ? (unsigned long long)wall_clock64() : 0ull;
#define PG8_STAMP() do { if (STAMP && wid == 0 && nts < 64) { const unsigned long long _c = (unsigned long long)clock64(); \
        ts_lo = (lane == nts) ? (int)(unsigned)_c : ts_lo; ts_hi = (lane == nts) ? (int)(unsigned)(_c >> 32) : ts_hi; ++nts; } } while (0)
    PG8_STAMP();
    unsigned voffA[2], voffB[2];
#pragma unroll
    for (int i = 0; i < 2; ++i) { int R, C; stage_rc(tid * 16 + i * 8192, R, C); const int Rb = Epi::PERM ? ((R & ~31) + perm32(R & 31)) : R;
        voffA[i] = (unsigned)(R * K + C) * 2u; voffB[i] = (unsigned)(Rb * K + C) * 2u; }
    const size_t kstep = (size_t)(BK * 2);
    const size_t hstep = (size_t)HALF * K * 2;
    const size_t tstep = 2 * hstep;
    const unsigned ldsw = (unsigned)wid * 1024u;
    const int aoff = lds_byte(wr * 64 + fr, fq * 8), boff = lds_byte(wc * 32 + fr, fq * 8);
#define PG8_SA(b, h) (((b) * 2 + (h)) * HTB)
#define PG8_SB(b, h) ((4 + (b) * 2 + (h)) * HTB)
#define PG8_STAGE(bufoff, gbase, voff) do { _Pragma("unroll") for (int _i = 0; _i < 2; ++_i) \
        __builtin_amdgcn_global_load_lds((const unsigned*)((const char*)(gbase) + (voff)[_i]), (PG8_LAS unsigned*)(lds + (bufoff) + ldsw + _i * 8192), 16, 0, 0); } while (0)
#define PG8_LDA(dst, b, h) do { _Pragma("unroll") for (int m = 0; m < 4; ++m) _Pragma("unroll") for (int k = 0; k < 2; ++k) dst[m][k] = *(const PG8_LAS bf16x8*)(lds + PG8_SA(b, h) + aoff + m * 2048 + k * 1024); } while (0)
#define PG8_LDB(dst, b, h) do { _Pragma("unroll") for (int n = 0; n < 2; ++n) _Pragma("unroll") for (int k = 0; k < 2; ++k) dst[n][k] = *(const PG8_LAS bf16x8*)(lds + PG8_SB(b, h) + boff + n * 2048 + k * 1024); } while (0)
#define PG8_MMA(ai, bj, At, Bt) do { __builtin_amdgcn_s_setprio(1); _Pragma("unroll") for (int m = 0; m < 4; ++m) _Pragma("unroll") for (int n = 0; n < 2; ++n) _Pragma("unroll") for (int k = 0; k < 2; ++k) \
        acc[ai][bj][m][n] = __builtin_amdgcn_mfma_f32_16x16x32_bf16(Bt[n][k], At[m][k], acc[ai][bj][m][n], 0, 0, 0); __builtin_amdgcn_s_setprio(0); } while (0)
#define PG8_WAIT_V(n) asm volatile("s_waitcnt vmcnt(" #n ")" ::: "memory")
#define PG8_WAIT_L(n) asm volatile("s_waitcnt lgkmcnt(" #n ")" ::: "memory")
#define PG8_BAR __builtin_amdgcn_s_barrier()
#define PG8_SCHED __builtin_amdgcn_sched_barrier(0)
    Unit cur, nxt; int ui = 0;
    if (!S.next(0, cur)) return;
    f32x4 acc[2][2][4][2];
#pragma unroll
    for (int a = 0; a < 2; ++a)
#pragma unroll
        for (int b = 0; b < 2; ++b)
#pragma unroll
            for (int m = 0; m < 4; ++m)
#pragma unroll
                for (int n = 0; n < 2; ++n) acc[a][b][m][n] = (f32x4){0.f, 0.f, 0.f, 0.f};
    bf16x8 At[4][2], B0[2][2], B1[2][2];
    const size_t pstep = (size_t)g.K * 2;
    const char* cA = (const char*)g.A + (size_t)cur.pm * tstep + (size_t)cur.pk * pstep; const char* cB = (const char*)g.Bt + (size_t)cur.pn * tstep + (size_t)cur.pk * pstep;
    S.a_ready(cur);
    if constexpr (SP2) {
        PG8_STAGE(PG8_SB(0, 0), cB, voffB); PG8_STAGE(PG8_SB(0, 1), cB + hstep, voffB); PG8_STAGE(PG8_SA(0, 0), cA, voffA); PG8_STAGE(PG8_SA(0, 1), cA + hstep, voffA);
        if (wr == 1) PG8_BAR;
        PG8_WAIT_V(2); PG8_BAR;
    } else {
        PG8_STAGE(PG8_SB(0, 0), cB, voffB); PG8_STAGE(PG8_SA(0, 0), cA, voffA); PG8_STAGE(PG8_SB(0, 1), cB + hstep, voffB); PG8_STAGE(PG8_SA(0, 1), cA + hstep, voffA);
        if (wr == 1) PG8_BAR;
        PG8_WAIT_V(4); PG8_BAR;
    }
    PG8_STAGE(PG8_SB(1, 0), cB + kstep, voffB); PG8_STAGE(PG8_SA(1, 0), cA + kstep, voffA); PG8_STAGE(PG8_SB(1, 1), cB + hstep + kstep, voffB);
    PG8_WAIT_V(6); PG8_BAR;
    PG8_STAMP();
    for (;;) {
        const bool has_next = S.next(ui + 1, nxt);
        const char* nA = has_next ? (const char*)g.A + (size_t)nxt.pm * tstep + (size_t)nxt.pk * pstep : cA; const char* nB = has_next ? (const char*)g.Bt + (size_t)nxt.pn * tstep + (size_t)nxt.pk * pstep : cB;
        for (int t = 0; t < nt; t += 2) {
            const bool last = (t == nt - 2);
            const char* a1 = cA + (size_t)(t + 1) * kstep;
            const char* a2 = last ? nA : cA + (size_t)(t + 2) * kstep; const char* b2 = last ? nB : cB + (size_t)(t + 2) * kstep;
            const char* a3 = a2 + kstep; const char* b3 = b2 + kstep;
            if (last && has_next) S.a_ready(nxt);
            if constexpr (SP2) {
            PG8_LDB(B0, 0, 0); PG8_LDB(B1, 0, 1); PG8_SCHED; PG8_LDA(At, 0, 0); PG8_STAGE(PG8_SA(1, 1), a1 + hstep, voffA);
            PG8_WAIT_V(8); PG8_WAIT_L(0); PG8_BAR; PG8_MMA(0, 0, At, B0); PG8_MMA(0, 1, At, B1); PG8_BAR; PG8_SCHED;
            PG8_LDA(At, 0, 1); PG8_STAGE(PG8_SB(0, 0), b2, voffB); PG8_STAGE(PG8_SB(0, 1), b2 + hstep, voffB); PG8_STAGE(PG8_SA(0, 0), a2, voffA);
            PG8_WAIT_V(8); PG8_WAIT_L(0); PG8_BAR; PG8_MMA(1, 0, At, B0); PG8_MMA(1, 1, At, B1); PG8_BAR; PG8_SCHED;
            PG8_LDB(B0, 1, 0); PG8_LDB(B1, 1, 1); PG8_SCHED; PG8_LDA(At, 1, 0); PG8_STAGE(PG8_SA(0, 1), a2 + hstep, voffA);
            PG8_WAIT_V(8); PG8_WAIT_L(0); PG8_BAR; PG8_MMA(0, 0, At, B0); PG8_MMA(0, 1, At, B1); PG8_BAR; PG8_SCHED;
            PG8_LDA(At, 1, 1); PG8_STAGE(PG8_SB(1, 0), b3, voffB); PG8_STAGE(PG8_SB(1, 1), b3 + hstep, voffB); PG8_STAGE(PG8_SA(1, 0), a3, voffA);
            PG8_WAIT_V(8); PG8_WAIT_L(0); PG8_BAR; PG8_MMA(1, 0, At, B0); PG8_MMA(1, 1, At, B1); PG8_BAR; PG8_SCHED;
            } else {
            PG8_LDB(B0, 0, 0); PG8_SCHED; PG8_LDA(At, 0, 0); PG8_STAGE(PG8_SA(1, 1), a1 + hstep, voffA);
            PG8_WAIT_L(8); PG8_BAR; PG8_WAIT_L(0); PG8_MMA(0, 0, At, B0); PG8_BAR; PG8_SCHED;
            PG8_LDB(B1, 0, 1); PG8_STAGE(PG8_SB(0, 0), b2, voffB);
            PG8_BAR; PG8_WAIT_L(0); PG8_MMA(0, 1, At, B1); PG8_BAR;
            PG8_LDA(At, 0, 1); PG8_STAGE(PG8_SA(0, 0), a2, voffA);
            PG8_BAR; PG8_WAIT_L(0); PG8_MMA(1, 0, At, B0); PG8_BAR; PG8_SCHED;
            PG8_STAGE(PG8_SB(0, 1), b2 + hstep, voffB);
            PG8_WAIT_V(6); PG8_BAR; PG8_MMA(1, 1, At, B1); PG8_BAR;
            PG8_LDB(B0, 1, 0); PG8_SCHED; PG8_LDA(At, 1, 0); PG8_STAGE(PG8_SA(0, 1), a2 + hstep, voffA);
            PG8_WAIT_L(8); PG8_BAR; PG8_WAIT_L(0); PG8_MMA(0, 0, At, B0); PG8_BAR; PG8_SCHED;
            PG8_LDB(B1, 1, 1); PG8_STAGE(PG8_SB(1, 0), b3, voffB);
            PG8_BAR; PG8_WAIT_L(0); PG8_MMA(0, 1, At, B1); PG8_BAR;
            PG8_LDA(At, 1, 1); PG8_STAGE(PG8_SA(1, 0), a3, voffA);
            PG8_BAR; PG8_WAIT_L(0); PG8_MMA(1, 0, At, B0); PG8_BAR; PG8_SCHED;
            PG8_STAGE(PG8_SB(1, 1), b3 + hstep, voffB);
            PG8_WAIT_V(6); PG8_BAR; PG8_MMA(1, 1, At, B1); PG8_BAR;
            }
        }
        PG8_STAMP();
        if constexpr (ALIGN_EPI) { if (wr == 0) PG8_BAR; }
        if constexpr (!Epi::AFTER_DRAIN) { E(acc, cur, wr, wc, fr, fq); S.done(cur); }
        PG8_STAMP();
        if (!has_next) break;
#pragma unroll
        for (int a = 0; a < 2; ++a)
#pragma unroll
            for (int b = 0; b < 2; ++b)
#pragma unroll
                for (int m = 0; m < 4; ++m)
#pragma unroll
                    for (int n = 0; n < 2; ++n) acc[a][b][m][n] = (f32x4){0.f, 0.f, 0.f, 0.f};
        cur = nxt; cA = nA; cB = nB; ++ui;
        if constexpr (ALIGN_EPI) { if (wr == 1) PG8_BAR; }
    }
    PG8_WAIT_V(0);
    if constexpr (!ALIGN_EPI) { if (wr == 0) PG8_BAR; }
    PG8_BAR;
    if constexpr (Epi::AFTER_DRAIN) { E.fused(acc, cur, wr, wc, fr, fq, lds, wid, lane); S.done(cur); }
    PG8_STAMP();
    if (STAMP && wid == 0) { stamps[lane] = lane < nts ? (((unsigned long long)(unsigned)ts_hi << 32) | (unsigned)ts_lo) : 0ull;
        if (lane == 62) stamps[62] = rt_entry; if (lane == 63) stamps[63] = (unsigned long long)wall_clock64(); }
#undef PG8_STAMP
#undef PG8_SA
#undef PG8_SB
#undef PG8_STAGE
#undef PG8_LDA
#undef PG8_LDB
#undef PG8_MMA
#undef PG8_WAIT_V
#undef PG8_WAIT_L
#undef PG8_BAR
#undef PG8_SCHED
}
}

#define LAS __attribute__((address_space(3)))
typedef unsigned short bf16;
typedef _Float16 f16;
typedef pg8::f32x4 f32x4;
typedef pg8::u32x4 u32x4;
typedef pg8::bf16x8 bf16x8;
typedef unsigned u32x2 __attribute__((ext_vector_type(2)));
typedef _Float16 f16x8 __attribute__((ext_vector_type(8)));
typedef _Float16 f16x4 __attribute__((ext_vector_type(4)));

constexpr int D = 1024, NB = 8, SEQ = 4096, CTXL = 256, ML = NB * SEQ, MC = NB * CTXL, MT = ML + MC, FF = 2816, NMODC = 9 * D;
constexpr float EPS = 1e-6f;
constexpr size_t MiB = 1ull << 20;
constexpr size_t WS_WUP = 0, WS_WDN = 11 * MiB, WS_WIN = 17 * MiB, WS_WPA = 35 * MiB, WS_WPB = 37 * MiB, WS_WO = 39 * MiB, WS_MOD = 41 * MiB,
                 WS_U = 42 * MiB, WS_R = 110 * MiB, WS_BAR = 41 * MiB + 512 * 1024;
constexpr size_t R_H = WS_R, R_HC1 = WS_R + 187 * MiB;
constexpr size_t R_Q = WS_R, R_GF = WS_R + 64 * MiB, R_GB = WS_R + 132 * MiB, R_V = WS_R + 200 * MiB, R_OF = WS_R + 268 * MiB, R_OB = WS_R + 332 * MiB;
constexpr size_t R_SG = WS_R, R_GLU = WS_R + 64 * MiB, R_GATES = WS_R + 128 * MiB;
constexpr size_t WS_NEED = WS_R + 396 * MiB;
constexpr int LDS_BYTES = 131072 + 4096;

struct Params { const float* in[26]; float* out; unsigned char* ws; };
enum { I_X = 0, I_C, I_CTX, I_CCTX, I_WADA, I_BADA, I_NF1, I_W1U, I_W1D, I_NMIX, I_WIN, I_LBL, I_HGN, I_WDW, I_BDW, I_LNG, I_LNB, I_WPA, I_WPB, I_WG, I_BG, I_WO,
       I_NF2, I_W2U, I_W2D, I_FN };

__device__ __forceinline__ int tid_opaque() { int t = threadIdx.x; asm volatile("" : "+v"(t)); return t; }
__device__ __forceinline__ float bf2f(unsigned short b) { return __uint_as_float(((unsigned)b) << 16); }
__device__ __forceinline__ float bflo(unsigned w) { return __uint_as_float(w << 16); }
__device__ __forceinline__ float bfhi(unsigned w) { return __uint_as_float(w & 0xffff0000u); }
typedef __bf16 bf2_t __attribute__((ext_vector_type(2)));
__device__ __forceinline__ unsigned pk2(float lo, float hi) { bf2_t v; v.x = (__bf16)lo; v.y = (__bf16)hi; return __builtin_bit_cast(unsigned, v); }
__device__ __forceinline__ float sigmoidf_(float x) { return __builtin_amdgcn_rcpf(1.0f + __expf(-x)); }
__device__ __forceinline__ float siluf_(float x) { return x * __builtin_amdgcn_rcpf(1.0f + __expf(-x)); }
typedef float f32x2 __attribute__((ext_vector_type(2)));
__device__ __forceinline__ f32x2 sig2_(f32x2 x) { const f32x2 t = x * (-1.44269504f); f32x2 e; e.x = __builtin_amdgcn_exp2f(t.x); e.y = __builtin_amdgcn_exp2f(t.y); const f32x2 d = e + 1.0f; f32x2 r; r.x = __builtin_amdgcn_rcpf(d.x); r.y = __builtin_amdgcn_rcpf(d.y); return r; }
__device__ __forceinline__ f32x4 sig4_(f32x4 x) { const f32x2 lo = sig2_(__builtin_shufflevector(x, x, 0, 1)), hi = sig2_(__builtin_shufflevector(x, x, 2, 3)); return (f32x4){lo.x, lo.y, hi.x, hi.y}; }
__device__ __forceinline__ f32x4 silu4_(f32x4 x) { return x * sig4_(x); }
__device__ __forceinline__ u32x2 pk4(f32x4 v) { u32x2 w; w.x = pk2(v[0], v[1]); w.y = pk2(v[2], v[3]); return w; }

struct EpiSwiglu {
    static constexpr bool PERM = true, AFTER_DRAIN = false;
    bf16* H; int ldh;
    __device__ __forceinline__ void operator()(const f32x4 (&acc)[2][2][4][2], const pg8::Unit& u, int wr, int wc, int fr, int fq) const {
        const int row0 = u.pm * 256 + wr * 64 + fr, col0 = u.pn * 128 + wc * 32 + 8 * fq;
#pragma unroll
        for (int ai = 0; ai < 2; ++ai)
#pragma unroll
            for (int m = 0; m < 4; ++m) {
                bf16* rowp = H + (size_t)(row0 + ai * 128 + m * 16) * ldh + col0;
                const u32x2 w0 = pk4(silu4_(acc[ai][0][m][0]) * acc[ai][1][m][0]), w1 = pk4(silu4_(acc[ai][0][m][1]) * acc[ai][1][m][1]);
                *(u32x4*)rowp = (u32x4){w0.x, w0.y, w1.x, w1.y};
            }
    }
};

struct EpiRes {
    static constexpr bool PERM = false, AFTER_DRAIN = false;
    const float* baseL; float* outL; const float* baseC; float* outC; const float* mod; int gidx; float coef;
    __device__ __forceinline__ void operator()(const f32x4 (&acc)[2][2][4][2], const pg8::Unit& u, int wr, int wc, int fr, int fq) const {
        const bool lat = u.pm < 128;
        const int prow = (lat ? u.pm : u.pm - 128) * 256 + wr * 64 + fr;
        const float* base = lat ? baseL : baseC; float* out = lat ? outL : outC;
        const float* gate = mod + (size_t)(lat ? (u.pm >> 4) : 8) * NMODC + gidx * D;
        const int col0 = u.pn * 256 + wc * 32 + 4 * fq;
        f32x4 gv[2][2];
#pragma unroll
        for (int bj = 0; bj < 2; ++bj)
#pragma unroll
            for (int n = 0; n < 2; ++n) gv[bj][n] = *(const f32x4*)(gate + col0 + bj * 128 + n * 16) * coef;
#pragma unroll
        for (int ai = 0; ai < 2; ++ai)
#pragma unroll
            for (int m = 0; m < 4; ++m) {
                const size_t off = (size_t)(prow + ai * 128 + m * 16) * D + col0;
#pragma unroll
                for (int bj = 0; bj < 2; ++bj)
#pragma unroll
                    for (int n = 0; n < 2; ++n) {
                        const f32x4 bs = *(const f32x4*)(base + off + bj * 128 + n * 16);
                        *(f32x4*)(out + off + bj * 128 + n * 16) = bs + gv[bj][n] * acc[ai][bj][m][n];
                    }
            }
    }
};


struct EpiDelta {
    static constexpr bool PERM = true, AFTER_DRAIN = false;
    bf16* delta; const float* mod; int gidx; float coef;
    __device__ __forceinline__ void operator()(const f32x4 (&acc)[2][2][4][2], const pg8::Unit& u, int wr, int wc, int fr, int fq) const {
        const int row0 = u.pm * 256 + wr * 64 + fr, col0 = u.pn * 256 + wc * 32 + 8 * fq;
        const float* gate = mod + (size_t)(u.pm >> 4) * NMODC + gidx * D;
#pragma unroll
        for (int bj = 0; bj < 2; ++bj) {
            const f32x4 g0 = *(const f32x4*)(gate + col0 + bj * 128) * coef, g1 = *(const f32x4*)(gate + col0 + bj * 128 + 4) * coef;
#pragma unroll
            for (int ai = 0; ai < 2; ++ai)
#pragma unroll
                for (int m = 0; m < 4; ++m) {
                    const u32x2 w0 = pk4(acc[ai][bj][m][0] * g0), w1 = pk4(acc[ai][bj][m][1] * g1);
                    *(u32x4*)(delta + (size_t)(row0 + ai * 128 + m * 16) * D + col0 + bj * 128) = (u32x4){w0.x, w0.y, w1.x, w1.y};
                }
        }
    }
};

struct EpiMix1 {
    static constexpr bool PERM = true, AFTER_DRAIN = false;
    bf16* Q; f16* GF; f16* GB; bf16* V; const float* lbf; const float* lbb;
    __device__ __forceinline__ void operator()(const f32x4 (&acc)[2][2][4][2], const pg8::Unit& u, int wr, int wc, int fr, int fq) const {
        const int seg = u.pn >> 2;
        const int row0 = u.pm * 256 + wr * 64 + fr, col0 = (u.pn & 3) * 256 + wc * 32 + 8 * fq;
        if (seg == 0) {
            if (u.pm >= 128) return;
#pragma unroll
            for (int ai = 0; ai < 2; ++ai)
#pragma unroll
                for (int m = 0; m < 4; ++m)
#pragma unroll
                    for (int bj = 0; bj < 2; ++bj) {
                        const f32x4 a = acc[ai][bj][m][0], b = acc[ai][bj][m][1];
                        const u32x2 w0 = pk4(silu4_(a)), w1 = pk4(silu4_(b)); const u32x4 w = (u32x4){w0.x, w0.y, w1.x, w1.y};
                        *(u32x4*)(Q + (size_t)(row0 + ai * 128 + m * 16) * D + col0 + bj * 128) = w;
                    }
        } else if (seg == 3) {
#pragma unroll
            for (int ai = 0; ai < 2; ++ai)
#pragma unroll
                for (int m = 0; m < 4; ++m)
#pragma unroll
                    for (int bj = 0; bj < 2; ++bj) {
                        const f32x4 a = acc[ai][bj][m][0], b = acc[ai][bj][m][1];
                        u32x4 w; w.x = pk2(a[0], a[1]); w.y = pk2(a[2], a[3]); w.z = pk2(b[0], b[1]); w.w = pk2(b[2], b[3]);
                        *(u32x4*)(V + (size_t)(row0 + ai * 128 + m * 16) * D + col0 + bj * 128) = w;
                    }
        } else {
            const float* lb = (seg == 1) ? lbf : lbb; f16* G = (seg == 1) ? GF : GB;
#pragma unroll
            for (int bj = 0; bj < 2; ++bj) {
                const f32x4 l0 = *(const f32x4*)(lb + col0 + bj * 128), l1 = *(const f32x4*)(lb + col0 + bj * 128 + 4);
#pragma unroll
                for (int ai = 0; ai < 2; ++ai)
#pragma unroll
                    for (int m = 0; m < 4; ++m) {
                        const f32x4 a = acc[ai][bj][m][0], b = acc[ai][bj][m][1];
                        f16x8 w;
                        const f32x4 fa = l0 + (1.0f - l0) * sig4_(a), fb = l1 + (1.0f - l1) * sig4_(b);
#pragma unroll
                        for (int j = 0; j < 4; ++j) { w[j] = (f16)__builtin_amdgcn_logf(fa[j]); w[4 + j] = (f16)__builtin_amdgcn_logf(fb[j]); }
                        *(f16x8*)(G + (size_t)(row0 + ai * 128 + m * 16) * D + col0 + bj * 128) = w;
                    }
            }
        }
    }
};

struct EpiMix2 {
    static constexpr bool PERM = true, AFTER_DRAIN = false;
    bf16* SG; bf16* GLU; bf16* GATES; const float* bgate;
    __device__ __forceinline__ void operator()(const f32x4 (&acc)[2][2][4][2], const pg8::Unit& u, int wr, int wc, int fr, int fq) const {
        const int row0 = u.pm * 256 + wr * 64 + fr, cw = wc * 32 + 8 * fq;
        if (u.pn < 4) {
#pragma unroll
            for (int ai = 0; ai < 2; ++ai)
#pragma unroll
                for (int m = 0; m < 4; ++m)
#pragma unroll
                    for (int bj = 0; bj < 2; ++bj) {
                        const f32x4 a = acc[ai][bj][m][0], b = acc[ai][bj][m][1];
                        const u32x2 w0 = pk4(silu4_(a)), w1 = pk4(silu4_(b)); const u32x4 w = (u32x4){w0.x, w0.y, w1.x, w1.y};
                        *(u32x4*)(SG + (size_t)(row0 + ai * 128 + m * 16) * D + u.pn * 256 + bj * 128 + cw) = w;
                    }
        } else if (u.pn < 12) {
            const int c0 = (u.pn - 4) * 128 + cw;
#pragma unroll
            for (int ai = 0; ai < 2; ++ai)
#pragma unroll
                for (int m = 0; m < 4; ++m) {
                    const u32x2 w0 = pk4(acc[ai][0][m][0] * sig4_(acc[ai][1][m][0])), w1 = pk4(acc[ai][0][m][1] * sig4_(acc[ai][1][m][1])); const u32x4 w = (u32x4){w0.x, w0.y, w1.x, w1.y};
                    *(u32x4*)(GLU + (size_t)(row0 + ai * 128 + m * 16) * D + c0) = w;
                }
        } else {
            const int c0 = (u.pn - 12) * 256 + cw;
#pragma unroll
            for (int bj = 0; bj < 2; ++bj) {
                const f32x4 b0 = *(const f32x4*)(bgate + c0 + bj * 128), b1 = *(const f32x4*)(bgate + c0 + bj * 128 + 4);
#pragma unroll
                for (int ai = 0; ai < 2; ++ai)
#pragma unroll
                    for (int m = 0; m < 4; ++m) {
                        const f32x4 a = acc[ai][bj][m][0] + b0, b = acc[ai][bj][m][1] + b1;
                        const u32x2 w0 = pk4(sig4_(a)), w1 = pk4(sig4_(b)); const u32x4 w = (u32x4){w0.x, w0.y, w1.x, w1.y};
                        *(u32x4*)(GATES + (size_t)(row0 + ai * 128 + m * 16) * 2048 + c0 + bj * 128) = w;
                    }
            }
        }
    }
};

template <int ADD> struct EpiGate {
    static constexpr bool PERM = true, AFTER_DRAIN = false;
    const bf16* GATES; bf16* T; int goff;
    __device__ __forceinline__ void operator()(const f32x4 (&acc)[2][2][4][2], const pg8::Unit& u, int wr, int wc, int fr, int fq) const {
        const int row0 = u.pm * 256 + wr * 64 + fr, col0 = u.pn * 256 + wc * 32 + 8 * fq;
#pragma unroll
        for (int ai = 0; ai < 2; ++ai)
#pragma unroll
            for (int m = 0; m < 4; ++m)
#pragma unroll
                for (int bj = 0; bj < 2; ++bj) {
                    const size_t r = (size_t)(row0 + ai * 128 + m * 16);
                    const u32x4 g = *(const u32x4*)(GATES + r * 2048 + goff + col0 + bj * 128);
                    bf16* tp = T + r * D + col0 + bj * 128;
                    const f32x4 a = acc[ai][bj][m][0], b = acc[ai][bj][m][1];
                    float o[8];
                    o[0] = bflo(g.x) * a[0]; o[1] = bfhi(g.x) * a[1]; o[2] = bflo(g.y) * a[2]; o[3] = bfhi(g.y) * a[3];
                    o[4] = bflo(g.z) * b[0]; o[5] = bfhi(g.z) * b[1]; o[6] = bflo(g.w) * b[2]; o[7] = bfhi(g.w) * b[3];
                    if (ADD) { const u32x4 t = *(const u32x4*)tp;
                        o[0] += bflo(t.x); o[1] += bfhi(t.x); o[2] += bflo(t.y); o[3] += bfhi(t.y); o[4] += bflo(t.z); o[5] += bfhi(t.z); o[6] += bflo(t.w); o[7] += bfhi(t.w); }
                    u32x4 w; w.x = pk2(o[0], o[1]); w.y = pk2(o[2], o[3]); w.z = pk2(o[4], o[5]); w.w = pk2(o[6], o[7]);
                    *(u32x4*)tp = w;
                }
    }
};


struct KSplitOrder {
    int G, c;
    __device__ bool next(int i, pg8::Unit& u) const { const int L = i * G + c; if (L >= 352) return false; u.pk = L >> 5; u.pm = 128 + ((L & 31) >> 2); u.pn = L & 3; return true; }
    __device__ __forceinline__ void a_ready(const pg8::Unit&) const {}
    __device__ __forceinline__ void done(const pg8::Unit&) const {}
};
struct EpiPart {
    static constexpr bool PERM = false, AFTER_DRAIN = false;
    float* part;
    __device__ __forceinline__ void operator()(const f32x4 (&acc)[2][2][4][2], const pg8::Unit& u, int wr, int wc, int fr, int fq) const {
        const int prow = (u.pm - 128) * 256 + wr * 64 + fr, col0 = u.pn * 256 + wc * 32 + 4 * fq;
        float* base = part + ((size_t)u.pk * MC + prow) * D + col0;
#pragma unroll
        for (int ai = 0; ai < 2; ++ai)
#pragma unroll
            for (int m = 0; m < 4; ++m)
#pragma unroll
                for (int bj = 0; bj < 2; ++bj)
#pragma unroll
                    for (int n = 0; n < 2; ++n) *(f32x4*)(base + (size_t)(ai * 128 + m * 16) * D + bj * 128 + n * 16) = acc[ai][bj][m][n];
    }
};

__device__ __forceinline__ void conv_tile(LAS unsigned char* lds, const float* src, int srcN, int k0, int n0, bf16* dst, int dstK, int drow0) {
    LAS float* T = (LAS float*)lds;
    const int tid = tid_opaque();
#pragma unroll
    for (int i = 0; i < 4; ++i) {
        const int kk = (tid >> 5) + 16 * i, n4 = tid & 31;
        const f32x4 v = *(const f32x4*)(src + (size_t)(k0 + kk) * srcN + n0 + 4 * n4);
#pragma unroll
        for (int j = 0; j < 4; ++j) T[kk * 129 + 4 * n4 + j] = v[j];
    }
    __syncthreads();
    {
        const int nn = tid >> 2, kq = tid & 3;
        float f[16];
#pragma unroll
        for (int j = 0; j < 16; ++j) f[j] = T[(16 * kq + j) * 129 + nn];
        u32x4 w0, w1;
        w0.x = pk2(f[0], f[1]); w0.y = pk2(f[2], f[3]); w0.z = pk2(f[4], f[5]); w0.w = pk2(f[6], f[7]);
        w1.x = pk2(f[8], f[9]); w1.y = pk2(f[10], f[11]); w1.z = pk2(f[12], f[13]); w1.w = pk2(f[14], f[15]);
        bf16* dp = dst + (size_t)(drow0 + nn) * dstK + k0 + 16 * kq;
        *(u32x4*)dp = w0; *(u32x4*)(dp + 8) = w1;
    }
    __syncthreads();
}
__device__ __forceinline__ void conv_job_item(LAS unsigned char* lds, int it, const float* src, int K, int N, bf16* dst, int roff, int pair_from, int NH) {
    const int nt = N / 128; const int kt = it / nt, ntile = it % nt; const int n0 = ntile * 128;
    int drow0;
    if (pair_from < 0 || n0 < pair_from) drow0 = roff + n0;
    else { const int n1 = n0 - pair_from; drow0 = roff + pair_from + ((n1 < NH) ? 256 * (n1 / 128) : 256 * ((n1 - NH) / 128) + 128); }
    conv_tile(lds, src, N, kt * 64, n0, dst, K, drow0);
}

template <bool MODU, bool OUT_BF16, bool CPART = false, bool ADDD = false>
__device__ __forceinline__ void normmod_phase(const float* srcL, const float* srcC, int nrows, const float* gain, const float* mod, int ishift, int iscale, bf16* ub, float* of, const float* part = nullptr, int igate = 0, const bf16* dlt = nullptr) {
    const int tido = tid_opaque(); const int lane = tido & 63, wv = tido >> 6;
    f32x4 gn[4];
#pragma unroll
    for (int j = 0; j < 4; ++j) gn[j] = *(const f32x4*)(gain + 256 * j + 4 * lane);
    for (int row = blockIdx.x * 8 + wv; row < nrows; row += gridDim.x * 8) {
        const float* src = (row < ML) ? srcL + (size_t)row * D : srcC + (size_t)(row - ML) * D;
        f32x4 x[4]; float ss = 0.f;
#pragma unroll
        for (int j = 0; j < 4; ++j) {
            x[j] = *(const f32x4*)(src + 256 * j + 4 * lane);
            if constexpr (ADDD) { const u32x2 t = *(const u32x2*)(dlt + (size_t)row * D + 256 * j + 4 * lane); x[j] += (f32x4){bflo(t.x), bfhi(t.x), bflo(t.y), bfhi(t.y)}; }
            if constexpr (CPART) { if (row >= ML) {
                f32x4 sp = *(const f32x4*)(part + (size_t)(row - ML) * D + 256 * j + 4 * lane);
#pragma unroll
                for (int pk = 1; pk < 11; ++pk) sp += *(const f32x4*)(part + ((size_t)pk * MC + (row - ML)) * D + 256 * j + 4 * lane);
                x[j] += sp * (*(const f32x4*)(mod + (size_t)8 * NMODC + igate * D + 256 * j + 4 * lane) * 0.5f); } }
            ss += x[j][0] * x[j][0] + x[j][1] * x[j][1] + x[j][2] * x[j][2] + x[j][3] * x[j][3]; }
#pragma unroll
        for (int o = 32; o >= 1; o >>= 1) ss += __shfl_xor(ss, o);
        const float rinv = rsqrtf(ss * (1.0f / D) + EPS);
        const int mrow = (row < ML) ? (row >> 12) : 8;
#pragma unroll
        for (int j = 0; j < 4; ++j) {
            f32x4 y = x[j] * rinv * gn[j];
            if constexpr (MODU) { const f32x4 sh = *(const f32x4*)(mod + (size_t)mrow * NMODC + ishift * D + 256 * j + 4 * lane), sc = *(const f32x4*)(mod + (size_t)mrow * NMODC + iscale * D + 256 * j + 4 * lane);
                y = y * (sc + 1.0f) + sh; }
            if constexpr (OUT_BF16) { u32x2 w; w.x = pk2(y[0], y[1]); w.y = pk2(y[2], y[3]); *(u32x2*)(ub + (size_t)row * D + 256 * j + 4 * lane) = w; }
            else *(f32x4*)(of + (size_t)row * D + 256 * j + 4 * lane) = y;
        }
    }
}

__device__ __forceinline__ void adaln_item(LAS unsigned char* lds, int item, const float* wada, const float* bada, float* MOD) {
    LAS float* SC = (LAS float*)lds;
    LAS float* RED = (LAS float*)(lds + 36864);
    const int tid = threadIdx.x, col = tid & 63, kg = tid >> 6, n0 = item * 64;
    float acc[9];
#pragma unroll
    for (int r = 0; r < 9; ++r) acc[r] = 0.f;
    for (int k = kg * 128; k < kg * 128 + 128; ++k) {
        const float w = wada[(size_t)k * NMODC + n0 + col];
#pragma unroll
        for (int r = 0; r < 9; ++r) acc[r] += SC[r * 1024 + k] * w;
    }
#pragma unroll
    for (int r = 0; r < 9; ++r) RED[(kg * 9 + r) * 64 + col] = acc[r];
    __syncthreads();
    for (int idx = tid; idx < 576; idx += 512) {
        const int r = idx >> 6, c = idx & 63; float s = bada[n0 + c];
#pragma unroll
        for (int g = 0; g < 8; ++g) s += RED[(g * 9 + r) * 64 + c];
        MOD[(size_t)r * NMODC + n0 + c] = s;
    }
    __syncthreads();
}

__device__ __forceinline__ void aop_rows(int row_begin, int row_end, int row_step, bf16* OF, const bf16* OB, const bf16* SG, const float* hgn) {
    const int lane = tid_opaque() & 63;
    float gn[16];
#pragma unroll
    for (int j = 0; j < 4; ++j) { const f32x4 t = *(const f32x4*)(hgn + (lane & 7) * 16 + 4 * j); gn[4 * j] = t[0]; gn[4 * j + 1] = t[1]; gn[4 * j + 2] = t[2]; gn[4 * j + 3] = t[3]; }
    for (int row = row_begin; row < row_end; row += row_step) {
        const size_t off = (size_t)row * D + 16 * lane;
        const u32x4 f0 = *(const u32x4*)(OF + off), f1 = *(const u32x4*)(OF + off + 8);
        const u32x4 b0 = *(const u32x4*)(OB + off), b1 = *(const u32x4*)(OB + off + 8);
        const u32x4 s0 = *(const u32x4*)(SG + off), s1 = *(const u32x4*)(SG + off + 8);
        float o[16], sg[16];
#pragma unroll
        for (int j = 0; j < 4; ++j) {
            o[2 * j] = bflo(f0[j]) + bflo(b0[j]); o[2 * j + 1] = bfhi(f0[j]) + bfhi(b0[j]);
            o[8 + 2 * j] = bflo(f1[j]) + bflo(b1[j]); o[8 + 2 * j + 1] = bfhi(f1[j]) + bfhi(b1[j]);
            sg[2 * j] = bflo(s0[j]); sg[2 * j + 1] = bfhi(s0[j]); sg[8 + 2 * j] = bflo(s1[j]); sg[8 + 2 * j + 1] = bfhi(s1[j]);
        }
        float ss = 0.f;
#pragma unroll
        for (int j = 0; j < 16; ++j) ss += o[j] * o[j];
        ss += __shfl_xor(ss, 1); ss += __shfl_xor(ss, 2); ss += __shfl_xor(ss, 4);
        const float rinv = rsqrtf(ss * (1.0f / 128.0f) + EPS);
        float a[16];
#pragma unroll
        for (int j = 0; j < 16; ++j) a[j] = o[j] * rinv * gn[j] * sg[j];
        u32x4 w0, w1;
        w0.x = pk2(a[0], a[1]); w0.y = pk2(a[2], a[3]); w0.z = pk2(a[4], a[5]); w0.w = pk2(a[6], a[7]);
        w1.x = pk2(a[8], a[9]); w1.y = pk2(a[10], a[11]); w1.z = pk2(a[12], a[13]); w1.w = pk2(a[14], a[15]);
        *(u32x4*)(OF + off) = w0; *(u32x4*)(OF + off + 8) = w1;
    }
}

__device__ __forceinline__ void conv_items(LAS unsigned char* lds, int item_begin, int item_end, int item_step, const bf16* GLU, const float* wdw, const float* bdw, const float* lng, const float* lnb, bf16* BOP) {
    constexpr int TT = 16;
    LAS float* P1 = (LAS float*)lds;
    LAS float* P2 = (LAS float*)(lds + 65536);
    LAS float* ST = (LAS float*)(lds + 131072);
    const int tid = tid_opaque(), c = 2 * tid;
    float w[31][2];
#pragma unroll
    for (int j = 0; j < 31; ++j) { w[j][0] = wdw[j * D + c]; w[j][1] = wdw[j * D + c + 1]; }
    const float bd0 = bdw[c], bd1 = bdw[c + 1], g0 = lng[c], g1 = lng[c + 1], b0 = lnb[c], b1 = lnb[c + 1];
    for (int item = item_begin; item < item_end; item += item_step) {
        const int b = item / (SEQ / TT), t0 = (item % (SEQ / TT)) * TT;
        float y[TT][2];
        unsigned xw[TT + 30];
#pragma unroll
        for (int r = 0; r < TT + 30; ++r) {
            const int pos = t0 - 15 + r;
            xw[r] = 0u;
            if (pos >= 0 && pos < SEQ) xw[r] = *(const unsigned*)(GLU + (size_t)(b * SEQ + pos) * D + c);
        }
        typedef float f32x2_t __attribute__((ext_vector_type(2)));
        f32x2_t xf[TT + 30];
#pragma unroll
        for (int r = 0; r < TT + 30; ++r) { xf[r].x = bflo(xw[r]); xf[r].y = bfhi(xw[r]); }
#pragma unroll
        for (int t = 0; t < TT; ++t) {
            f32x2_t a2; a2.x = bd0; a2.y = bd1;
#pragma unroll
            for (int j = 0; j < 31; ++j) { f32x2_t w2; w2.x = w[j][0]; w2.y = w[j][1]; a2 = __builtin_elementwise_fma(xf[t + j], w2, a2); }
            y[t][0] = a2.x; y[t][1] = a2.y;
        }
#pragma unroll
        for (int t = 0; t < TT; ++t) { P1[t * 512 + tid] = y[t][0] + y[t][1]; P2[t * 512 + tid] = y[t][0] * y[t][0] + y[t][1] * y[t][1]; }
        __syncthreads();
        {
            const int t = tid >> 5, part = tid & 31; float s = 0.f, q = 0.f;
#pragma unroll
            for (int j = 0; j < 4; ++j) { const f32x4 a = *(const LAS f32x4*)(P1 + t * 512 + part * 16 + 4 * j), bq = *(const LAS f32x4*)(P2 + t * 512 + part * 16 + 4 * j);
                s += (a[0] + a[1]) + (a[2] + a[3]); q += (bq[0] + bq[1]) + (bq[2] + bq[3]); }
#pragma unroll
            for (int o = 16; o >= 1; o >>= 1) { s += __shfl_xor(s, o); q += __shfl_xor(q, o); }
            if (part == 0) { const float mean = s * (1.0f / D); const float var = fmaxf(q * (1.0f / D) - mean * mean, 0.f); ST[2 * t] = mean; ST[2 * t + 1] = rsqrtf(var + EPS); }
        }
        __syncthreads();
#pragma unroll
        for (int t = 0; t < TT; ++t) {
            const float mean = ST[2 * t], rstd = ST[2 * t + 1];
            const float v0 = (y[t][0] - mean) * rstd * g0 + b0, v1 = (y[t][1] - mean) * rstd * g1 + b1;
            *(unsigned*)(BOP + (size_t)(b * SEQ + t0 + t) * D + c) = pk2(siluf_(v0), siluf_(v1));
        }
        __syncthreads();
    }
}

__device__ __forceinline__ size_t scan_rowbase(int ci, int t, int dir, int b) {
    const bool ctx = ci < 8; const int lc = ctx ? ci : ci - 8, nch = ctx ? 8 : 128;
    const int p0 = dir ? (nch - 1 - lc) * 32 : lc * 32; const int pos = dir ? p0 + 31 - t : p0 + t;
    return ctx ? (size_t)(ML + b * CTXL + pos) : (size_t)(b * SEQ + pos);
}
constexpr int S2_QS = 0, S2_KS = 26112, S2_KET = 43520, S2_VT = 74240, S2_DEC = 89600, S2_AS = 91136, S2_ST = 96256;
constexpr int QROW = 272, SROW = 80;
struct ScanRegs { u32x4 q, g, v; };
struct ScanCtx { const bf16* Q; const f16* G; const bf16* V; bf16* O; int b, h, dvh, dir, w, lane, l15, q4, tau, cg; };

__device__ __forceinline__ void scan_issue(const ScanCtx& c, int ci, ScanRegs& r) {
    const size_t row = scan_rowbase(ci, c.tau, c.dir, c.b);
    const size_t qrow = (ci >= 8) ? row : (size_t)(c.b * SEQ + c.tau);
    const int d0 = 16 * c.w + 8 * c.cg;
    r.g = *(const u32x4*)(c.G + row * D + c.h * 128 + d0);
    r.q = *(const u32x4*)(c.Q + qrow * D + c.h * 128 + d0);
    r.v = *(const u32x4*)(c.V + row * D + c.h * 128 + c.dvh * 64 + 8 * c.w);
}
template <int CTRL, int ROWMASK> __device__ __forceinline__ float dpp_mul_(float x) {
    const int y = __builtin_amdgcn_update_dpp(0x3f800000, __float_as_int(x), CTRL, ROWMASK, 0xF, false);
    return x * __int_as_float(y);
}
__device__ __forceinline__ void scan_E(LAS unsigned char* lds, const ScanCtx& c, int ci, const ScanRegs& r) {
    const bool lat = ci >= 8; const int s3 = ci % 3, s2 = ci & 1; const int tau = c.tau, d0 = 16 * c.w + 8 * c.cg;
    float f[8], P[8];
    { const f16x8 gh = __builtin_bit_cast(f16x8, r.g);
#pragma unroll
      for (int j = 0; j < 8; ++j) { P[j] = __builtin_amdgcn_exp2f((float)gh[j]); f[j] = 1.0f - P[j]; } }
#define DPP8(ctrl) "v_mul_f32_dpp %0, %0, %0 " ctrl "\n\tv_mul_f32_dpp %1, %1, %1 " ctrl "\n\tv_mul_f32_dpp %2, %2, %2 " ctrl "\n\tv_mul_f32_dpp %3, %3, %3 " ctrl "\n\t" \
                   "v_mul_f32_dpp %4, %4, %4 " ctrl "\n\tv_mul_f32_dpp %5, %5, %5 " ctrl "\n\tv_mul_f32_dpp %6, %6, %6 " ctrl "\n\tv_mul_f32_dpp %7, %7, %7 " ctrl "\n\t"
    asm volatile("s_nop 1\n\t"
                 DPP8("row_shr:1 row_mask:0xf bank_mask:0xf") DPP8("row_shr:2 row_mask:0xf bank_mask:0xf") DPP8("row_shr:4 row_mask:0xf bank_mask:0xf")
                 DPP8("row_shr:8 row_mask:0xf bank_mask:0xf") DPP8("row_bcast:15 row_mask:0xa bank_mask:0xf") "s_nop 1"
                 : "+v"(P[0]), "+v"(P[1]), "+v"(P[2]), "+v"(P[3]), "+v"(P[4]), "+v"(P[5]), "+v"(P[6]), "+v"(P[7]));
#undef DPP8
    float kt[8], qg[8];
    const unsigned qw[4] = {r.q.x, r.q.y, r.q.z, r.q.w};
#pragma unroll
    for (int j = 0; j < 8; ++j) {
        const float k = f[j];
        float pc; asm("v_max_f32 %0, %1, %2" : "=v"(pc) : "v"(P[j]), "v"(1e-30f));
        kt[j] = k * __builtin_amdgcn_rcpf(pc);
        const float qv = (j & 1) ? bfhi(qw[j >> 1]) : bflo(qw[j >> 1]);
        qg[j] = qv * P[j];
    }
    u32x4 wk; wk.x = pk2(kt[0], kt[1]); wk.y = pk2(kt[2], kt[3]); wk.z = pk2(kt[4], kt[5]); wk.w = pk2(kt[6], kt[7]);
    *(LAS u32x4*)(lds + S2_KS + s2 * 8704 + tau * QROW + d0 * 2) = wk;
    if (lat) { u32x4 wq; wq.x = pk2(qg[0], qg[1]); wq.y = pk2(qg[2], qg[3]); wq.z = pk2(qg[4], qg[5]); wq.w = pk2(qg[6], qg[7]);
        *(LAS u32x4*)(lds + S2_QS + s3 * 8704 + tau * QROW + d0 * 2) = wq; }
    { const unsigned kw[4] = {wk.x, wk.y, wk.z, wk.w};
#pragma unroll
      for (int j = 0; j < 4; ++j) {
        *(LAS unsigned short*)(lds + S2_KET + s3 * 10240 + (d0 + 2 * j) * SROW + tau * 2) = (unsigned short)(kw[j] & 0xffffu);
        *(LAS unsigned short*)(lds + S2_KET + s3 * 10240 + (d0 + 2 * j + 1) * SROW + tau * 2) = (unsigned short)(kw[j] >> 16); } }
    if (tau == 31) { LAS float* DC = (LAS float*)(lds + S2_DEC + s3 * 512);
        *(LAS f32x4*)(DC + d0) = (f32x4){P[0], P[1], P[2], P[3]};
        *(LAS f32x4*)(DC + d0 + 4) = (f32x4){P[4], P[5], P[6], P[7]}; }
    if (c.lane < 32) { const unsigned vw[4] = {r.v.x, r.v.y, r.v.z, r.v.w};
#pragma unroll
        for (int j = 0; j < 4; ++j) {
            *(LAS unsigned short*)(lds + S2_VT + s3 * 5120 + (8 * c.w + 2 * j) * SROW + tau * 2) = (unsigned short)(vw[j] & 0xffffu);
            *(LAS unsigned short*)(lds + S2_VT + s3 * 5120 + (8 * c.w + 2 * j + 1) * SROW + tau * 2) = (unsigned short)(vw[j] >> 16); } }
}
__device__ __forceinline__ void scan_A(LAS unsigned char* lds, const ScanCtx& c, int ci) {
    if (c.w >= 3) return;
    const int s3 = ci % 3, s2 = ci & 1; const int l15 = c.l15, q4 = c.q4;
    const LAS unsigned char* QS = lds + S2_QS + s3 * 8704; const LAS unsigned char* KS = lds + S2_KS + s2 * 8704;
    const int ti = (c.w == 0) ? 0 : 1, sj = (c.w == 2) ? 1 : 0;
    f32x4 a4 = (f32x4){0.f, 0.f, 0.f, 0.f};
#pragma unroll
    for (int kk = 0; kk < 4; ++kk) {
        const bf16x8 xa = *(const LAS bf16x8*)(KS + (sj * 16 + l15) * QROW + kk * 64 + q4 * 16);
        const bf16x8 yb = *(const LAS bf16x8*)(QS + (ti * 16 + l15) * QROW + kk * 64 + q4 * 16);
        a4 = __builtin_amdgcn_mfma_f32_16x16x32_bf16(xa, yb, a4, 0, 0, 0);
    }
    const int t = ti * 16 + l15, s0 = sj * 16 + 4 * q4;
    const float m0 = (s0 <= t) ? a4[0] : 0.f, m1 = (s0 + 1 <= t) ? a4[1] : 0.f, m2 = (s0 + 2 <= t) ? a4[2] : 0.f, m3 = (s0 + 3 <= t) ? a4[3] : 0.f;
    u32x2 wa; wa.x = pk2(m0, m1); wa.y = pk2(m2, m3);
    *(LAS u32x2*)(lds + S2_AS + s2 * 2560 + t * SROW + s0 * 2) = wa;
}
__device__ __forceinline__ void scan_M(LAS unsigned char* lds, const ScanCtx& c, int ci, f32x4 (&accS)[4]) {
    const bool lat = ci >= 8; const int s3 = ci % 3, s2 = ci & 1; const int l15 = c.l15, q4 = c.q4, w = c.w;
    const LAS unsigned char* QS = lds + S2_QS + s3 * 8704; const LAS unsigned char* KET = lds + S2_KET + s3 * 10240; const LAS unsigned char* VT = lds + S2_VT + s3 * 5120;
    const LAS unsigned char* STr = lds + S2_ST + s2 * 17408; LAS unsigned char* STw = lds + S2_ST + (s2 ^ 1) * 17408;
    const int tt = w >> 2, et = w & 3;
    if (lat) {
        f32x4 acco = (f32x4){0.f, 0.f, 0.f, 0.f};
#pragma unroll
        for (int kk = 0; kk < 4; ++kk) {
            const bf16x8 xa = *(const LAS bf16x8*)(STr + (et * 16 + l15) * QROW + kk * 64 + q4 * 16);
            const bf16x8 yb = *(const LAS bf16x8*)(QS + (tt * 16 + l15) * QROW + kk * 64 + q4 * 16);
            acco = __builtin_amdgcn_mfma_f32_16x16x32_bf16(xa, yb, acco, 0, 0, 0);
        }
        {
            const bf16x8 xa = *(const LAS bf16x8*)(VT + (et * 16 + l15) * SROW + q4 * 16);
            const bf16x8 yb = *(const LAS bf16x8*)(lds + S2_AS + s2 * 2560 + (tt * 16 + l15) * SROW + q4 * 16);
            acco = __builtin_amdgcn_mfma_f32_16x16x32_bf16(xa, yb, acco, 0, 0, 0);
        }
        const size_t r = scan_rowbase(ci, tt * 16 + l15, c.dir, c.b);
        u32x2 wo; wo.x = pk2(acco[0], acco[1]); wo.y = pk2(acco[2], acco[3]);
        { bf16* op = c.O + r * D + c.h * 128 + c.dvh * 64 + et * 16 + 4 * q4;
          asm volatile("global_store_dwordx2 %0, %1, off" :: "v"(op), "v"(wo) : "memory"); }
    }
    {
        const f32x4 dc = *(const LAS f32x4*)(lds + S2_DEC + s3 * 512 + (16 * w + 4 * q4) * 4);
        const bf16x8 xa = *(const LAS bf16x8*)(KET + (16 * w + l15) * SROW + q4 * 16);
#pragma unroll
        for (int i = 0; i < 4; ++i) {
            const bf16x8 yb = *(const LAS bf16x8*)(VT + (16 * i + l15) * SROW + q4 * 16);
            accS[i] = __builtin_amdgcn_mfma_f32_16x16x32_bf16(xa, yb, accS[i], 0, 0, 0) * dc;
        }
#pragma unroll
        for (int i = 0; i < 4; ++i) {
            u32x2 ws_; ws_.x = pk2(accS[i][0], accS[i][1]); ws_.y = pk2(accS[i][2], accS[i][3]);
            *(LAS u32x2*)(STw + (16 * i + l15) * QROW + (16 * w + 4 * q4) * 2) = ws_;
        }
    }
}
__device__ __forceinline__ void scan_item(LAS unsigned char* lds, int item, const bf16* Q, const f16* GF, const f16* GB, const bf16* V, bf16* OF, bf16* OB) {
    const int tid = tid_opaque(), lane = tid & 63;
    ScanCtx c;
    c.dvh = item & 1; c.dir = (item >> 1) & 1; c.h = (item >> 2) & 7; c.b = item >> 5;
    c.Q = Q; c.G = c.dir ? GB : GF; c.V = V; c.O = c.dir ? OB : OF;
    c.w = __builtin_amdgcn_readfirstlane(tid >> 6); c.lane = lane; c.l15 = lane & 15; c.q4 = lane >> 4; c.tau = lane & 31; c.cg = lane >> 5;
    for (int i = tid; i < (5120 + 34816) / 4; i += 512) ((LAS unsigned*)(lds + S2_AS))[i] = 0u;
    f32x4 accS[4];
#pragma unroll
    for (int i = 0; i < 4; ++i) accS[i] = (f32x4){0.f, 0.f, 0.f, 0.f};
    ScanRegs r0, r1, r2, r3;
    r0.q = r1.q = r2.q = r3.q = (u32x4){0u, 0u, 0u, 0u}; r0.v = r1.v = r2.v = r3.v = (u32x4){0u, 0u, 0u, 0u};
    scan_issue(c, 0, r0); scan_issue(c, 1, r1); scan_issue(c, 2, r2); scan_issue(c, 3, r3);
    __syncthreads();
#define SCAN_STEP(T_, R_) do { const int T = (T_); \
        __builtin_amdgcn_s_setprio(2); if (T >= 2) scan_M(lds, c, T - 2, accS); __builtin_amdgcn_s_setprio(0); \
        if (T >= 9) scan_A(lds, c, T - 1); \
        scan_E(lds, c, T, R_); { const int nx = (T + 4 < 136) ? T + 4 : 135; scan_issue(c, nx, R_); } \
        __syncthreads(); } while (0)
    for (int T0 = 0; T0 < 136; T0 += 4) { SCAN_STEP(T0, r0); SCAN_STEP(T0 + 1, r1); SCAN_STEP(T0 + 2, r2); SCAN_STEP(T0 + 3, r3); }
    scan_M(lds, c, 134, accS); scan_A(lds, c, 135); __syncthreads();
    scan_M(lds, c, 135, accS); __syncthreads();
    asm volatile("s_waitcnt vmcnt(0)" ::: "memory");
#undef SCAN_STEP
}

#define XB_TMO      128
#define XB_XCNT(j)  (256  + 64 * (j))
#define XB_XSUB(j)  (1280 + 64 * (j))
#define XB_XGEN(j)  (2304 + 64 * (j))
#define XB_TOP      3328
#define XB_TOPGEN   3392
#define XCD_BAR_WORDS 3456
#define XB_SPIN_CAP (1u << 18)

__device__ __forceinline__ unsigned xb_ld(unsigned* p)              { return __hip_atomic_load(p, __ATOMIC_RELAXED, __HIP_MEMORY_SCOPE_AGENT); }
__device__ __forceinline__ unsigned xb_add(unsigned* p, unsigned v) { return __hip_atomic_fetch_add(p, v, __ATOMIC_RELAXED, __HIP_MEMORY_SCOPE_AGENT); }
__device__ __forceinline__ unsigned xb_xcc_id() { return (unsigned)__builtin_amdgcn_s_getreg((3 << 11) | 20) & 0xFu; }
#define XB_SPIN(cond, bar) do { unsigned _sp = 0; while (cond) { __builtin_amdgcn_s_sleep(1); \
    if ((++_sp & 255u) == 0u) { if (xb_ld(&(bar)[XB_TMO])) break; if (_sp > XB_SPIN_CAP) { atomicAdd(&(bar)[XB_TMO], 1u); break; } } } } while (0)

struct XcdBarrier {
    unsigned* bar; unsigned x;
    volatile LAS unsigned* st;
};

__device__ __forceinline__ XcdBarrier xcd_barrier_post(unsigned* bar, volatile LAS unsigned* st) {
    XcdBarrier b; b.bar = bar; b.x = xb_xcc_id(); b.st = st;
    if (threadIdx.x == 0) (void)xb_add(&bar[XB_XCNT(b.x)], 1u);
    return b;
}
__device__ __forceinline__ void xcd_barrier_complete(unsigned* bar, unsigned x, unsigned& nloc, unsigned& nx) {
    const unsigned G = gridDim.x * gridDim.y * gridDim.z;
    unsigned sum, cnt, mine, sp = 0u;
    for (;;) {
        sum = 0u; cnt = 0u; mine = 0u;
#pragma unroll
        for (unsigned j = 0; j < 16; ++j) { const unsigned c = xb_ld(&bar[XB_XCNT(j)]); sum += c; cnt += (c > 0u) ? 1u : 0u; mine = (j == x) ? c : mine; }
        if (sum == G) break;
        __builtin_amdgcn_s_sleep(1);
        if ((++sp & 255u) == 0u) { if (xb_ld(&bar[XB_TMO])) break; if (sp > XB_SPIN_CAP) { atomicAdd(&bar[XB_TMO], 1u); break; } }
    }
    nloc = mine > 0u ? mine : 1u; nx = cnt > 0u ? cnt : 1u;
}

__device__ __forceinline__ void xcd_barrier(const XcdBarrier& b) {
    asm volatile("s_waitcnt vmcnt(0)" ::: "memory");
    __syncthreads();
    if (threadIdx.x == 0) {
        unsigned* bar = b.bar;
        __builtin_amdgcn_s_waitcnt(0);
        unsigned nloc = b.st[0], nx = b.st[1];
        if (nloc == 0u) { xcd_barrier_complete(bar, b.x, nloc, nx); b.st[0] = nloc; b.st[1] = nx; }
        const unsigned old = xb_add(&bar[XB_XSUB(b.x)], 1u);
        const unsigned gen = old / nloc;
        if (old + 1u == (gen + 1u) * nloc) {
            __builtin_amdgcn_fence(__ATOMIC_RELEASE, "agent");
            asm volatile("s_waitcnt vmcnt(0)" ::: "memory");
            const unsigned og = xb_add(&bar[XB_TOP], 1u);
            const unsigned tg = og / nx;
            if (og + 1u == (tg + 1u) * nx) xb_add(&bar[XB_TOPGEN], 1u);
            else XB_SPIN(xb_ld(&bar[XB_TOPGEN]) == tg, bar);
            __builtin_amdgcn_fence(__ATOMIC_ACQUIRE, "agent");
            xb_add(&bar[XB_XGEN(b.x)], 1u);
            asm volatile("s_waitcnt vmcnt(0)" ::: "memory");
        } else {
            XB_SPIN(xb_ld(&bar[XB_XGEN(b.x)]) == gen, bar);
            __builtin_amdgcn_fence(__ATOMIC_ACQUIRE, "agent");
            asm volatile("s_waitcnt vmcnt(0)" ::: "memory");
        }
    }
    __syncthreads();
}

__global__ void __launch_bounds__(512, 2) mega(Params P) {
    extern __shared__ __attribute__((aligned(16))) unsigned char lds_raw[];
    LAS unsigned char* lds = (LAS unsigned char*)lds_raw;
#define GRID_SYNC() xcd_barrier(xbar)
    if (threadIdx.x < 2) ((volatile LAS unsigned*)(lds + 131072 + 1024))[threadIdx.x] = 0u;
    __syncthreads();
    XcdBarrier xbar = xcd_barrier_post((unsigned*)(P.ws + WS_BAR), (volatile LAS unsigned*)(lds + 131072 + 1024));
    const int tid = threadIdx.x, G = gridDim.x, bid = blockIdx.x;
    unsigned char* ws = P.ws;
    bf16* WUP = (bf16*)(ws + WS_WUP); bf16* WDN = (bf16*)(ws + WS_WDN); bf16* WIN = (bf16*)(ws + WS_WIN);
    bf16* WPA = (bf16*)(ws + WS_WPA); bf16* WPB = (bf16*)(ws + WS_WPB); bf16* WO = (bf16*)(ws + WS_WO);
    float* MOD = (float*)(ws + WS_MOD); float* LBF = MOD + 9 * NMODC; float* LBB = LBF + 1024;
    bf16* U = (bf16*)(ws + WS_U);
    bf16* H = (bf16*)(ws + R_H); float* HC1 = (float*)(ws + R_HC1);
    bf16* Qb = (bf16*)(ws + R_Q); f16* GFb = (f16*)(ws + R_GF); f16* GBb = (f16*)(ws + R_GB); bf16* Vb = (bf16*)(ws + R_V);
    bf16* OFb = (bf16*)(ws + R_OF); bf16* OBb = (bf16*)(ws + R_OB);
    bf16* SGb = (bf16*)(ws + R_SG); bf16* GLUb = (bf16*)(ws + R_GLU); bf16* GATESb = (bf16*)(ws + R_GATES);
    bf16* BOP = U; bf16* Tb = OBb;
    bf16* DLT = (bf16*)(ws + WS_R + 192 * MiB);
    float* PART = (float*)(ws + WS_R + 192 * MiB);
    float* OUT = P.out;

    {
        if (bid < 144) {
            LAS float* SC = (LAS float*)lds;
            for (int i = tid; i < 9 * 1024; i += 512) { const float v = (i < 8192) ? P.in[I_C][i] : P.in[I_CCTX][i - 8192]; SC[i] = siluf_(v); }
            __syncthreads();
            for (int item = bid; item < 144; item += G) adaln_item(lds, item, P.in[I_WADA], P.in[I_BADA], MOD);
        }
        if (bid == G - 1) {
            const float* l = P.in[I_LBL];
            for (int d = tid; d < 1024; d += 512) { LBF[d] = 1.0f / (1.0f + __expf(l[2048 + d] - l[d])); LBB[d] = 1.0f / (1.0f + __expf(l[3072 + d] - l[1024 + d])); }
        }
        for (int it = (bid + 112) % G; it < 2592; it += G) {
            if (it < 704) conv_job_item(lds, it, P.in[I_W1U], 1024, 5632, WUP, 0, 0, 2816);
            else if (it < 1056) conv_job_item(lds, it - 704, P.in[I_W1D], 2816, 1024, WDN, 0, -1, 0);
            else if (it < 1952) conv_job_item(lds, it - 1056, P.in[I_WIN], 1024, 7168, WIN, 0, 5120, 1024);
            else if (it < 2208) conv_job_item(lds, it - 1952, P.in[I_WG], 1024, 2048, WIN, 7168, -1, 0);
            else if (it < 2336) conv_job_item(lds, it - 2208, P.in[I_WPA], 1024, 1024, WPA, 0, -1, 0);
            else if (it < 2464) conv_job_item(lds, it - 2336, P.in[I_WPB], 1024, 1024, WPB, 0, -1, 0);
            else conv_job_item(lds, it - 2464, P.in[I_WO], 1024, 1024, WO, 0, -1, 0);
        }
    }
    GRID_SYNC();
    normmod_phase<true, true>(P.in[I_X], P.in[I_CTX], MT, P.in[I_NF1], MOD, 0, 1, U, OUT);
    GRID_SYNC();
    { pg8::Gemm g{U, WUP, MT, 2 * FF, D, D}; pg8::StaticOrder S; S.init(MT, 2 * FF, G, bid); EpiSwiglu E{H, FF}; pg8::gemm_phase<EpiSwiglu, pg8::StaticOrder, GEMM_ALIGN, GEMM_SP2>(lds, g, S, E, nullptr); }
    GRID_SYNC();
    { pg8::Gemm g{H, WDN, ML, D, FF, FF}; pg8::StaticOrder S; S.init(ML, D, G, bid); EpiRes E{P.in[I_X], OUT, P.in[I_CTX], HC1, MOD, 2, 0.5f}; pg8::gemm_phase<EpiRes, pg8::StaticOrder, GEMM_ALIGN, GEMM_SP2>(lds, g, S, E, nullptr); }
    { pg8::Gemm g{H, WDN, MT, D, 256, FF}; KSplitOrder S{G, bid}; EpiPart E{PART}; pg8::gemm_phase<EpiPart, KSplitOrder, GEMM_ALIGN, GEMM_SP2>(lds, g, S, E, nullptr); }
    GRID_SYNC();
    normmod_phase<true, true, true>(OUT, P.in[I_CTX], MT, P.in[I_NMIX], MOD, 3, 4, U, OUT, PART, 2);
    GRID_SYNC();
    { pg8::Gemm g{U, WIN, MT, 4096, D, D}; pg8::StaticOrder S; S.init(MT, 4096, G, bid); EpiMix1 E{Qb, GFb, GBb, Vb, LBF, LBB}; pg8::gemm_phase<EpiMix1, pg8::StaticOrder, GEMM_ALIGN, GEMM_SP2>(lds, g, S, E, nullptr); }
    GRID_SYNC();
    for (int item = bid; item < 256; item += G) scan_item(lds, item, Qb, GFb, GBb, Vb, OFb, OBb);
    GRID_SYNC();
    { pg8::Gemm g{U, WIN + (size_t)4096 * D, ML, 5120, D, D}; pg8::StaticOrder S; S.init(ML, 5120, G, bid); EpiMix2 E{SGb, GLUb, GATESb, P.in[I_BG]}; pg8::gemm_phase<EpiMix2, pg8::StaticOrder, GEMM_ALIGN, GEMM_SP2>(lds, g, S, E, nullptr); }
    GRID_SYNC();
    {
        conv_items(lds, bid, 2048, G, GLUb, P.in[I_WDW], P.in[I_BDW], P.in[I_LNG], P.in[I_LNB], BOP);
        aop_rows(bid * 8 + (tid >> 6), ML, G * 8, OFb, OBb, SGb, P.in[I_HGN]);
        for (int it = bid; it < 1056; it += G) {
            if (it < 704) conv_job_item(lds, it, P.in[I_W2U], 1024, 5632, WUP, 0, 0, 2816);
            else conv_job_item(lds, it - 704, P.in[I_W2D], 2816, 1024, WDN, 0, -1, 0);
        }
    }
    GRID_SYNC();
    { pg8::Gemm g{OFb, WPA, ML, D, D, D}; pg8::StaticOrder S; S.init(ML, D, G, bid); EpiGate<0> E{GATESb, Tb, 0}; pg8::gemm_phase<EpiGate<0>, pg8::StaticOrder, GEMM_ALIGN, GEMM_SP2>(lds, g, S, E, nullptr); }
    GRID_SYNC();
    { pg8::Gemm g{BOP, WPB, ML, D, D, D}; pg8::StaticOrder S; S.init(ML, D, G, bid); EpiGate<1> E{GATESb, Tb, 1024}; pg8::gemm_phase<EpiGate<1>, pg8::StaticOrder, GEMM_ALIGN, GEMM_SP2>(lds, g, S, E, nullptr); }
    GRID_SYNC();
    { pg8::Gemm g{Tb, WO, ML, D, D, D}; pg8::StaticOrder S; S.init(ML, D, G, bid); EpiRes E{OUT, OUT, nullptr, nullptr, MOD, 5, 1.0f}; pg8::gemm_phase<EpiRes, pg8::StaticOrder, GEMM_ALIGN, GEMM_SP2>(lds, g, S, E, nullptr); }
    GRID_SYNC();
    normmod_phase<true, true>(OUT, HC1, ML, P.in[I_NF2], MOD, 6, 7, U, OUT);
    GRID_SYNC();
    { pg8::Gemm g{U, WUP, ML, 2 * FF, D, D}; pg8::StaticOrder S; S.init(ML, 2 * FF, G, bid); EpiSwiglu E{H, FF}; pg8::gemm_phase<EpiSwiglu, pg8::StaticOrder, GEMM_ALIGN, GEMM_SP2>(lds, g, S, E, nullptr); }
    GRID_SYNC();
    { pg8::Gemm g{H, WDN, ML, D, FF, FF}; pg8::StaticOrder S; S.init(ML, D, G, bid); EpiDelta E{DLT, MOD, 8, 0.5f}; pg8::gemm_phase<EpiDelta, pg8::StaticOrder, GEMM_ALIGN, GEMM_SP2>(lds, g, S, E, nullptr); }
    GRID_SYNC();
    normmod_phase<false, false, false, true>(OUT, HC1, ML, P.in[I_FN], MOD, 0, 0, U, OUT, nullptr, 0, DLT);
}

extern "C" void kernel_launch(void* const* d_in, const int* in_sizes, int n_in, void* d_out, int out_size, void* d_ws, size_t ws_size, hipStream_t stream) {
    static int grid = 0;
    if (grid == 0) {
        if (n_in != 26 || ws_size < WS_NEED) { fprintf(stderr, "kernel_launch: n_in %d ws %zu (need %zu)\n", n_in, ws_size, (size_t)WS_NEED); grid = -1; return; }
        int dev = 0, cus = 0, per_cu = 0;
        hipGetDevice(&dev); hipDeviceGetAttribute(&cus, hipDeviceAttributeMultiprocessorCount, dev);
        if (hipFuncSetAttribute((const void*)mega, hipFuncAttributeMaxDynamicSharedMemorySize, LDS_BYTES) != hipSuccess) { fprintf(stderr, "hipFuncSetAttribute failed\n"); grid = -1; return; }
        if (hipOccupancyMaxActiveBlocksPerMultiprocessor(&per_cu, (const void*)mega, 512, LDS_BYTES) != hipSuccess || per_cu < 1) { fprintf(stderr, "occupancy query: %d\n", per_cu); grid = -1; return; }
        grid = cus;
    }
    if (grid < 0) return;
    if (hipMemsetAsync((char*)d_ws + WS_BAR, 0, XCD_BAR_WORDS * sizeof(unsigned), stream) != hipSuccess) { fprintf(stderr, "memset failed\n"); return; }
    Params p{};
    for (int i = 0; i < 26; ++i) p.in[i] = (const float*)d_in[i];
    p.out = (float*)d_out; p.ws = (unsigned char*)d_ws;
    void* args[] = {&p};
    hipError_t e = hipLaunchCooperativeKernel((const void*)mega, dim3(grid), dim3(512), args, LDS_BYTES, stream);
    if (e != hipSuccess) fprintf(stderr, "cooperative launch failed: %s (grid %d)\n", hipGetErrorString(e), grid);
}
```

```cpp
#include <hip/hip_runtime.h>
#include <cstdio>
#define GEMM_ALIGN true
#define GEMM_SP2 true
namespace pg8 {
#define PG8_LAS __attribute__((address_space(3)))
typedef unsigned short bf16_t;
typedef short bf16x8 __attribute__((ext_vector_type(8)));
typedef float f32x4 __attribute__((ext_vector_type(4)));
typedef unsigned u32x4 __attribute__((ext_vector_type(4)));
constexpr int BM = 256, BK = 64, HALF = 128, HTB = HALF * BK * 2  , STAGE_BYTES = 8 * HTB, NXCD = 8, WGM = 8;

__host__ __device__ __forceinline__ int lds_byte(int r, int c) { const int st = (r >> 4) * 2 + (c >> 5), rr = r & 15, cc = c & 31, ob = rr * 64 + cc * 2; return st * 1024 + (ob ^ (((ob >> 9) & 1) << 5)); }
__host__ __device__ __forceinline__ void stage_rc(int b, int& R, int& C) { const int st = b / 1024, sb = b % 1024, swz = sb ^ (((sb >> 9) & 1) << 5); R = (st >> 1) * 16 + swz / 64; C = (st & 1) * 32 + (swz % 64) / 2; }
__host__ __device__ __forceinline__ int perm32(int rho) { const int n = rho >> 4, i = rho & 15; return 8 * (i >> 2) + 4 * n + (i & 3); }

struct Unit { int pm, pn, pk; };
struct Gemm { const bf16_t* A; const bf16_t* Bt; int M, N, K, Kp; };

struct StaticOrder {
    int nM, nN, nwg, G, c;
    __host__ __device__ void init(int M, int N, int G_, int c_) { nM = M / BM; nN = N / BM; nwg = nM * nN; G = G_; c = c_; }
    __host__ __device__ bool next(int i, Unit& u) const {
        const long L = (long)i * G + c; if (L >= nwg) return false;
        int wgid = (int)L; { const int q = nwg / NXCD, r = nwg % NXCD, xcd = wgid % NXCD, off = wgid / NXCD; wgid = (xcd < r ? xcd * (q + 1) : r * (q + 1) + (xcd - r) * q) + off; }
        const int nig = WGM * nN, gid = wgid / nig, fm = gid * WGM, gsz = (nM - fm) < WGM ? (nM - fm) : WGM;
        u.pm = fm + ((wgid % nig) % gsz); u.pn = (wgid % nig) / gsz; u.pk = 0; return true;
    }
    __device__ __forceinline__ void a_ready(const Unit&) const {}
    __device__ __forceinline__ void done(const Unit&) const {}
};
__device__ __forceinline__ unsigned cvt_pk_bf16(float lo, float hi) { unsigned r; asm volatile("v_cvt_pk_bf16_f32 %0, %1, %2" : "=v"(r) : "v"(lo), "v"(hi)); return r; }
template <class Epi, class Sched, bool ALIGN_EPI = false, bool SP2 = false, bool STAMP = false>
__device__ __forceinline__ void gemm_phase(PG8_LAS unsigned char* lds, const Gemm g, const Sched& S, const Epi& E, unsigned long long* stamps) {
    int tid_ = threadIdx.x; asm volatile("" : "+v"(tid_));
    const int tid = tid_, wid = __builtin_amdgcn_readfirstlane(tid >> 6), lane = tid & 63, wr = wid >> 2, wc = wid & 3, fr = lane & 15, fq = lane >> 4;
    const int K = g.Kp, nt = g.K / BK;
    int ts_lo = 0, ts_hi = 0, nts = 0; const unsigned long long rt_entry = STAMP ? (unsigned long long)wall_clock64() : 0ull;
#define PG8_STAMP() do { if (STAMP && wid == 0 && nts < 64) { const unsigned long long _c = (unsigned long long)clock64(); \
        ts_lo = (lane == nts) ? (int)(unsigned)_c : ts_lo; ts_hi = (lane == nts) ? (int)(unsigned)(_c >> 32) : ts_hi; ++nts; } } while (0)
    PG8_STAMP();
    unsigned voffA[2], voffB[2];
#pragma unroll
    for (int i = 0; i < 2; ++i) { int R, C; stage_rc(tid * 16 + i * 8192, R, C); const int Rb = Epi::PERM ? ((R & ~31) + perm32(R & 31)) : R;
        voffA[i] = (unsigned)(R * K + C) * 2u; voffB[i] = (unsigned)(Rb * K + C) * 2u; }
    const size_t kstep = (size_t)(BK * 2);
    const size_t hstep = (size_t)HALF * K * 2;
    const size_t tstep = 2 * hstep;
    const unsigned ldsw = (unsigned)wid * 1024u;
    const int aoff = lds_byte(wr * 64 + fr, fq * 8), boff = lds_byte(wc * 32 + fr, fq * 8);
#define PG8_SA(b, h) (((b) * 2 + (h)) * HTB)
#define PG8_SB(b, h) ((4 + (b) * 2 + (h)) * HTB)
#define PG8_STAGE(bufoff, gbase, voff) do { _Pragma("unroll") for (int _i = 0; _i < 2; ++_i) \
        __builtin_amdgcn_global_load_lds((const unsigned*)((const char*)(gbase) + (voff)[_i]), (PG8_LAS unsigned*)(lds + (bufoff) + ldsw + _i * 8192), 16, 0, 0); } while (0)
#define PG8_LDA(dst, b, h) do { _Pragma("unroll") for (int m = 0; m < 4; ++m) _Pragma("unroll") for (int k = 0; k < 2; ++k) dst[m][k] = *(const PG8_LAS bf16x8*)(lds + PG8_SA(b, h) + aoff + m * 2048 + k * 1024); } while (0)
#define PG8_LDB(dst, b, h) do { _Pragma("unroll") for (int n = 0; n < 2; ++n) _Pragma("unroll") for (int k = 0; k < 2; ++k) dst[n][k] = *(const PG8_LAS bf16x8*)(lds + PG8_SB(b, h) + boff + n * 2048 + k * 1024); } while (0)
#define PG8_MMA(ai, bj, At, Bt) do { __builtin_amdgcn_s_setprio(1); _Pragma("unroll") for (int m = 0; m < 4; ++m) _Pragma("unroll") for (int n = 0; n < 2; ++n) _Pragma("unroll") for (int k = 0; k < 2; ++k) \
        acc[ai][bj][m][n] = __builtin_amdgcn_mfma_f32_16x16x32_bf16(Bt[n][k], At[m][k], acc[ai][bj][m][n], 0, 0, 0); __builtin_amdgcn_s_setprio(0); } while (0)
#define PG8_WAIT_V(n) asm volatile("s_waitcnt vmcnt(" #n ")" ::: "memory")
#define PG8_WAIT_L(n) asm volatile("s_waitcnt lgkmcnt(" #n ")" ::: "memory")
#define PG8_BAR __builtin_amdgcn_s_barrier()
#define PG8_SCHED __builtin_amdgcn_sched_barrier(0)
    Unit cur, nxt; int ui = 0;
    if (!S.next(0, cur)) return;
    f32x4 acc[2][2][4][2];
#pragma unroll
    for (int a = 0; a < 2; ++a)
#pragma unroll
        for (int b = 0; b < 2; ++b)
#pragma unroll
            for (int m = 0; m < 4; ++m)
#pragma unroll
                for (int n = 0; n < 2; ++n) acc[a][b][m][n] = (f32x4){0.f, 0.f, 0.f, 0.f};
    bf16x8 At[4][2], B0[2][2], B1[2][2];
    const size_t pstep = (size_t)g.K * 2;
    const char* cA = (const char*)g.A + (size_t)cur.pm * tstep + (size_t)cur.pk * pstep; const char* cB = (const char*)g.Bt + (size_t)cur.pn * tstep + (size_t)cur.pk * pstep;
    S.a_ready(cur);
    if constexpr (SP2) {
        PG8_STAGE(PG8_SB(0, 0), cB, voffB); PG8_STAGE(PG8_SB(0, 1), cB + hstep, voffB); PG8_STAGE(PG8_SA(0, 0), cA, voffA); PG8_STAGE(PG8_SA(0, 1), cA + hstep, voffA);
        if (wr == 1) PG8_BAR;
        PG8_WAIT_V(2); PG8_BAR;
    } else {
        PG8_STAGE(PG8_SB(0, 0), cB, voffB); PG8_STAGE(PG8_SA(0, 0), cA, voffA); PG8_STAGE(PG8_SB(0, 1), cB + hstep, voffB); PG8_STAGE(PG8_SA(0, 1), cA + hstep, voffA);
        if (wr == 1) PG8_BAR;
        PG8_WAIT_V(4); PG8_BAR;
    }
    PG8_STAGE(PG8_SB(1, 0), cB + kstep, voffB); PG8_STAGE(PG8_SA(1, 0), cA + kstep, voffA); PG8_STAGE(PG8_SB(1, 1), cB + hstep + kstep, voffB);
    PG8_WAIT_V(6); PG8_BAR;
    PG8_STAMP();
    for (;;) {
        const bool has_next = S.next(ui + 1, nxt);
        const char* nA = has_next ? (const char*)g.A + (size_t)nxt.pm * tstep + (size_t)nxt.pk * pstep : cA; const char* nB = has_next ? (const char*)g.Bt + (size_t)nxt.pn * tstep + (size_t)nxt.pk * pstep : cB;
        for (int t = 0; t < nt; t += 2) {
            const bool last = (t == nt - 2);
            const char* a1 = cA + (size_t)(t + 1) * kstep;
            const char* a2 = last ? nA : cA + (size_t)(t + 2) * kstep; const char* b2 = last ? nB : cB + (size_t)(t + 2) * kstep;
            const char* a3 = a2 + kstep; const char* b3 = b2 + kstep;
            if (last && has_next) S.a_ready(nxt);
            if constexpr (SP2) {
            PG8_LDB(B0, 0, 0); PG8_LDB(B1, 0, 1); PG8_SCHED; PG8_LDA(At, 0, 0); PG8_STAGE(PG8_SA(1, 1), a1 + hstep, voffA);
            PG8_WAIT_V(8); PG8_WAIT_L(0); PG8_BAR; PG8_MMA(0, 0, At, B0); PG8_MMA(0, 1, At, B1); PG8_BAR; PG8_SCHED;
            PG8_LDA(At, 0, 1); PG8_STAGE(PG8_SB(0, 0), b2, voffB); PG8_STAGE(PG8_SB(0, 1), b2 + hstep, voffB); PG8_STAGE(PG8_SA(0, 0), a2, voffA);
            PG8_WAIT_V(8); PG8_WAIT_L(0); PG8_BAR; PG8_MMA(1, 0, At, B0); PG8_MMA(1, 1, At, B1); PG8_BAR; PG8_SCHED;
            PG8_LDB(B0, 1, 0); PG8_LDB(B1, 1, 1); PG8_SCHED; PG8_LDA(At, 1, 0); PG8_STAGE(PG8_SA(0, 1), a2 + hstep, voffA);
            PG8_WAIT_V(8); PG8_WAIT_L(0); PG8_BAR; PG8_MMA(0, 0, At, B0); PG8_MMA(0, 1, At, B1); PG8_BAR; PG8_SCHED;
            PG8_LDA(At, 1, 1); PG8_STAGE(PG8_SB(1, 0), b3, voffB); PG8_STAGE(PG8_SB(1, 1), b3 + hstep, voffB); PG8_STAGE(PG8_SA(1, 0), a3, voffA);
            PG8_WAIT_V(8); PG8_WAIT_L(0); PG8_BAR; PG8_MMA(1, 0, At, B0); PG8_MMA(1, 1, At, B1); PG8_BAR; PG8_SCHED;
            } else {
            PG8_LDB(B0, 0, 0); PG8_SCHED; PG8_LDA(At, 0, 0); PG8_STAGE(PG8_SA(1, 1), a1 + hstep, voffA);
            PG8_WAIT_L(8); PG8_BAR; PG8_WAIT_L(0); PG8_MMA(0, 0, At, B0); PG8_BAR; PG8_SCHED;
            PG8_LDB(B1, 0, 1); PG8_STAGE(PG8_SB(0, 0), b2, voffB);
            PG8_BAR; PG8_WAIT_L(0); PG8_MMA(0, 1, At, B1); PG8_BAR;
            PG8_LDA(At, 0, 1); PG8_STAGE(PG8_SA(0, 0), a2, voffA);
            PG8_BAR; PG8_WAIT_L(0); PG8_MMA(1, 0, At, B0); PG8_BAR; PG8_SCHED;
            PG8_STAGE(PG8_SB(0, 1), b2 + hstep, voffB);
            PG8_WAIT_V(6); PG8_BAR; PG8_MMA(1, 1, At, B1); PG8_BAR;
            PG8_LDB(B0, 1, 0); PG8_SCHED; PG8_LDA(At, 1, 0); PG8_STAGE(PG8_SA(0, 1), a2 + hstep, voffA);
            PG8_WAIT_L(8); PG8_BAR; PG8_WAIT_L(0); PG8_MMA(0, 0, At, B0); PG8_BAR; PG8_SCHED;
            PG8_LDB(B1, 1, 1); PG8_STAGE(PG8_SB(1, 0), b3, voffB);
            PG8_BAR; PG8_WAIT_L(0); PG8_MMA(0, 1, At, B1); PG8_BAR;
            PG8_LDA(At, 1, 1); PG8_STAGE(PG8_SA(1, 0), a3, voffA);
            PG8_BAR; PG8_WAIT_L(0); PG8_MMA(1, 0, At, B0); PG8_BAR; PG8_SCHED;
            PG8_STAGE(PG8_SB(1, 1), b3 + hstep, voffB);
            PG8_WAIT_V(6); PG8_BAR; PG8_MMA(1, 1, At, B1); PG8_BAR;
            }
        }
        PG8_STAMP();
        if constexpr (ALIGN_EPI) { if (wr == 0) PG8_BAR; }
        if constexpr (!Epi::AFTER_DRAIN) { E(acc, cur, wr, wc, fr, fq); S.done(cur); }
        PG8_STAMP();
        if (!has_next) break;
#pragma unroll
        for (int a = 0; a < 2; ++a)
#pragma unroll
            for (int b = 0; b < 2; ++b)
#pragma unroll
                for (int m = 0; m < 4; ++m)
#pragma unroll
                    for (int n = 0; n < 2; ++n) acc[a][b][m][n] = (f32x4){0.f, 0.f, 0.f, 0.f};
        cur = nxt; cA = nA; cB = nB; ++ui;
        if constexpr (ALIGN_EPI) { if (wr == 1) PG8_BAR; }
    }
    PG8_WAIT_V(0);
    if constexpr (!ALIGN_EPI) { if (wr == 0) PG8_BAR; }
    PG8_BAR;
    if constexpr (Epi::AFTER_DRAIN) { E.fused(acc, cur, wr, wc, fr, fq, lds, wid, lane); S.done(cur); }
    PG8_STAMP();
    if (STAMP && wid == 0) { stamps[lane] = lane < nts ? (((unsigned long long)(unsigned)ts_hi << 32) | (unsigned)ts_lo) : 0ull;
        if (lane == 62) stamps[62] = rt_entry; if (lane == 63) stamps[63] = (unsigned long long)wall_clock64(); }
#undef PG8_STAMP
#undef PG8_SA
#undef PG8_SB
#undef PG8_STAGE
#undef PG8_LDA
#undef PG8_LDB
#undef PG8_MMA
#undef PG8_WAIT_V
#undef PG8_WAIT_L
#undef PG8_BAR
#undef PG8_SCHED
}
}

#define LAS __attribute__((address_space(3)))
typedef unsigned short bf16;
typedef _Float16 f16;
typedef pg8::f32x4 f32x4;
typedef pg8::u32x4 u32x4;
typedef pg8::bf16x8 bf16x8;
typedef unsigned u32x2 __attribute__((ext_vector_type(2)));
typedef _Float16 f16x8 __attribute__((ext_vector_type(8)));
typedef _Float16 f16x4 __attribute__((ext_vector_type(4)));

constexpr int D = 1024, NB = 8, SEQ = 4096, CTXL = 256, ML = NB * SEQ, MC = NB * CTXL, MT = ML + MC, FF = 2816, NMODC = 9 * D;
constexpr float EPS = 1e-6f;
constexpr size_t MiB = 1ull << 20;
constexpr size_t WS_WUP = 0, WS_WDN = 11 * MiB, WS_WIN = 17 * MiB, WS_WPA = 35 * MiB, WS_WPB = 37 * MiB, WS_WO = 39 * MiB, WS_MOD = 41 * MiB,
                 WS_U = 42 * MiB, WS_R = 110 * MiB, WS_BAR = 41 * MiB + 512 * 1024;
constexpr size_t R_H = WS_R, R_HC1 = WS_R + 187 * MiB;
constexpr size_t R_Q = WS_R, R_GF = WS_R + 64 * MiB, R_GB = WS_R + 132 * MiB, R_V = WS_R + 200 * MiB, R_OF = WS_R + 268 * MiB, R_OB = WS_R + 332 * MiB;
constexpr size_t R_SG = WS_R, R_GLU = WS_R + 64 * MiB, R_GATES = WS_R + 128 * MiB;
constexpr size_t WS_NEED = WS_R + 396 * MiB;
constexpr int LDS_BYTES = 131072 + 4096;

struct Params { const float* in[26]; float* out; unsigned char* ws; };
enum { I_X = 0, I_C, I_CTX, I_CCTX, I_WADA, I_BADA, I_NF1, I_W1U, I_W1D, I_NMIX, I_WIN, I_LBL, I_HGN, I_WDW, I_BDW, I_LNG, I_LNB, I_WPA, I_WPB, I_WG, I_BG, I_WO,
       I_NF2, I_W2U, I_W2D, I_FN };

__device__ __forceinline__ int tid_opaque() { int t = threadIdx.x; asm volatile("" : "+v"(t)); return t; }
__device__ __forceinline__ float bf2f(unsigned short b) { return __uint_as_float(((unsigned)b) << 16); }
__device__ __forceinline__ float bflo(unsigned w) { return __uint_as_float(w << 16); }
__device__ __forceinline__ float bfhi(unsigned w) { return __uint_as_float(w & 0xffff0000u); }
typedef __bf16 bf2_t __attribute__((ext_vector_type(2)));
__device__ __forceinline__ unsigned pk2(float lo, float hi) { bf2_t v; v.x = (__bf16)lo; v.y = (__bf16)hi; return __builtin_bit_cast(unsigned, v); }
__device__ __forceinline__ float sigmoidf_(float x) { return __builtin_amdgcn_rcpf(1.0f + __expf(-x)); }
__device__ __forceinline__ float siluf_(float x) { return x * __builtin_amdgcn_rcpf(1.0f + __expf(-x)); }
typedef float f32x2 __attribute__((ext_vector_type(2)));
__device__ __forceinline__ f32x2 sig2_(f32x2 x) { const f32x2 t = x * (-1.44269504f); f32x2 e; e.x = __builtin_amdgcn_exp2f(t.x); e.y = __builtin_amdgcn_exp2f(t.y); const f32x2 d = e + 1.0f; f32x2 r; r.x = __builtin_amdgcn_rcpf(d.x); r.y = __builtin_amdgcn_rcpf(d.y); return r; }
__device__ __forceinline__ f32x4 sig4_(f32x4 x) { const f32x2 lo = sig2_(__builtin_shufflevector(x, x, 0, 1)), hi = sig2_(__builtin_shufflevector(x, x, 2, 3)); return (f32x4){lo.x, lo.y, hi.x, hi.y}; }
__device__ __forceinline__ f32x4 silu4_(f32x4 x) { return x * sig4_(x); }
__device__ __forceinline__ u32x2 pk4(f32x4 v) { u32x2 w; w.x = pk2(v[0], v[1]); w.y = pk2(v[2], v[3]); return w; }

struct EpiSwiglu {
    static constexpr bool PERM = true, AFTER_DRAIN = false;
    bf16* H; int ldh;
    __device__ __forceinline__ void operator()(const f32x4 (&acc)[2][2][4][2], const pg8::Unit& u, int wr, int wc, int fr, int fq) const {
        const int row0 = u.pm * 256 + wr * 64 + fr, col0 = u.pn * 128 + wc * 32 + 8 * fq;
#pragma unroll
        for (int ai = 0; ai < 2; ++ai)
#pragma unroll
            for (int m = 0; m < 4; ++m) {
                bf16* rowp = H + (size_t)(row0 + ai * 128 + m * 16) * ldh + col0;
                const u32x2 w0 = pk4(silu4_(acc[ai][0][m][0]) * acc[ai][1][m][0]), w1 = pk4(silu4_(acc[ai][0][m][1]) * acc[ai][1][m][1]);
                *(u32x4*)rowp = (u32x4){w0.x, w0.y, w1.x, w1.y};
            }
    }
};

struct EpiRes {
    static constexpr bool PERM = false, AFTER_DRAIN = false;
    const float* baseL; float* outL; const float* baseC; float* outC; const float* mod; int gidx; float coef;
    __device__ __forceinline__ void operator()(const f32x4 (&acc)[2][2][4][2], const pg8::Unit& u, int wr, int wc, int fr, int fq) const {
        const bool lat = u.pm < 128;
        const int prow = (lat ? u.pm : u.pm - 128) * 256 + wr * 64 + fr;
        const float* base = lat ? baseL : baseC; float* out = lat ? outL : outC;
        const float* gate = mod + (size_t)(lat ? (u.pm >> 4) : 8) * NMODC + gidx * D;
        const int col0 = u.pn * 256 + wc * 32 + 4 * fq;
        f32x4 gv[2][2];
#pragma unroll
        for (int bj = 0; bj < 2; ++bj)
#pragma unroll
            for (int n = 0; n < 2; ++n) gv[bj][n] = *(const f32x4*)(gate + col0 + bj * 128 + n * 16) * coef;
#pragma unroll
        for (int ai = 0; ai < 2; ++ai)
#pragma unroll
            for (int m = 0; m < 4; ++m) {
                const size_t off = (size_t)(prow + ai * 128 + m * 16) * D + col0;
#pragma unroll
                for (int bj = 0; bj < 2; ++bj)
#pragma unroll
                    for (int n = 0; n < 2; ++n) {
                        const f32x4 bs = *(const f32x4*)(base + off + bj * 128 + n * 16);
                        *(f32x4*)(out + off + bj * 128 + n * 16) = bs + gv[bj][n] * acc[ai][bj][m][n];
                    }
            }
    }
};


struct EpiResB {
    static constexpr bool PERM = false, AFTER_DRAIN = false;
    const float* base; bf16* outb; const float* mod; int gidx; float coef;
    __device__ __forceinline__ void operator()(const f32x4 (&acc)[2][2][4][2], const pg8::Unit& u, int wr, int wc, int fr, int fq) const {
        const int prow = u.pm * 256 + wr * 64 + fr;
        const float* gate = mod + (size_t)(u.pm >> 4) * NMODC + gidx * D;
        const int col0 = u.pn * 256 + wc * 32 + 4 * fq;
        f32x4 gv[2][2];
#pragma unroll
        for (int bj = 0; bj < 2; ++bj)
#pragma unroll
            for (int n = 0; n < 2; ++n) gv[bj][n] = *(const f32x4*)(gate + col0 + bj * 128 + n * 16) * coef;
#pragma unroll
        for (int ai = 0; ai < 2; ++ai)
#pragma unroll
            for (int m = 0; m < 4; ++m) {
                const size_t off = (size_t)(prow + ai * 128 + m * 16) * D + col0;
#pragma unroll
                for (int bj = 0; bj < 2; ++bj)
#pragma unroll
                    for (int n = 0; n < 2; ++n) {
                        const f32x4 bs = *(const f32x4*)(base + off + bj * 128 + n * 16);
                        *(u32x2*)(outb + off + bj * 128 + n * 16) = pk4(bs + gv[bj][n] * acc[ai][bj][m][n]);
                    }
            }
    }
};

struct EpiDelta {
    static constexpr bool PERM = true, AFTER_DRAIN = false;
    bf16* delta; const float* mod; int gidx; float coef;
    __device__ __forceinline__ void operator()(const f32x4 (&acc)[2][2][4][2], const pg8::Unit& u, int wr, int wc, int fr, int fq) const {
        const int row0 = u.pm * 256 + wr * 64 + fr, col0 = u.pn * 256 + wc * 32 + 8 * fq;
        const float* gate = mod + (size_t)(u.pm >> 4) * NMODC + gidx * D;
#pragma unroll
        for (int bj = 0; bj < 2; ++bj) {
            const f32x4 g0 = *(const f32x4*)(gate + col0 + bj * 128) * coef, g1 = *(const f32x4*)(gate + col0 + bj * 128 + 4) * coef;
#pragma unroll
            for (int ai = 0; ai < 2; ++ai)
#pragma unroll
                for (int m = 0; m < 4; ++m) {
                    const u32x2 w0 = pk4(acc[ai][bj][m][0] * g0), w1 = pk4(acc[ai][bj][m][1] * g1);
                    *(u32x4*)(delta + (size_t)(row0 + ai * 128 + m * 16) * D + col0 + bj * 128) = (u32x4){w0.x, w0.y, w1.x, w1.y};
                }
        }
    }
};

struct EpiMix1 {
    static constexpr bool PERM = true, AFTER_DRAIN = false;
    bf16* Q; f16* GF; f16* GB; bf16* V; const float* lbf; const float* lbb;
    __device__ __forceinline__ void operator()(const f32x4 (&acc)[2][2][4][2], const pg8::Unit& u, int wr, int wc, int fr, int fq) const {
        const int seg = u.pn >> 2;
        const int row0 = u.pm * 256 + wr * 64 + fr, col0 = (u.pn & 3) * 256 + wc * 32 + 8 * fq;
        if (seg == 0) {
            if (u.pm >= 128) return;
#pragma unroll
            for (int ai = 0; ai < 2; ++ai)
#pragma unroll
                for (int m = 0; m < 4; ++m)
#pragma unroll
                    for (int bj = 0; bj < 2; ++bj) {
                        const f32x4 a = acc[ai][bj][m][0], b = acc[ai][bj][m][1];
                        const u32x2 w0 = pk4(silu4_(a)), w1 = pk4(silu4_(b)); const u32x4 w = (u32x4){w0.x, w0.y, w1.x, w1.y};
                        *(u32x4*)(Q + (size_t)(row0 + ai * 128 + m * 16) * D + col0 + bj * 128) = w;
                    }
        } else if (seg == 3) {
#pragma unroll
            for (int ai = 0; ai < 2; ++ai)
#pragma unroll
                for (int m = 0; m < 4; ++m)
#pragma unroll
                    for (int bj = 0; bj < 2; ++bj) {
                        const f32x4 a = acc[ai][bj][m][0], b = acc[ai][bj][m][1];
                        u32x4 w; w.x = pk2(a[0], a[1]); w.y = pk2(a[2], a[3]); w.z = pk2(b[0], b[1]); w.w = pk2(b[2], b[3]);
                        *(u32x4*)(V + (size_t)(row0 + ai * 128 + m * 16) * D + col0 + bj * 128) = w;
                    }
        } else {
            const float* lb = (seg == 1) ? lbf : lbb; f16* G = (seg == 1) ? GF : GB;
#pragma unroll
            for (int bj = 0; bj < 2; ++bj) {
                const f32x4 l0 = *(const f32x4*)(lb + col0 + bj * 128), l1 = *(const f32x4*)(lb + col0 + bj * 128 + 4);
#pragma unroll
                for (int ai = 0; ai < 2; ++ai)
#pragma unroll
                    for (int m = 0; m < 4; ++m) {
                        const f32x4 a = acc[ai][bj][m][0], b = acc[ai][bj][m][1];
                        f16x8 w;
                        const f32x4 fa = l0 + (1.0f - l0) * sig4_(a), fb = l1 + (1.0f - l1) * sig4_(b);
#pragma unroll
                        for (int j = 0; j < 4; ++j) { w[j] = (f16)__builtin_amdgcn_logf(fa[j]); w[4 + j] = (f16)__builtin_amdgcn_logf(fb[j]); }
                        *(f16x8*)(G + (size_t)(row0 + ai * 128 + m * 16) * D + col0 + bj * 128) = w;
                    }
            }
        }
    }
};

struct EpiMix2 {
    static constexpr bool PERM = true, AFTER_DRAIN = false;
    bf16* SG; bf16* GLU; bf16* GATES; const float* bgate;
    __device__ __forceinline__ void operator()(const f32x4 (&acc)[2][2][4][2], const pg8::Unit& u, int wr, int wc, int fr, int fq) const {
        const int row0 = u.pm * 256 + wr * 64 + fr, cw = wc * 32 + 8 * fq;
        if (u.pn < 4) {
#pragma unroll
            for (int ai = 0; ai < 2; ++ai)
#pragma unroll
                for (int m = 0; m < 4; ++m)
#pragma unroll
                    for (int bj = 0; bj < 2; ++bj) {
                        const f32x4 a = acc[ai][bj][m][0], b = acc[ai][bj][m][1];
                        const u32x2 w0 = pk4(silu4_(a)), w1 = pk4(silu4_(b)); const u32x4 w = (u32x4){w0.x, w0.y, w1.x, w1.y};
                        *(u32x4*)(SG + (size_t)(row0 + ai * 128 + m * 16) * D + u.pn * 256 + bj * 128 + cw) = w;
                    }
        } else if (u.pn < 12) {
            const int c0 = (u.pn - 4) * 128 + cw;
#pragma unroll
            for (int ai = 0; ai < 2; ++ai)
#pragma unroll
                for (int m = 0; m < 4; ++m) {
                    const u32x2 w0 = pk4(acc[ai][0][m][0] * sig4_(acc[ai][1][m][0])), w1 = pk4(acc[ai][0][m][1] * sig4_(acc[ai][1][m][1])); const u32x4 w = (u32x4){w0.x, w0.y, w1.x, w1.y};
                    *(u32x4*)(GLU + (size_t)(row0 + ai * 128 + m * 16) * D + c0) = w;
                }
        } else {
            const int c0 = (u.pn - 12) * 256 + cw;
#pragma unroll
            for (int bj = 0; bj < 2; ++bj) {
                const f32x4 b0 = *(const f32x4*)(bgate + c0 + bj * 128), b1 = *(const f32x4*)(bgate + c0 + bj * 128 + 4);
#pragma unroll
                for (int ai = 0; ai < 2; ++ai)
#pragma unroll
                    for (int m = 0; m < 4; ++m) {
                        const f32x4 a = acc[ai][bj][m][0] + b0, b = acc[ai][bj][m][1] + b1;
                        const u32x2 w0 = pk4(sig4_(a)), w1 = pk4(sig4_(b)); const u32x4 w = (u32x4){w0.x, w0.y, w1.x, w1.y};
                        *(u32x4*)(GATES + (size_t)(row0 + ai * 128 + m * 16) * 2048 + c0 + bj * 128) = w;
                    }
            }
        }
    }
};

template <int ADD> struct EpiGate {
    static constexpr bool PERM = true, AFTER_DRAIN = false;
    const bf16* GATES; bf16* T; int goff;
    __device__ __forceinline__ void operator()(const f32x4 (&acc)[2][2][4][2], const pg8::Unit& u, int wr, int wc, int fr, int fq) const {
        const int row0 = u.pm * 256 + wr * 64 + fr, col0 = u.pn * 256 + wc * 32 + 8 * fq;
#pragma unroll
        for (int ai = 0; ai < 2; ++ai)
#pragma unroll
            for (int m = 0; m < 4; ++m)
#pragma unroll
                for (int bj = 0; bj < 2; ++bj) {
                    const size_t r = (size_t)(row0 + ai * 128 + m * 16);
                    const u32x4 g = *(const u32x4*)(GATES + r * 2048 + goff + col0 + bj * 128);
                    bf16* tp = T + r * D + col0 + bj * 128;
                    const f32x4 a = acc[ai][bj][m][0], b = acc[ai][bj][m][1];
                    float o[8];
                    o[0] = bflo(g.x) * a[0]; o[1] = bfhi(g.x) * a[1]; o[2] = bflo(g.y) * a[2]; o[3] = bfhi(g.y) * a[3];
                    o[4] = bflo(g.z) * b[0]; o[5] = bfhi(g.z) * b[1]; o[6] = bflo(g.w) * b[2]; o[7] = bfhi(g.w) * b[3];
                    if (ADD) { const u32x4 t = *(const u32x4*)tp;
                        o[0] += bflo(t.x); o[1] += bfhi(t.x); o[2] += bflo(t.y); o[3] += bfhi(t.y); o[4] += bflo(t.z); o[5] += bfhi(t.z); o[6] += bflo(t.w); o[7] += bfhi(t.w); }
                    u32x4 w; w.x = pk2(o[0], o[1]); w.y = pk2(o[2], o[3]); w.z = pk2(o[4], o[5]); w.w = pk2(o[6], o[7]);
                    *(u32x4*)tp = w;
                }
    }
};


struct KSplitOrder {
    int G, c;
    __device__ bool next(int i, pg8::Unit& u) const { const int L = i * G + c; if (L >= 352) return false; u.pk = L >> 5; u.pm = 128 + ((L & 31) >> 2); u.pn = L & 3; return true; }
    __device__ __forceinline__ void a_ready(const pg8::Unit&) const {}
    __device__ __forceinline__ void done(const pg8::Unit&) const {}
};
struct EpiPart {
    static constexpr bool PERM = false, AFTER_DRAIN = false;
    float* part;
    __device__ __forceinline__ void operator()(const f32x4 (&acc)[2][2][4][2], const pg8::Unit& u, int wr, int wc, int fr, int fq) const {
        const int prow = (u.pm - 128) * 256 + wr * 64 + fr, col0 = u.pn * 256 + wc * 32 + 4 * fq;
        float* base = part + ((size_t)u.pk * MC + prow) * D + col0;
#pragma unroll
        for (int ai = 0; ai < 2; ++ai)
#pragma unroll
            for (int m = 0; m < 4; ++m)
#pragma unroll
                for (int bj = 0; bj < 2; ++bj)
#pragma unroll
                    for (int n = 0; n < 2; ++n) *(f32x4*)(base + (size_t)(ai * 128 + m * 16) * D + bj * 128 + n * 16) = acc[ai][bj][m][n];
    }
};

__device__ __forceinline__ void conv_tile(LAS unsigned char* lds, const float* src, int srcN, int k0, int n0, bf16* dst, int dstK, int drow0) {
    LAS float* T = (LAS float*)lds;
    const int tid = tid_opaque();
#pragma unroll
    for (int i = 0; i < 4; ++i) {
        const int kk = (tid >> 5) + 16 * i, n4 = tid & 31;
        const f32x4 v = *(const f32x4*)(src + (size_t)(k0 + kk) * srcN + n0 + 4 * n4);
#pragma unroll
        for (int j = 0; j < 4; ++j) T[kk * 129 + 4 * n4 + j] = v[j];
    }
    __syncthreads();
    {
        const int nn = tid >> 2, kq = tid & 3;
        float f[16];
#pragma unroll
        for (int j = 0; j < 16; ++j) f[j] = T[(16 * kq + j) * 129 + nn];
        u32x4 w0, w1;
        w0.x = pk2(f[0], f[1]); w0.y = pk2(f[2], f[3]); w0.z = pk2(f[4], f[5]); w0.w = pk2(f[6], f[7]);
        w1.x = pk2(f[8], f[9]); w1.y = pk2(f[10], f[11]); w1.z = pk2(f[12], f[13]); w1.w = pk2(f[14], f[15]);
        bf16* dp = dst + (size_t)(drow0 + nn) * dstK + k0 + 16 * kq;
        *(u32x4*)dp = w0; *(u32x4*)(dp + 8) = w1;
    }
    __syncthreads();
}
__device__ __forceinline__ void conv_job_item(LAS unsigned char* lds, int it, const float* src, int K, int N, bf16* dst, int roff, int pair_from, int NH) {
    const int nt = N / 128; const int kt = it / nt, ntile = it % nt; const int n0 = ntile * 128;
    int drow0;
    if (pair_from < 0 || n0 < pair_from) drow0 = roff + n0;
    else { const int n1 = n0 - pair_from; drow0 = roff + pair_from + ((n1 < NH) ? 256 * (n1 / 128) : 256 * ((n1 - NH) / 128) + 128); }
    conv_tile(lds, src, N, kt * 64, n0, dst, K, drow0);
}

template <bool MODU, bool OUT_BF16, bool CPART = false, bool ADDD = false, bool SRCB = false>
__device__ __forceinline__ void normmod_phase(const float* srcL, const float* srcC, int nrows, const float* gain, const float* mod, int ishift, int iscale, bf16* ub, float* of, const float* part = nullptr, int igate = 0, const bf16* dlt = nullptr) {
    const int tido = tid_opaque(); const int lane = tido & 63, wv = tido >> 6;
    f32x4 gn[4];
#pragma unroll
    for (int j = 0; j < 4; ++j) gn[j] = *(const f32x4*)(gain + 256 * j + 4 * lane);
    for (int row = blockIdx.x * 8 + wv; row < nrows; row += gridDim.x * 8) {
        const float* src = (row < ML) ? srcL + (size_t)row * D : srcC + (size_t)(row - ML) * D;
        f32x4 x[4]; float ss = 0.f;
#pragma unroll
        for (int j = 0; j < 4; ++j) {
            if constexpr (SRCB) { const u32x2 t = *(const u32x2*)((const bf16*)srcL + (size_t)row * D + 256 * j + 4 * lane); x[j] = (f32x4){bflo(t.x), bfhi(t.x), bflo(t.y), bfhi(t.y)}; }
            else x[j] = *(const f32x4*)(src + 256 * j + 4 * lane);
            if constexpr (ADDD) { const u32x2 t = *(const u32x2*)(dlt + (size_t)row * D + 256 * j + 4 * lane); x[j] += (f32x4){bflo(t.x), bfhi(t.x), bflo(t.y), bfhi(t.y)}; }
            if constexpr (CPART) { if (row >= ML) {
                f32x4 sp = *(const f32x4*)(part + (size_t)(row - ML) * D + 256 * j + 4 * lane);
#pragma unroll
                for (int pk = 1; pk < 11; ++pk) sp += *(const f32x4*)(part + ((size_t)pk * MC + (row - ML)) * D + 256 * j + 4 * lane);
                x[j] += sp * (*(const f32x4*)(mod + (size_t)8 * NMODC + igate * D + 256 * j + 4 * lane) * 0.5f); } }
            ss += x[j][0] * x[j][0] + x[j][1] * x[j][1] + x[j][2] * x[j][2] + x[j][3] * x[j][3]; }
#pragma unroll
        for (int o = 32; o >= 1; o >>= 1) ss += __shfl_xor(ss, o);
        const float rinv = rsqrtf(ss * (1.0f / D) + EPS);
        const int mrow = (row < ML) ? (row >> 12) : 8;
#pragma unroll
        for (int j = 0; j < 4; ++j) {
            f32x4 y = x[j] * rinv * gn[j];
            if constexpr (MODU) { const f32x4 sh = *(const f32x4*)(mod + (size_t)mrow * NMODC + ishift * D + 256 * j + 4 * lane), sc = *(const f32x4*)(mod + (size_t)mrow * NMODC + iscale * D + 256 * j + 4 * lane);
                y = y * (sc + 1.0f) + sh; }
            if constexpr (OUT_BF16) { u32x2 w; w.x = pk2(y[0], y[1]); w.y = pk2(y[2], y[3]); *(u32x2*)(ub + (size_t)row * D + 256 * j + 4 * lane) = w; }
            else *(f32x4*)(of + (size_t)row * D + 256 * j + 4 * lane) = y;
        }
    }
}

__device__ __forceinline__ void adaln_item(LAS unsigned char* lds, int item, const float* wada, const float* bada, float* MOD) {
    LAS float* SC = (LAS float*)lds;
    LAS float* RED = (LAS float*)(lds + 36864);
    const int tid = threadIdx.x, col = tid & 63, kg = tid >> 6, n0 = item * 64;
    float acc[9];
#pragma unroll
    for (int r = 0; r < 9; ++r) acc[r] = 0.f;
    for (int k = kg * 128; k < kg * 128 + 128; ++k) {
        const float w = wada[(size_t)k * NMODC + n0 + col];
#pragma unroll
        for (int r = 0; r < 9; ++r) acc[r] += SC[r * 1024 + k] * w;
    }
#pragma unroll
    for (int r = 0; r < 9; ++r) RED[(kg * 9 + r) * 64 + col] = acc[r];
    __syncthreads();
    for (int idx = tid; idx < 576; idx += 512) {
        const int r = idx >> 6, c = idx & 63; float s = bada[n0 + c];
#pragma unroll
        for (int g = 0; g < 8; ++g) s += RED[(g * 9 + r) * 64 + c];
        MOD[(size_t)r * NMODC + n0 + c] = s;
    }
    __syncthreads();
}

__device__ __forceinline__ void aop_rows(int row_begin, int row_end, int row_step, bf16* OF, const bf16* OB, const bf16* SG, const float* hgn) {
    const int lane = tid_opaque() & 63;
    float gn[16];
#pragma unroll
    for (int j = 0; j < 4; ++j) { const f32x4 t = *(const f32x4*)(hgn + (lane & 7) * 16 + 4 * j); gn[4 * j] = t[0]; gn[4 * j + 1] = t[1]; gn[4 * j + 2] = t[2]; gn[4 * j + 3] = t[3]; }
    for (int row = row_begin; row < row_end; row += row_step) {
        const size_t off = (size_t)row * D + 16 * lane;
        const u32x4 f0 = *(const u32x4*)(OF + off), f1 = *(const u32x4*)(OF + off + 8);
        const u32x4 b0 = *(const u32x4*)(OB + off), b1 = *(const u32x4*)(OB + off + 8);
        const u32x4 s0 = *(const u32x4*)(SG + off), s1 = *(const u32x4*)(SG + off + 8);
        float o[16], sg[16];
#pragma unroll
        for (int j = 0; j < 4; ++j) {
            o[2 * j] = bflo(f0[j]) + bflo(b0[j]); o[2 * j + 1] = bfhi(f0[j]) + bfhi(b0[j]);
            o[8 + 2 * j] = bflo(f1[j]) + bflo(b1[j]); o[8 + 2 * j + 1] = bfhi(f1[j]) + bfhi(b1[j]);
            sg[2 * j] = bflo(s0[j]); sg[2 * j + 1] = bfhi(s0[j]); sg[8 + 2 * j] = bflo(s1[j]); sg[8 + 2 * j + 1] = bfhi(s1[j]);
        }
        float ss = 0.f;
#pragma unroll
        for (int j = 0; j < 16; ++j) ss += o[j] * o[j];
        ss += __shfl_xor(ss, 1); ss += __shfl_xor(ss, 2); ss += __shfl_xor(ss, 4);
        const float rinv = rsqrtf(ss * (1.0f / 128.0f) + EPS);
        float a[16];
#pragma unroll
        for (int j = 0; j < 16; ++j) a[j] = o[j] * rinv * gn[j] * sg[j];
        u32x4 w0, w1;
        w0.x = pk2(a[0], a[1]); w0.y = pk2(a[2], a[3]); w0.z = pk2(a[4], a[5]); w0.w = pk2(a[6], a[7]);
        w1.x = pk2(a[8], a[9]); w1.y = pk2(a[10], a[11]); w1.z = pk2(a[12], a[13]); w1.w = pk2(a[14], a[15]);
        *(u32x4*)(OF + off) = w0; *(u32x4*)(OF + off + 8) = w1;
    }
}

__device__ __forceinline__ void conv_items(LAS unsigned char* lds, int item_begin, int item_end, int item_step, const bf16* GLU, const float* wdw, const float* bdw, const float* lng, const float* lnb, bf16* BOP) {
    constexpr int TT = 16;
    LAS float* P1 = (LAS float*)lds;
    LAS float* P2 = (LAS float*)(lds + 65536);
    LAS float* ST = (LAS float*)(lds + 131072);
    const int tid = tid_opaque(), c = 2 * tid;
    float w[31][2];
#pragma unroll
    for (int j = 0; j < 31; ++j) { w[j][0] = wdw[j * D + c]; w[j][1] = wdw[j * D + c + 1]; }
    const float bd0 = bdw[c], bd1 = bdw[c + 1], g0 = lng[c], g1 = lng[c + 1], b0 = lnb[c], b1 = lnb[c + 1];
    for (int item = item_begin; item < item_end; item += item_step) {
        const int b = item / (SEQ / TT), t0 = (item % (SEQ / TT)) * TT;
        float y[TT][2];
        unsigned xw[TT + 30];
#pragma unroll
        for (int r = 0; r < TT + 30; ++r) {
            const int pos = t0 - 15 + r;
            xw[r] = 0u;
            if (pos >= 0 && pos < SEQ) xw[r] = *(const unsigned*)(GLU + (size_t)(b * SEQ + pos) * D + c);
        }
        typedef float f32x2_t __attribute__((ext_vector_type(2)));
        f32x2_t xf[TT + 30];
#pragma unroll
        for (int r = 0; r < TT + 30; ++r) { xf[r].x = bflo(xw[r]); xf[r].y = bfhi(xw[r]); }
#pragma unroll
        for (int t = 0; t < TT; ++t) {
            f32x2_t a2; a2.x = bd0; a2.y = bd1;
#pragma unroll
            for (int j = 0; j < 31; ++j) { f32x2_t w2; w2.x = w[j][0]; w2.y = w[j][1]; a2 = __builtin_elementwise_fma(xf[t + j], w2, a2); }
            y[t][0] = a2.x; y[t][1] = a2.y;
        }
#pragma unroll
        for (int t = 0; t < TT; ++t) { P1[t * 512 + tid] = y[t][0] + y[t][1]; P2[t * 512 + tid] = y[t][0] * y[t][0] + y[t][1] * y[t][1]; }
        __syncthreads();
        {
            const int t = tid >> 5, part = tid & 31; float s = 0.f, q = 0.f;
#pragma unroll
            for (int j = 0; j < 4; ++j) { const f32x4 a = *(const LAS f32x4*)(P1 + t * 512 + part * 16 + 4 * j), bq = *(const LAS f32x4*)(P2 + t * 512 + part * 16 + 4 * j);
                s += (a[0] + a[1]) + (a[2] + a[3]); q += (bq[0] + bq[1]) + (bq[2] + bq[3]); }
#pragma unroll
            for (int o = 16; o >= 1; o >>= 1) { s += __shfl_xor(s, o); q += __shfl_xor(q, o); }
            if (part == 0) { const float mean = s * (1.0f / D); const float var = fmaxf(q * (1.0f / D) - mean * mean, 0.f); ST[2 * t] = mean; ST[2 * t + 1] = rsqrtf(var + EPS); }
        }
        __syncthreads();
#pragma unroll
        for (int t = 0; t < TT; ++t) {
            const float mean = ST[2 * t], rstd = ST[2 * t + 1];
            const float v0 = (y[t][0] - mean) * rstd * g0 + b0, v1 = (y[t][1] - mean) * rstd * g1 + b1;
            *(unsigned*)(BOP + (size_t)(b * SEQ + t0 + t) * D + c) = pk2(siluf_(v0), siluf_(v1));
        }
        __syncthreads();
    }
}

__device__ __forceinline__ size_t scan_rowbase(int ci, int t, int dir, int b) {
    const bool ctx = ci < 8; const int lc = ctx ? ci : ci - 8, nch = ctx ? 8 : 128;
    const int p0 = dir ? (nch - 1 - lc) * 32 : lc * 32; const int pos = dir ? p0 + 31 - t : p0 + t;
    return ctx ? (size_t)(ML + b * CTXL + pos) : (size_t)(b * SEQ + pos);
}
constexpr int S2_QS = 0, S2_KS = 26112, S2_KET = 43520, S2_VT = 74240, S2_DEC = 89600, S2_AS = 91136, S2_ST = 96256;
constexpr int QROW = 272, SROW = 80;
struct ScanRegs { u32x4 q, g, v; };
struct ScanCtx { const bf16* Q; const f16* G; const bf16* V; bf16* O; int b, h, dvh, dir, w, lane, l15, q4, tau, cg; };

__device__ __forceinline__ void scan_issue(const ScanCtx& c, int ci, ScanRegs& r) {
    const size_t row = scan_rowbase(ci, c.tau, c.dir, c.b);
    const size_t qrow = (ci >= 8) ? row : (size_t)(c.b * SEQ + c.tau);
    const int d0 = 16 * c.w + 8 * c.cg;
    r.g = *(const u32x4*)(c.G + row * D + c.h * 128 + d0);
    r.q = *(const u32x4*)(c.Q + qrow * D + c.h * 128 + d0);
    r.v = *(const u32x4*)(c.V + row * D + c.h * 128 + c.dvh * 64 + 8 * c.w);
}
template <int CTRL, int ROWMASK> __device__ __forceinline__ float dpp_mul_(float x) {
    const int y = __builtin_amdgcn_update_dpp(0x3f800000, __float_as_int(x), CTRL, ROWMASK, 0xF, false);
    return x * __int_as_float(y);
}
__device__ __forceinline__ void scan_E(LAS unsigned char* lds, const ScanCtx& c, int ci, const ScanRegs& r) {
    const bool lat = ci >= 8; const int s3 = ci % 3, s2 = ci & 1; const int tau = c.tau, d0 = 16 * c.w + 8 * c.cg;
    float f[8], P[8];
    { const f16x8 gh = __builtin_bit_cast(f16x8, r.g);
#pragma unroll
      for (int j = 0; j < 8; ++j) { P[j] = __builtin_amdgcn_exp2f((float)gh[j]); f[j] = 1.0f - P[j]; } }
#define DPP8(ctrl) "v_mul_f32_dpp %0, %0, %0 " ctrl "\n\tv_mul_f32_dpp %1, %1, %1 " ctrl "\n\tv_mul_f32_dpp %2, %2, %2 " ctrl "\n\tv_mul_f32_dpp %3, %3, %3 " ctrl "\n\t" \
                   "v_mul_f32_dpp %4, %4, %4 " ctrl "\n\tv_mul_f32_dpp %5, %5, %5 " ctrl "\n\tv_mul_f32_dpp %6, %6, %6 " ctrl "\n\tv_mul_f32_dpp %7, %7, %7 " ctrl "\n\t"
    asm volatile("s_nop 1\n\t"
                 DPP8("row_shr:1 row_mask:0xf bank_mask:0xf") DPP8("row_shr:2 row_mask:0xf bank_mask:0xf") DPP8("row_shr:4 row_mask:0xf bank_mask:0xf")
                 DPP8("row_shr:8 row_mask:0xf bank_mask:0xf") DPP8("row_bcast:15 row_mask:0xa bank_mask:0xf") "s_nop 1"
                 : "+v"(P[0]), "+v"(P[1]), "+v"(P[2]), "+v"(P[3]), "+v"(P[4]), "+v"(P[5]), "+v"(P[6]), "+v"(P[7]));
#undef DPP8
    float kt[8], qg[8];
    const unsigned qw[4] = {r.q.x, r.q.y, r.q.z, r.q.w};
#pragma unroll
    for (int j = 0; j < 8; ++j) {
        const float k = f[j];
        float pc; asm("v_max_f32 %0, %1, %2" : "=v"(pc) : "v"(P[j]), "v"(1e-30f));
        kt[j] = k * __builtin_amdgcn_rcpf(pc);
        const float qv = (j & 1) ? bfhi(qw[j >> 1]) : bflo(qw[j >> 1]);
        qg[j] = qv * P[j];
    }
    u32x4 wk; wk.x = pk2(kt[0], kt[1]); wk.y = pk2(kt[2], kt[3]); wk.z = pk2(kt[4], kt[5]); wk.w = pk2(kt[6], kt[7]);
    *(LAS u32x4*)(lds + S2_KS + s2 * 8704 + tau * QROW + d0 * 2) = wk;
    if (lat) { u32x4 wq; wq.x = pk2(qg[0], qg[1]); wq.y = pk2(qg[2], qg[3]); wq.z = pk2(qg[4], qg[5]); wq.w = pk2(qg[6], qg[7]);
        *(LAS u32x4*)(lds + S2_QS + s3 * 8704 + tau * QROW + d0 * 2) = wq; }
    { const unsigned kw[4] = {wk.x, wk.y, wk.z, wk.w};
#pragma unroll
      for (int j = 0; j < 4; ++j) {
        *(LAS unsigned short*)(lds + S2_KET + s3 * 10240 + (d0 + 2 * j) * SROW + tau * 2) = (unsigned short)(kw[j] & 0xffffu);
        *(LAS unsigned short*)(lds + S2_KET + s3 * 10240 + (d0 + 2 * j + 1) * SROW + tau * 2) = (unsigned short)(kw[j] >> 16); } }
    if (tau == 31) { LAS float* DC = (LAS float*)(lds + S2_DEC + s3 * 512);
        *(LAS f32x4*)(DC + d0) = (f32x4){P[0], P[1], P[2], P[3]};
        *(LAS f32x4*)(DC + d0 + 4) = (f32x4){P[4], P[5], P[6], P[7]}; }
    if (c.lane < 32) { const unsigned vw[4] = {r.v.x, r.v.y, r.v.z, r.v.w};
#pragma unroll
        for (int j = 0; j < 4; ++j) {
            *(LAS unsigned short*)(lds + S2_VT + s3 * 5120 + (8 * c.w + 2 * j) * SROW + tau * 2) = (unsigned short)(vw[j] & 0xffffu);
            *(LAS unsigned short*)(lds + S2_VT + s3 * 5120 + (8 * c.w + 2 * j + 1) * SROW + tau * 2) = (unsigned short)(vw[j] >> 16); } }
}
__device__ __forceinline__ void scan_A(LAS unsigned char* lds, const ScanCtx& c, int ci) {
    if (c.w >= 3) return;
    const int s3 = ci % 3, s2 = ci & 1; const int l15 = c.l15, q4 = c.q4;
    const LAS unsigned char* QS = lds + S2_QS + s3 * 8704; const LAS unsigned char* KS = lds + S2_KS + s2 * 8704;
    const int ti = (c.w == 0) ? 0 : 1, sj = (c.w == 2) ? 1 : 0;
    f32x4 a4 = (f32x4){0.f, 0.f, 0.f, 0.f};
#pragma unroll
    for (int kk = 0; kk < 4; ++kk) {
        const bf16x8 xa = *(const LAS bf16x8*)(KS + (sj * 16 + l15) * QROW + kk * 64 + q4 * 16);
        const bf16x8 yb = *(const LAS bf16x8*)(QS + (ti * 16 + l15) * QROW + kk * 64 + q4 * 16);
        a4 = __builtin_amdgcn_mfma_f32_16x16x32_bf16(xa, yb, a4, 0, 0, 0);
    }
    const int t = ti * 16 + l15, s0 = sj * 16 + 4 * q4;
    const float m0 = (s0 <= t) ? a4[0] : 0.f, m1 = (s0 + 1 <= t) ? a4[1] : 0.f, m2 = (s0 + 2 <= t) ? a4[2] : 0.f, m3 = (s0 + 3 <= t) ? a4[3] : 0.f;
    u32x2 wa; wa.x = pk2(m0, m1); wa.y = pk2(m2, m3);
    *(LAS u32x2*)(lds + S2_AS + s2 * 2560 + t * SROW + s0 * 2) = wa;
}
__device__ __forceinline__ void scan_M(LAS unsigned char* lds, const ScanCtx& c, int ci, f32x4 (&accS)[4]) {
    const bool lat = ci >= 8; const int s3 = ci % 3, s2 = ci & 1; const int l15 = c.l15, q4 = c.q4, w = c.w;
    const LAS unsigned char* QS = lds + S2_QS + s3 * 8704; const LAS unsigned char* KET = lds + S2_KET + s3 * 10240; const LAS unsigned char* VT = lds + S2_VT + s3 * 5120;
    const LAS unsigned char* STr = lds + S2_ST + s2 * 17408; LAS unsigned char* STw = lds + S2_ST + (s2 ^ 1) * 17408;
    const int tt = w >> 2, et = w & 3;
    if (lat) {
        f32x4 acco = (f32x4){0.f, 0.f, 0.f, 0.f};
#pragma unroll
        for (int kk = 0; kk < 4; ++kk) {
            const bf16x8 xa = *(const LAS bf16x8*)(STr + (et * 16 + l15) * QROW + kk * 64 + q4 * 16);
            const bf16x8 yb = *(const LAS bf16x8*)(QS + (tt * 16 + l15) * QROW + kk * 64 + q4 * 16);
            acco = __builtin_amdgcn_mfma_f32_16x16x32_bf16(xa, yb, acco, 0, 0, 0);
        }
        {
            const bf16x8 xa = *(const LAS bf16x8*)(VT + (et * 16 + l15) * SROW + q4 * 16);
            const bf16x8 yb = *(const LAS bf16x8*)(lds + S2_AS + s2 * 2560 + (tt * 16 + l15) * SROW + q4 * 16);
            acco = __builtin_amdgcn_mfma_f32_16x16x32_bf16(xa, yb, acco, 0, 0, 0);
        }
        const size_t r = scan_rowbase(ci, tt * 16 + l15, c.dir, c.b);
        u32x2 wo; wo.x = pk2(acco[0], acco[1]); wo.y = pk2(acco[2], acco[3]);
        { bf16* op = c.O + r * D + c.h * 128 + c.dvh * 64 + et * 16 + 4 * q4;
          asm volatile("global_store_dwordx2 %0, %1, off" :: "v"(op), "v"(wo) : "memory"); }
    }
    {
        const f32x4 dc = *(const LAS f32x4*)(lds + S2_DEC + s3 * 512 + (16 * w + 4 * q4) * 4);
        const bf16x8 xa = *(const LAS bf16x8*)(KET + (16 * w + l15) * SROW + q4 * 16);
#pragma unroll
        for (int i = 0; i < 4; ++i) {
            const bf16x8 yb = *(const LAS bf16x8*)(VT + (16 * i + l15) * SROW + q4 * 16);
            accS[i] = __builtin_amdgcn_mfma_f32_16x16x32_bf16(xa, yb, accS[i], 0, 0, 0) * dc;
        }
#pragma unroll
        for (int i = 0; i < 4; ++i) {
            u32x2 ws_; ws_.x = pk2(accS[i][0], accS[i][1]); ws_.y = pk2(accS[i][2], accS[i][3]);
            *(LAS u32x2*)(STw + (16 * i + l15) * QROW + (16 * w + 4 * q4) * 2) = ws_;
        }
    }
}
__device__ __forceinline__ void scan_item(LAS unsigned char* lds, int item, const bf16* Q, const f16* GF, const f16* GB, const bf16* V, bf16* OF, bf16* OB) {
    const int tid = tid_opaque(), lane = tid & 63;
    ScanCtx c;
    c.dvh = item & 1; c.dir = (item >> 1) & 1; c.h = (item >> 2) & 7; c.b = item >> 5;
    c.Q = Q; c.G = c.dir ? GB : GF; c.V = V; c.O = c.dir ? OB : OF;
    c.w = __builtin_amdgcn_readfirstlane(tid >> 6); c.lane = lane; c.l15 = lane & 15; c.q4 = lane >> 4; c.tau = lane & 31; c.cg = lane >> 5;
    for (int i = tid; i < (5120 + 34816) / 4; i += 512) ((LAS unsigned*)(lds + S2_AS))[i] = 0u;
    f32x4 accS[4];
#pragma unroll
    for (int i = 0; i < 4; ++i) accS[i] = (f32x4){0.f, 0.f, 0.f, 0.f};
    ScanRegs r0, r1, r2, r3;
    r0.q = r1.q = r2.q = r3.q = (u32x4){0u, 0u, 0u, 0u}; r0.v = r1.v = r2.v = r3.v = (u32x4){0u, 0u, 0u, 0u};
    scan_issue(c, 0, r0); scan_issue(c, 1, r1); scan_issue(c, 2, r2); scan_issue(c, 3, r3);
    __syncthreads();
#define SCAN_STEP(T_, R_) do { const int T = (T_); \
        __builtin_amdgcn_s_setprio(2); if (T >= 2) scan_M(lds, c, T - 2, accS); __builtin_amdgcn_s_setprio(0); \
        if (T >= 9) scan_A(lds, c, T - 1); \
        scan_E(lds, c, T, R_); { const int nx = (T + 4 < 136) ? T + 4 : 135; scan_issue(c, nx, R_); } \
        __syncthreads(); } while (0)
    for (int T0 = 0; T0 < 136; T0 += 4) { SCAN_STEP(T0, r0); SCAN_STEP(T0 + 1, r1); SCAN_STEP(T0 + 2, r2); SCAN_STEP(T0 + 3, r3); }
    scan_M(lds, c, 134, accS); scan_A(lds, c, 135); __syncthreads();
    scan_M(lds, c, 135, accS); __syncthreads();
    asm volatile("s_waitcnt vmcnt(0)" ::: "memory");
#undef SCAN_STEP
}

#define XB_TMO      128
#define XB_XCNT(j)  (256  + 64 * (j))
#define XB_XSUB(j)  (1280 + 64 * (j))
#define XB_XGEN(j)  (2304 + 64 * (j))
#define XB_TOP      3328
#define XB_TOPGEN   3392
#define XCD_BAR_WORDS 3456
#define XB_SPIN_CAP (1u << 18)

__device__ __forceinline__ unsigned xb_ld(unsigned* p)              { return __hip_atomic_load(p, __ATOMIC_RELAXED, __HIP_MEMORY_SCOPE_AGENT); }
__device__ __forceinline__ unsigned xb_add(unsigned* p, unsigned v) { return __hip_atomic_fetch_add(p, v, __ATOMIC_RELAXED, __HIP_MEMORY_SCOPE_AGENT); }
__device__ __forceinline__ unsigned xb_xcc_id() { return (unsigned)__builtin_amdgcn_s_getreg((3 << 11) | 20) & 0xFu; }
#define XB_SPIN(cond, bar) do { unsigned _sp = 0; while (cond) { __builtin_amdgcn_s_sleep(1); \
    if ((++_sp & 255u) == 0u) { if (xb_ld(&(bar)[XB_TMO])) break; if (_sp > XB_SPIN_CAP) { atomicAdd(&(bar)[XB_TMO], 1u); break; } } } } while (0)

struct XcdBarrier {
    unsigned* bar; unsigned x;
    volatile LAS unsigned* st;
};

__device__ __forceinline__ XcdBarrier xcd_barrier_post(unsigned* bar, volatile LAS unsigned* st) {
    XcdBarrier b; b.bar = bar; b.x = xb_xcc_id(); b.st = st;
    if (threadIdx.x == 0) (void)xb_add(&bar[XB_XCNT(b.x)], 1u);
    return b;
}
__device__ __forceinline__ void xcd_barrier_complete(unsigned* bar, unsigned x, unsigned& nloc, unsigned& nx) {
    const unsigned G = gridDim.x * gridDim.y * gridDim.z;
    unsigned sum, cnt, mine, sp = 0u;
    for (;;) {
        sum = 0u; cnt = 0u; mine = 0u;
#pragma unroll
        for (unsigned j = 0; j < 16; ++j) { const unsigned c = xb_ld(&bar[XB_XCNT(j)]); sum += c; cnt += (c > 0u) ? 1u : 0u; mine = (j == x) ? c : mine; }
        if (sum == G) break;
        __builtin_amdgcn_s_sleep(1);
        if ((++sp & 255u) == 0u) { if (xb_ld(&bar[XB_TMO])) break; if (sp > XB_SPIN_CAP) { atomicAdd(&bar[XB_TMO], 1u); break; } }
    }
    nloc = mine > 0u ? mine : 1u; nx = cnt > 0u ? cnt : 1u;
}

__device__ __forceinline__ void xcd_barrier(const XcdBarrier& b) {
    asm volatile("s_waitcnt vmcnt(0)" ::: "memory");
    __syncthreads();
    if (threadIdx.x == 0) {
        unsigned* bar = b.bar;
        __builtin_amdgcn_s_waitcnt(0);
        unsigned nloc = b.st[0], nx = b.st[1];
        if (nloc == 0u) { xcd_barrier_complete(bar, b.x, nloc, nx); b.st[0] = nloc; b.st[1] = nx; }
        const unsigned old = xb_add(&bar[XB_XSUB(b.x)], 1u);
        const unsigned gen = old / nloc;
        if (old + 1u == (gen + 1u) * nloc) {
            __builtin_amdgcn_fence(__ATOMIC_RELEASE, "agent");
            asm volatile("s_waitcnt vmcnt(0)" ::: "memory");
            const unsigned og = xb_add(&bar[XB_TOP], 1u);
            const unsigned tg = og / nx;
            if (og + 1u == (tg + 1u) * nx) xb_add(&bar[XB_TOPGEN], 1u);
            else XB_SPIN(xb_ld(&bar[XB_TOPGEN]) == tg, bar);
            __builtin_amdgcn_fence(__ATOMIC_ACQUIRE, "agent");
            xb_add(&bar[XB_XGEN(b.x)], 1u);
            asm volatile("s_waitcnt vmcnt(0)" ::: "memory");
        } else {
            XB_SPIN(xb_ld(&bar[XB_XGEN(b.x)]) == gen, bar);
            __builtin_amdgcn_fence(__ATOMIC_ACQUIRE, "agent");
            asm volatile("s_waitcnt vmcnt(0)" ::: "memory");
        }
    }
    __syncthreads();
}

__global__ void __launch_bounds__(512, 2) mega(Params P) {
    extern __shared__ __attribute__((aligned(16))) unsigned char lds_raw[];
    LAS unsigned char* lds = (LAS unsigned char*)lds_raw;
#define GRID_SYNC() xcd_barrier(xbar)
    if (threadIdx.x < 2) ((volatile LAS unsigned*)(lds + 131072 + 1024))[threadIdx.x] = 0u;
    __syncthreads();
    XcdBarrier xbar = xcd_barrier_post((unsigned*)(P.ws + WS_BAR), (volatile LAS unsigned*)(lds + 131072 + 1024));
    const int tid = threadIdx.x, G = gridDim.x, bid = blockIdx.x;
    unsigned char* ws = P.ws;
    bf16* WUP = (bf16*)(ws + WS_WUP); bf16* WDN = (bf16*)(ws + WS_WDN); bf16* WIN = (bf16*)(ws + WS_WIN);
    bf16* WPA = (bf16*)(ws + WS_WPA); bf16* WPB = (bf16*)(ws + WS_WPB); bf16* WO = (bf16*)(ws + WS_WO);
    float* MOD = (float*)(ws + WS_MOD); float* LBF = MOD + 9 * NMODC; float* LBB = LBF + 1024;
    bf16* U = (bf16*)(ws + WS_U);
    bf16* H = (bf16*)(ws + R_H); float* HC1 = (float*)(ws + R_HC1);
    bf16* Qb = (bf16*)(ws + R_Q); f16* GFb = (f16*)(ws + R_GF); f16* GBb = (f16*)(ws + R_GB); bf16* Vb = (bf16*)(ws + R_V);
    bf16* OFb = (bf16*)(ws + R_OF); bf16* OBb = (bf16*)(ws + R_OB);
    bf16* SGb = (bf16*)(ws + R_SG); bf16* GLUb = (bf16*)(ws + R_GLU); bf16* GATESb = (bf16*)(ws + R_GATES);
    bf16* BOP = U; bf16* Tb = OBb;
    bf16* H2B = OFb;
    bf16* DLT = (bf16*)(ws + WS_R + 192 * MiB);
    float* PART = (float*)(ws + WS_R + 192 * MiB);
    float* OUT = P.out;

    {
        if (bid < 144) {
            LAS float* SC = (LAS float*)lds;
            for (int i = tid; i < 9 * 1024; i += 512) { const float v = (i < 8192) ? P.in[I_C][i] : P.in[I_CCTX][i - 8192]; SC[i] = siluf_(v); }
            __syncthreads();
            for (int item = bid; item < 144; item += G) adaln_item(lds, item, P.in[I_WADA], P.in[I_BADA], MOD);
        }
        if (bid == G - 1) {
            const float* l = P.in[I_LBL];
            for (int d = tid; d < 1024; d += 512) { LBF[d] = 1.0f / (1.0f + __expf(l[2048 + d] - l[d])); LBB[d] = 1.0f / (1.0f + __expf(l[3072 + d] - l[1024 + d])); }
        }
        for (int it = (bid + 112) % G; it < 2592; it += G) {
            if (it < 704) conv_job_item(lds, it, P.in[I_W1U], 1024, 5632, WUP, 0, 0, 2816);
            else if (it < 1056) conv_job_item(lds, it - 704, P.in[I_W1D], 2816, 1024, WDN, 0, -1, 0);
            else if (it < 1952) conv_job_item(lds, it - 1056, P.in[I_WIN], 1024, 7168, WIN, 0, 5120, 1024);
            else if (it < 2208) conv_job_item(lds, it - 1952, P.in[I_WG], 1024, 2048, WIN, 7168, -1, 0);
            else if (it < 2336) conv_job_item(lds, it - 2208, P.in[I_WPA], 1024, 1024, WPA, 0, -1, 0);
            else if (it < 2464) conv_job_item(lds, it - 2336, P.in[I_WPB], 1024, 1024, WPB, 0, -1, 0);
            else conv_job_item(lds, it - 2464, P.in[I_WO], 1024, 1024, WO, 0, -1, 0);
        }
    }
    GRID_SYNC();
    normmod_phase<true, true>(P.in[I_X], P.in[I_CTX], MT, P.in[I_NF1], MOD, 0, 1, U, OUT);
    GRID_SYNC();
    { pg8::Gemm g{U, WUP, MT, 2 * FF, D, D}; pg8::StaticOrder S; S.init(MT, 2 * FF, G, bid); EpiSwiglu E{H, FF}; pg8::gemm_phase<EpiSwiglu, pg8::StaticOrder, GEMM_ALIGN, GEMM_SP2>(lds, g, S, E, nullptr); }
    GRID_SYNC();
    { pg8::Gemm g{H, WDN, ML, D, FF, FF}; pg8::StaticOrder S; S.init(ML, D, G, bid); EpiRes E{P.in[I_X], OUT, P.in[I_CTX], HC1, MOD, 2, 0.5f}; pg8::gemm_phase<EpiRes, pg8::StaticOrder, GEMM_ALIGN, GEMM_SP2>(lds, g, S, E, nullptr); }
    { pg8::Gemm g{H, WDN, MT, D, 256, FF}; KSplitOrder S{G, bid}; EpiPart E{PART}; pg8::gemm_phase<EpiPart, KSplitOrder, GEMM_ALIGN, GEMM_SP2>(lds, g, S, E, nullptr); }
    GRID_SYNC();
    normmod_phase<true, true, true>(OUT, P.in[I_CTX], MT, P.in[I_NMIX], MOD, 3, 4, U, OUT, PART, 2);
    GRID_SYNC();
    { pg8::Gemm g{U, WIN, MT, 4096, D, D}; pg8::StaticOrder S; S.init(MT, 4096, G, bid); EpiMix1 E{Qb, GFb, GBb, Vb, LBF, LBB}; pg8::gemm_phase<EpiMix1, pg8::StaticOrder, GEMM_ALIGN, GEMM_SP2>(lds, g, S, E, nullptr); }
    GRID_SYNC();
    for (int item = bid; item < 256; item += G) scan_item(lds, item, Qb, GFb, GBb, Vb, OFb, OBb);
    GRID_SYNC();
    { pg8::Gemm g{U, WIN + (size_t)4096 * D, ML, 5120, D, D}; pg8::StaticOrder S; S.init(ML, 5120, G, bid); EpiMix2 E{SGb, GLUb, GATESb, P.in[I_BG]}; pg8::gemm_phase<EpiMix2, pg8::StaticOrder, GEMM_ALIGN, GEMM_SP2>(lds, g, S, E, nullptr); }
    GRID_SYNC();
    {
        conv_items(lds, bid, 2048, G, GLUb, P.in[I_WDW], P.in[I_BDW], P.in[I_LNG], P.in[I_LNB], BOP);
        aop_rows(bid * 8 + (tid >> 6), ML, G * 8, OFb, OBb, SGb, P.in[I_HGN]);
        for (int it = bid; it < 1056; it += G) {
            if (it < 704) conv_job_item(lds, it, P.in[I_W2U], 1024, 5632, WUP, 0, 0, 2816);
            else conv_job_item(lds, it - 704, P.in[I_W2D], 2816, 1024, WDN, 0, -1, 0);
        }
    }
    GRID_SYNC();
    { pg8::Gemm g{OFb, WPA, ML, D, D, D}; pg8::StaticOrder S; S.init(ML, D, G, bid); EpiGate<0> E{GATESb, Tb, 0}; pg8::gemm_phase<EpiGate<0>, pg8::StaticOrder, GEMM_ALIGN, GEMM_SP2>(lds, g, S, E, nullptr); }
    GRID_SYNC();
    { pg8::Gemm g{BOP, WPB, ML, D, D, D}; pg8::StaticOrder S; S.init(ML, D, G, bid); EpiGate<1> E{GATESb, Tb, 1024}; pg8::gemm_phase<EpiGate<1>, pg8::StaticOrder, GEMM_ALIGN, GEMM_SP2>(lds, g, S, E, nullptr); }
    GRID_SYNC();
    { pg8::Gemm g{Tb, WO, ML, D, D, D}; pg8::StaticOrder S; S.init(ML, D, G, bid); EpiResB E{OUT, H2B, MOD, 5, 1.0f}; pg8::gemm_phase<EpiResB, pg8::StaticOrder, GEMM_ALIGN, GEMM_SP2>(lds, g, S, E, nullptr); }
    GRID_SYNC();
    normmod_phase<true, true, false, false, true>((const float*)H2B, HC1, ML, P.in[I_NF2], MOD, 6, 7, U, OUT);
    GRID_SYNC();
    { pg8::Gemm g{U, WUP, ML, 2 * FF, D, D}; pg8::StaticOrder S; S.init(ML, 2 * FF, G, bid); EpiSwiglu E{H, FF}; pg8::gemm_phase<EpiSwiglu, pg8::StaticOrder, GEMM_ALIGN, GEMM_SP2>(lds, g, S, E, nullptr); }
    GRID_SYNC();
    { pg8::Gemm g{H, WDN, ML, D, FF, FF}; pg8::StaticOrder S; S.init(ML, D, G, bid); EpiDelta E{DLT, MOD, 8, 0.5f}; pg8::gemm_phase<EpiDelta, pg8::StaticOrder, GEMM_ALIGN, GEMM_SP2>(lds, g, S, E, nullptr); }
    GRID_SYNC();
    normmod_phase<false, false, false, true, true>((const float*)H2B, HC1, ML, P.in[I_FN], MOD, 0, 0, U, OUT, nullptr, 0, DLT);
}

extern "C" void kernel_launch(void* const* d_in, const int* in_sizes, int n_in, void* d_out, int out_size, void* d_ws, size_t ws_size, hipStream_t stream) {
    static int grid = 0;
    if (grid == 0) {
        if (n_in != 26 || ws_size < WS_NEED) { fprintf(stderr, "kernel_launch: n_in %d ws %zu (need %zu)\n", n_in, ws_size, (size_t)WS_NEED); grid = -1; return; }
        int dev = 0, cus = 0, per_cu = 0;
        hipGetDevice(&dev); hipDeviceGetAttribute(&cus, hipDeviceAttributeMultiprocessorCount, dev);
        if (hipFuncSetAttribute((const void*)mega, hipFuncAttributeMaxDynamicSharedMemorySize, LDS_BYTES) != hipSuccess) { fprintf(stderr, "hipFuncSetAttribute failed\n"); grid = -1; return; }
        if (hipOccupancyMaxActiveBlocksPerMultiprocessor(&per_cu, (const void*)mega, 512, LDS_BYTES) != hipSuccess || per_cu < 1) { fprintf(stderr, "occupancy query: %d\n", per_cu); grid = -1; return; }
        grid = cus;
    }
    if (grid < 0) return;
    if (hipMemsetAsync((char*)d_ws + WS_BAR, 0, XCD_BAR_WORDS * sizeof(unsigned), stream) != hipSuccess) { fprintf(stderr, "memset failed\n"); return; }
    Params p{};
    for (int i = 0; i < 26; ++i) p.in[i] = (const float*)d_in[i];
    p.out = (float*)d_out; p.ws = (unsigned char*)d_ws;
    void* args[] = {&p};
    hipError_t e = hipLaunchCooperativeKernel((const void*)mega, dim3(grid), dim3(512), args, LDS_BYTES, stream);
    if (e != hipSuccess) fprintf(stderr, "cooperative launch failed: %s (grid %d)\n", hipGetErrorString(e), grid);
}
```

```cpp
#include <hip/hip_runtime.h>
#include <cstdio>
#define GEMM_ALIGN true
#define GEMM_SP2 true
namespace pg8 {
#define PG8_LAS __attribute__((address_space(3)))
typedef unsigned short bf16_t;
typedef short bf16x8 __attribute__((ext_vector_type(8)));
typedef float f32x4 __attribute__((ext_vector_type(4)));
typedef unsigned u32x4 __attribute__((ext_vector_type(4)));
constexpr int BM = 256, BK = 64, HALF = 128, HTB = HALF * BK * 2  , STAGE_BYTES = 8 * HTB, NXCD = 8, WGM = 8;

__host__ __device__ __forceinline__ int lds_byte(int r, int c) { const int st = (r >> 4) * 2 + (c >> 5), rr = r & 15, cc = c & 31, ob = rr * 64 + cc * 2; return st * 1024 + (ob ^ (((ob >> 9) & 1) << 5)); }
__host__ __device__ __forceinline__ void stage_rc(int b, int& R, int& C) { const int st = b / 1024, sb = b % 1024, swz = sb ^ (((sb >> 9) & 1) << 5); R = (st >> 1) * 16 + swz / 64; C = (st & 1) * 32 + (swz % 64) / 2; }
__host__ __device__ __forceinline__ int perm32(int rho) { const int n = rho >> 4, i = rho & 15; return 8 * (i >> 2) + 4 * n + (i & 3); }

struct Unit { int pm, pn, pk; };
struct Gemm { const bf16_t* A; const bf16_t* Bt; int M, N, K, Kp; };

struct StaticOrder {
    int nM, nN, nwg, G, c;
    __host__ __device__ void init(int M, int N, int G_, int c_) { nM = M / BM; nN = N / BM; nwg = nM * nN; G = G_; c = c_; }
    __host__ __device__ bool next(int i, Unit& u) const {
        const long L = (long)i * G + c; if (L >= nwg) return false;
        int wgid = (int)L; { const int q = nwg / NXCD, r = nwg % NXCD, xcd = wgid % NXCD, off = wgid / NXCD; wgid = (xcd < r ? xcd * (q + 1) : r * (q + 1) + (xcd - r) * q) + off; }
        const int nig = WGM * nN, gid = wgid / nig, fm = gid * WGM, gsz = (nM - fm) < WGM ? (nM - fm) : WGM;
        u.pm = fm + ((wgid % nig) % gsz); u.pn = (wgid % nig) / gsz; u.pk = 0; return true;
    }
    __device__ __forceinline__ void a_ready(const Unit&) const {}
    __device__ __forceinline__ void done(const Unit&) const {}
};
__device__ __forceinline__ unsigned cvt_pk_bf16(float lo, float hi) { unsigned r; asm volatile("v_cvt_pk_bf16_f32 %0, %1, %2" : "=v"(r) : "v"(lo), "v"(hi)); return r; }
template <class Epi, class Sched, bool ALIGN_EPI = false, bool SP2 = false, bool STAMP = false>
__device__ __forceinline__ void gemm_phase(PG8_LAS unsigned char* lds, const Gemm g, const Sched& S, const Epi& E, unsigned long long* stamps) {
    int tid_ = threadIdx.x; asm volatile("" : "+v"(tid_));
    const int tid = tid_, wid = __builtin_amdgcn_readfirstlane(tid >> 6), lane = tid & 63, wr = wid >> 2, wc = wid & 3, fr = lane & 15, fq = lane >> 4;
    const int K = g.Kp, nt = g.K / BK;
    int ts_lo = 0, ts_hi = 0, nts = 0; const unsigned long long rt_entry = STAMP ? (unsigned long long)wall_clock64() : 0ull;
#define PG8_STAMP() do { if (STAMP && wid == 0 && nts < 64) { const unsigned long long _c = (unsigned long long)clock64(); \
        ts_lo = (lane == nts) ? (int)(unsigned)_c : ts_lo; ts_hi = (lane == nts) ? (int)(unsigned)(_c >> 32) : ts_hi; ++nts; } } while (0)
    PG8_STAMP();
    unsigned voffA[2], voffB[2];
#pragma unroll
    for (int i = 0; i < 2; ++i) { int R, C; stage_rc(tid * 16 + i * 8192, R, C); const int Rb = Epi::PERM ? ((R & ~31) + perm32(R & 31)) : R;
        voffA[i] = (unsigned)(R * K + C) * 2u; voffB[i] = (unsigned)(Rb * K + C) * 2u; }
    const size_t kstep = (size_t)(BK * 2);
    const size_t hstep = (size_t)HALF * K * 2;
    const size_t tstep = 2 * hstep;
    const unsigned ldsw = (unsigned)wid * 1024u;
    const int aoff = lds_byte(wr * 64 + fr, fq * 8), boff = lds_byte(wc * 32 + fr, fq * 8);
#define PG8_SA(b, h) (((b) * 2 + (h)) * HTB)
#define PG8_SB(b, h) ((4 + (b) * 2 + (h)) * HTB)
#define PG8_STAGE(bufoff, gbase, voff) do { _Pragma("unroll") for (int _i = 0; _i < 2; ++_i) \
        __builtin_amdgcn_global_load_lds((const unsigned*)((const char*)(gbase) + (voff)[_i]), (PG8_LAS unsigned*)(lds + (bufoff) + ldsw + _i * 8192), 16, 0, 0); } while (0)
#define PG8_LDA(dst, b, h) do { _Pragma("unroll") for (int m = 0; m < 4; ++m) _Pragma("unroll") for (int k = 0; k < 2; ++k) dst[m][k] = *(const PG8_LAS bf16x8*)(lds + PG8_SA(b, h) + aoff + m * 2048 + k * 1024); } while (0)
#define PG8_LDB(dst, b, h) do { _Pragma("unroll") for (int n = 0; n < 2; ++n) _Pragma("unroll") for (int k = 0; k < 2; ++k) dst[n][k] = *(const PG8_LAS bf16x8*)(lds + PG8_SB(b, h) + boff + n * 2048 + k * 1024); } while (0)
#define PG8_MMA(ai, bj, At, Bt) do { __builtin_amdgcn_s_setprio(1); _Pragma("unroll") for (int m = 0; m < 4; ++m) _Pragma("unroll") for (int n = 0; n < 2; ++n) _Pragma("unroll") for (int k = 0; k < 2; ++k) \
        acc[ai][bj][m][n] = __builtin_amdgcn_mfma_f32_16x16x32_bf16(Bt[n][k], At[m][k], acc[ai][bj][m][n], 0, 0, 0); __builtin_amdgcn_s_setprio(0); } while (0)
#define PG8_WAIT_V(n) asm volatile("s_waitcnt vmcnt(" #n ")" ::: "memory")
#define PG8_WAIT_L(n) asm volatile("s_waitcnt lgkmcnt(" #n ")" ::: "memory")
#define PG8_BAR __builtin_amdgcn_s_barrier()
#define PG8_SCHED __builtin_amdgcn_sched_barrier(0)
    Unit cur, nxt; int ui = 0;
    if (!S.next(0, cur)) return;
    f32x4 acc[2][2][4][2];
#pragma unroll
    for (int a = 0; a < 2; ++a)
#pragma unroll
        for (int b = 0; b < 2; ++b)
#pragma unroll
            for (int m = 0; m < 4; ++m)
#pragma unroll
                for (int n = 0; n < 2; ++n) acc[a][b][m][n] = (f32x4){0.f, 0.f, 0.f, 0.f};
    bf16x8 At[4][2], B0[2][2], B1[2][2];
    const size_t pstep = (size_t)g.K * 2;
    const char* cA = (const char*)g.A + (size_t)cur.pm * tstep + (size_t)cur.pk * pstep; const char* cB = (const char*)g.Bt + (size_t)cur.pn * tstep + (size_t)cur.pk * pstep;
    S.a_ready(cur);
    if constexpr (SP2) {
        PG8_STAGE(PG8_SB(0, 0), cB, voffB); PG8_STAGE(PG8_SB(0, 1), cB + hstep, voffB); PG8_STAGE(PG8_SA(0, 0), cA, voffA); PG8_STAGE(PG8_SA(0, 1), cA + hstep, voffA);
        if (wr == 1) PG8_BAR;
        PG8_WAIT_V(2); PG8_BAR;
    } else {
        PG8_STAGE(PG8_SB(0, 0), cB, voffB); PG8_STAGE(PG8_SA(0, 0), cA, voffA); PG8_STAGE(PG8_SB(0, 1), cB + hstep, voffB); PG8_STAGE(PG8_SA(0, 1), cA + hstep, voffA);
        if (wr == 1) PG8_BAR;
        PG8_WAIT_V(4); PG8_BAR;
    }
    PG8_STAGE(PG8_SB(1, 0), cB + kstep, voffB); PG8_STAGE(PG8_SA(1, 0), cA + kstep, voffA); PG8_STAGE(PG8_SB(1, 1), cB + hstep + kstep, voffB);
    PG8_WAIT_V(6); PG8_BAR;
    PG8_STAMP();
    for (;;) {
        const bool has_next = S.next(ui + 1, nxt);
        const char* nA = has_next ? (const char*)g.A + (size_t)nxt.pm * tstep + (size_t)nxt.pk * pstep : cA; const char* nB = has_next ? (const char*)g.Bt + (size_t)nxt.pn * tstep + (size_t)nxt.pk * pstep : cB;
        for (int t = 0; t < nt; t += 2) {
            const bool last = (t == nt - 2);
            const char* a1 = cA + (size_t)(t + 1) * kstep;
            const char* a2 = last ? nA : cA + (size_t)(t + 2) * kstep; const char* b2 = last ? nB : cB + (size_t)(t + 2) * kstep;
            const char* a3 = a2 + kstep; const char* b3 = b2 + kstep;
            if (last && has_next) S.a_ready(nxt);
            if constexpr (SP2) {
            PG8_LDB(B0, 0, 0); PG8_LDB(B1, 0, 1); PG8_SCHED; PG8_LDA(At, 0, 0); PG8_STAGE(PG8_SA(1, 1), a1 + hstep, voffA);
            PG8_WAIT_V(8); PG8_WAIT_L(0); PG8_BAR; PG8_MMA(0, 0, At, B0); PG8_MMA(0, 1, At, B1); PG8_BAR; PG8_SCHED;
            PG8_LDA(At, 0, 1); PG8_STAGE(PG8_SB(0, 0), b2, voffB); PG8_STAGE(PG8_SB(0, 1), b2 + hstep, voffB); PG8_STAGE(PG8_SA(0, 0), a2, voffA);
            PG8_WAIT_V(8); PG8_WAIT_L(0); PG8_BAR; PG8_MMA(1, 0, At, B0); PG8_MMA(1, 1, At, B1); PG8_BAR; PG8_SCHED;
            PG8_LDB(B0, 1, 0); PG8_LDB(B1, 1, 1); PG8_SCHED; PG8_LDA(At, 1, 0); PG8_STAGE(PG8_SA(0, 1), a2 + hstep, voffA);
            PG8_WAIT_V(8); PG8_WAIT_L(0); PG8_BAR; PG8_MMA(0, 0, At, B0); PG8_MMA(0, 1, At, B1); PG8_BAR; PG8_SCHED;
            PG8_LDA(At, 1, 1); PG8_STAGE(PG8_SB(1, 0), b3, voffB); PG8_STAGE(PG8_SB(1, 1), b3 + hstep, voffB); PG8_STAGE(PG8_SA(1, 0), a3, voffA);
            PG8_WAIT_V(8); PG8_WAIT_L(0); PG8_BAR; PG8_MMA(1, 0, At, B0); PG8_MMA(1, 1, At, B1); PG8_BAR; PG8_SCHED;
            } else {
            PG8_LDB(B0, 0, 0); PG8_SCHED; PG8_LDA(At, 0, 0); PG8_STAGE(PG8_SA(1, 1), a1 + hstep, voffA);
            PG8_WAIT_L(8); PG8_BAR; PG8_WAIT_L(0); PG8_MMA(0, 0, At, B0); PG8_BAR; PG8_SCHED;
            PG8_LDB(B1, 0, 1); PG8_STAGE(PG8_SB(0, 0), b2, voffB);
            PG8_BAR; PG8_WAIT_L(0); PG8_MMA(0, 1, At, B1); PG8_BAR;
            PG8_LDA(At, 0, 1); PG8_STAGE(PG8_SA(0, 0), a2, voffA);
            PG8_BAR; PG8_WAIT_L(0); PG8_MMA(1, 0, At, B0); PG8_BAR; PG8_SCHED;
            PG8_STAGE(PG8_SB(0, 1), b2 + hstep, voffB);
            PG8_WAIT_V(6); PG8_BAR; PG8_MMA(1, 1, At, B1); PG8_BAR;
            PG8_LDB(B0, 1, 0); PG8_SCHED; PG8_LDA(At, 1, 0); PG8_STAGE(PG8_SA(0, 1), a2 + hstep, voffA);
            PG8_WAIT_L(8); PG8_BAR; PG8_WAIT_L(0); PG8_MMA(0, 0, At, B0); PG8_BAR; PG8_SCHED;
            PG8_LDB(B1, 1, 1); PG8_STAGE(PG8_SB(1, 0), b3, voffB);
            PG8_BAR; PG8_WAIT_L(0); PG8_MMA(0, 1, At, B1); PG8_BAR;
            PG8_LDA(At, 1, 1); PG8_STAGE(PG8_SA(1, 0), a3, voffA);
            PG8_BAR; PG8_WAIT_L(0); PG8_MMA(1, 0, At, B0); PG8_BAR; PG8_SCHED;
            PG8_STAGE(PG8_SB(1, 1), b3 + hstep, voffB);
            PG8_WAIT_V(6); PG8_BAR; PG8_MMA(1, 1, At, B1); PG8_BAR;
            }
        }
        PG8_STAMP();
        if constexpr (ALIGN_EPI) { if (wr == 0) PG8_BAR; }
        if constexpr (!Epi::AFTER_DRAIN) { E(acc, cur, wr, wc, fr, fq); S.done(cur); }
        PG8_STAMP();
        if (!has_next) break;
#pragma unroll
        for (int a = 0; a < 2; ++a)
#pragma unroll
            for (int b = 0; b < 2; ++b)
#pragma unroll
                for (int m = 0; m < 4; ++m)
#pragma unroll
                    for (int n = 0; n < 2; ++n) acc[a][b][m][n] = (f32x4){0.f, 0.f, 0.f, 0.f};
        cur = nxt; cA = nA; cB = nB; ++ui;
        if constexpr (ALIGN_EPI) { if (wr == 1) PG8_BAR; }
    }
    PG8_WAIT_V(0);
    if constexpr (!ALIGN_EPI) { if (wr == 0) PG8_BAR; }
    PG8_BAR;
    if constexpr (Epi::AFTER_DRAIN) { E.fused(acc, cur, wr, wc, fr, fq, lds, wid, lane); S.done(cur); }
    PG8_STAMP();
    if (STAMP && wid == 0) { stamps[lane] = lane < nts ? (((unsigned long long)(unsigned)ts_hi << 32) | (unsigned)ts_lo) : 0ull;
        if (lane == 62) stamps[62] = rt_entry; if (lane == 63) stamps[63] = (unsigned long long)wall_clock64(); }
#undef PG8_STAMP
#undef PG8_SA
#undef PG8_SB
#undef PG8_STAGE
#undef PG8_LDA
#undef PG8_LDB
#undef PG8_MMA
#undef PG8_WAIT_V
#undef PG8_WAIT_L
#undef PG8_BAR
#undef PG8_SCHED
}
}

#define LAS __attribute__((address_space(3)))
typedef unsigned short bf16;
typedef _Float16 f16;
typedef pg8::f32x4 f32x4;
typedef pg8::u32x4 u32x4;
typedef pg8::bf16x8 bf16x8;
typedef unsigned u32x2 __attribute__((ext_vector_type(2)));
typedef _Float16 f16x8 __attribute__((ext_vector_type(8)));
typedef _Float16 f16x4 __attribute__((ext_vector_type(4)));

constexpr int D = 1024, NB = 8, SEQ = 4096, CTXL = 256, ML = NB * SEQ, MC = NB * CTXL, MT = ML + MC, FF = 2816, NMODC = 9 * D;
constexpr float EPS = 1e-6f;
constexpr size_t MiB = 1ull << 20;
constexpr size_t WS_WUP = 0, WS_WDN = 11 * MiB, WS_WIN = 17 * MiB, WS_WPA = 35 * MiB, WS_WPB = 37 * MiB, WS_WO = 39 * MiB, WS_MOD = 41 * MiB,
                 WS_U = 42 * MiB, WS_R = 110 * MiB, WS_BAR = 41 * MiB + 512 * 1024;
constexpr size_t R_H = WS_R, R_HC1 = WS_R + 187 * MiB;
constexpr size_t R_Q = WS_R, R_GF = WS_R + 64 * MiB, R_GB = WS_R + 132 * MiB, R_V = WS_R + 200 * MiB, R_OF = WS_R + 268 * MiB, R_OB = WS_R + 332 * MiB;
constexpr size_t R_SG = WS_R, R_GLU = WS_R + 64 * MiB, R_GATES = WS_R + 128 * MiB;
constexpr size_t WS_NEED = WS_R + 396 * MiB;
constexpr int LDS_BYTES = 131072 + 4096;

struct Params { const float* in[26]; float* out; unsigned char* ws; };
enum { I_X = 0, I_C, I_CTX, I_CCTX, I_WADA, I_BADA, I_NF1, I_W1U, I_W1D, I_NMIX, I_WIN, I_LBL, I_HGN, I_WDW, I_BDW, I_LNG, I_LNB, I_WPA, I_WPB, I_WG, I_BG, I_WO,
       I_NF2, I_W2U, I_W2D, I_FN };

__device__ __forceinline__ int tid_opaque() { int t = threadIdx.x; asm volatile("" : "+v"(t)); return t; }
__device__ __forceinline__ float bf2f(unsigned short b) { return __uint_as_float(((unsigned)b) << 16); }
__device__ __forceinline__ float bflo(unsigned w) { return __uint_as_float(w << 16); }
__device__ __forceinline__ float bfhi(unsigned w) { return __uint_as_float(w & 0xffff0000u); }
typedef __bf16 bf2_t __attribute__((ext_vector_type(2)));
__device__ __forceinline__ unsigned pk2(float lo, float hi) { bf2_t v; v.x = (__bf16)lo; v.y = (__bf16)hi; return __builtin_bit_cast(unsigned, v); }
__device__ __forceinline__ float sigmoidf_(float x) { return __builtin_amdgcn_rcpf(1.0f + __expf(-x)); }
__device__ __forceinline__ float siluf_(float x) { return x * __builtin_amdgcn_rcpf(1.0f + __expf(-x)); }
typedef float f32x2 __attribute__((ext_vector_type(2)));
__device__ __forceinline__ f32x2 sig2_(f32x2 x) { const f32x2 t = x * (-1.44269504f); f32x2 e; e.x = __builtin_amdgcn_exp2f(t.x); e.y = __builtin_amdgcn_exp2f(t.y); const f32x2 d = e + 1.0f; f32x2 r; r.x = __builtin_amdgcn_rcpf(d.x); r.y = __builtin_amdgcn_rcpf(d.y); return r; }
__device__ __forceinline__ f32x4 sig4_(f32x4 x) { const f32x2 lo = sig2_(__builtin_shufflevector(x, x, 0, 1)), hi = sig2_(__builtin_shufflevector(x, x, 2, 3)); return (f32x4){lo.x, lo.y, hi.x, hi.y}; }
__device__ __forceinline__ f32x4 silu4_(f32x4 x) { return x * sig4_(x); }
__device__ __forceinline__ u32x2 pk4(f32x4 v) { u32x2 w; w.x = pk2(v[0], v[1]); w.y = pk2(v[2], v[3]); return w; }

struct EpiSwiglu {
    static constexpr bool PERM = true, AFTER_DRAIN = false;
    bf16* H; int ldh;
    __device__ __forceinline__ void operator()(const f32x4 (&acc)[2][2][4][2], const pg8::Unit& u, int wr, int wc, int fr, int fq) const {
        const int row0 = u.pm * 256 + wr * 64 + fr, col0 = u.pn * 128 + wc * 32 + 8 * fq;
#pragma unroll
        for (int ai = 0; ai < 2; ++ai)
#pragma unroll
            for (int m = 0; m < 4; ++m) {
                bf16* rowp = H + (size_t)(row0 + ai * 128 + m * 16) * ldh + col0;
                const u32x2 w0 = pk4(silu4_(acc[ai][0][m][0]) * acc[ai][1][m][0]), w1 = pk4(silu4_(acc[ai][0][m][1]) * acc[ai][1][m][1]);
                *(u32x4*)rowp = (u32x4){w0.x, w0.y, w1.x, w1.y};
            }
    }
};

struct EpiRes {
    static constexpr bool PERM = false, AFTER_DRAIN = false;
    const float* baseL; float* outL; const float* baseC; float* outC; const float* mod; int gidx; float coef;
    __device__ __forceinline__ void operator()(const f32x4 (&acc)[2][2][4][2], const pg8::Unit& u, int wr, int wc, int fr, int fq) const {
        const bool lat = u.pm < 128;
        const int prow = (lat ? u.pm : u.pm - 128) * 256 + wr * 64 + fr;
        const float* base = lat ? baseL : baseC; float* out = lat ? outL : outC;
        const float* gate = mod + (size_t)(lat ? (u.pm >> 4) : 8) * NMODC + gidx * D;
        const int col0 = u.pn * 256 + wc * 32 + 4 * fq;
        f32x4 gv[2][2];
#pragma unroll
        for (int bj = 0; bj < 2; ++bj)
#pragma unroll
            for (int n = 0; n < 2; ++n) gv[bj][n] = *(const f32x4*)(gate + col0 + bj * 128 + n * 16) * coef;
#pragma unroll
        for (int ai = 0; ai < 2; ++ai)
#pragma unroll
            for (int m = 0; m < 4; ++m) {
                const size_t off = (size_t)(prow + ai * 128 + m * 16) * D + col0;
#pragma unroll
                for (int bj = 0; bj < 2; ++bj)
#pragma unroll
                    for (int n = 0; n < 2; ++n) {
                        const f32x4 bs = *(const f32x4*)(base + off + bj * 128 + n * 16);
                        *(f32x4*)(out + off + bj * 128 + n * 16) = bs + gv[bj][n] * acc[ai][bj][m][n];
                    }
            }
    }
};


template <bool BASEB> struct EpiResB {
    static constexpr bool PERM = false, AFTER_DRAIN = false;
    const float* base; bf16* outb; const float* mod; int gidx; float coef;
    __device__ __forceinline__ void operator()(const f32x4 (&acc)[2][2][4][2], const pg8::Unit& u, int wr, int wc, int fr, int fq) const {
        const int prow = u.pm * 256 + wr * 64 + fr;
        const float* gate = mod + (size_t)(u.pm >> 4) * NMODC + gidx * D;
        const int col0 = u.pn * 256 + wc * 32 + 4 * fq;
        f32x4 gv[2][2];
#pragma unroll
        for (int bj = 0; bj < 2; ++bj)
#pragma unroll
            for (int n = 0; n < 2; ++n) gv[bj][n] = *(const f32x4*)(gate + col0 + bj * 128 + n * 16) * coef;
#pragma unroll
        for (int ai = 0; ai < 2; ++ai)
#pragma unroll
            for (int m = 0; m < 4; ++m) {
                const size_t off = (size_t)(prow + ai * 128 + m * 16) * D + col0;
#pragma unroll
                for (int bj = 0; bj < 2; ++bj)
#pragma unroll
                    for (int n = 0; n < 2; ++n) {
                        f32x4 bs;
                        if constexpr (BASEB) { const u32x2 t = *(const u32x2*)((const bf16*)base + off + bj * 128 + n * 16); bs = (f32x4){bflo(t.x), bfhi(t.x), bflo(t.y), bfhi(t.y)}; }
                        else bs = *(const f32x4*)(base + off + bj * 128 + n * 16);
                        *(u32x2*)(outb + off + bj * 128 + n * 16) = pk4(bs + gv[bj][n] * acc[ai][bj][m][n]);
                    }
            }
    }
};

struct EpiDelta {
    static constexpr bool PERM = true, AFTER_DRAIN = false;
    bf16* delta; const float* mod; int gidx; float coef;
    __device__ __forceinline__ void operator()(const f32x4 (&acc)[2][2][4][2], const pg8::Unit& u, int wr, int wc, int fr, int fq) const {
        const int row0 = u.pm * 256 + wr * 64 + fr, col0 = u.pn * 256 + wc * 32 + 8 * fq;
        const float* gate = mod + (size_t)(u.pm >> 4) * NMODC + gidx * D;
#pragma unroll
        for (int bj = 0; bj < 2; ++bj) {
            const f32x4 g0 = *(const f32x4*)(gate + col0 + bj * 128) * coef, g1 = *(const f32x4*)(gate + col0 + bj * 128 + 4) * coef;
#pragma unroll
            for (int ai = 0; ai < 2; ++ai)
#pragma unroll
                for (int m = 0; m < 4; ++m) {
                    const u32x2 w0 = pk4(acc[ai][bj][m][0] * g0), w1 = pk4(acc[ai][bj][m][1] * g1);
                    *(u32x4*)(delta + (size_t)(row0 + ai * 128 + m * 16) * D + col0 + bj * 128) = (u32x4){w0.x, w0.y, w1.x, w1.y};
                }
        }
    }
};

struct EpiMix1 {
    static constexpr bool PERM = true, AFTER_DRAIN = false;
    bf16* Q; f16* GF; f16* GB; bf16* V; const float* lbf; const float* lbb;
    __device__ __forceinline__ void operator()(const f32x4 (&acc)[2][2][4][2], const pg8::Unit& u, int wr, int wc, int fr, int fq) const {
        const int seg = u.pn >> 2;
        const int row0 = u.pm * 256 + wr * 64 + fr, col0 = (u.pn & 3) * 256 + wc * 32 + 8 * fq;
        if (seg == 0) {
            if (u.pm >= 128) return;
#pragma unroll
            for (int ai = 0; ai < 2; ++ai)
#pragma unroll
                for (int m = 0; m < 4; ++m)
#pragma unroll
                    for (int bj = 0; bj < 2; ++bj) {
                        const f32x4 a = acc[ai][bj][m][0], b = acc[ai][bj][m][1];
                        const u32x2 w0 = pk4(silu4_(a)), w1 = pk4(silu4_(b)); const u32x4 w = (u32x4){w0.x, w0.y, w1.x, w1.y};
                        *(u32x4*)(Q + (size_t)(row0 + ai * 128 + m * 16) * D + col0 + bj * 128) = w;
                    }
        } else if (seg == 3) {
#pragma unroll
            for (int ai = 0; ai < 2; ++ai)
#pragma unroll
                for (int m = 0; m < 4; ++m)
#pragma unroll
                    for (int bj = 0; bj < 2; ++bj) {
                        const f32x4 a = acc[ai][bj][m][0], b = acc[ai][bj][m][1];
                        u32x4 w; w.x = pk2(a[0], a[1]); w.y = pk2(a[2], a[3]); w.z = pk2(b[0], b[1]); w.w = pk2(b[2], b[3]);
                        *(u32x4*)(V + (size_t)(row0 + ai * 128 + m * 16) * D + col0 + bj * 128) = w;
                    }
        } else {
            const float* lb = (seg == 1) ? lbf : lbb; f16* G = (seg == 1) ? GF : GB;
#pragma unroll
            for (int bj = 0; bj < 2; ++bj) {
                const f32x4 l0 = *(const f32x4*)(lb + col0 + bj * 128), l1 = *(const f32x4*)(lb + col0 + bj * 128 + 4);
#pragma unroll
                for (int ai = 0; ai < 2; ++ai)
#pragma unroll
                    for (int m = 0; m < 4; ++m) {
                        const f32x4 a = acc[ai][bj][m][0], b = acc[ai][bj][m][1];
                        f16x8 w;
                        const f32x4 fa = l0 + (1.0f - l0) * sig4_(a), fb = l1 + (1.0f - l1) * sig4_(b);
#pragma unroll
                        for (int j = 0; j < 4; ++j) { w[j] = (f16)__builtin_amdgcn_logf(fa[j]); w[4 + j] = (f16)__builtin_amdgcn_logf(fb[j]); }
                        *(f16x8*)(G + (size_t)(row0 + ai * 128 + m * 16) * D + col0 + bj * 128) = w;
                    }
            }
        }
    }
};

struct EpiMix2 {
    static constexpr bool PERM = true, AFTER_DRAIN = false;
    bf16* SG; bf16* GLU; bf16* GATES; const float* bgate;
    __device__ __forceinline__ void operator()(const f32x4 (&acc)[2][2][4][2], const pg8::Unit& u, int wr, int wc, int fr, int fq) const {
        const int row0 = u.pm * 256 + wr * 64 + fr, cw = wc * 32 + 8 * fq;
        if (u.pn < 4) {
#pragma unroll
            for (int ai = 0; ai < 2; ++ai)
#pragma unroll
                for (int m = 0; m < 4; ++m)
#pragma unroll
                    for (int bj = 0; bj < 2; ++bj) {
                        const f32x4 a = acc[ai][bj][m][0], b = acc[ai][bj][m][1];
                        const u32x2 w0 = pk4(silu4_(a)), w1 = pk4(silu4_(b)); const u32x4 w = (u32x4){w0.x, w0.y, w1.x, w1.y};
                        *(u32x4*)(SG + (size_t)(row0 + ai * 128 + m * 16) * D + u.pn * 256 + bj * 128 + cw) = w;
                    }
        } else if (u.pn < 12) {
            const int c0 = (u.pn - 4) * 128 + cw;
#pragma unroll
            for (int ai = 0; ai < 2; ++ai)
#pragma unroll
                for (int m = 0; m < 4; ++m) {
                    const u32x2 w0 = pk4(acc[ai][0][m][0] * sig4_(acc[ai][1][m][0])), w1 = pk4(acc[ai][0][m][1] * sig4_(acc[ai][1][m][1])); const u32x4 w = (u32x4){w0.x, w0.y, w1.x, w1.y};
                    *(u32x4*)(GLU + (size_t)(row0 + ai * 128 + m * 16) * D + c0) = w;
                }
        } else {
            const int c0 = (u.pn - 12) * 256 + cw;
#pragma unroll
            for (int bj = 0; bj < 2; ++bj) {
                const f32x4 b0 = *(const f32x4*)(bgate + c0 + bj * 128), b1 = *(const f32x4*)(bgate + c0 + bj * 128 + 4);
#pragma unroll
                for (int ai = 0; ai < 2; ++ai)
#pragma unroll
                    for (int m = 0; m < 4; ++m) {
                        const f32x4 a = acc[ai][bj][m][0] + b0, b = acc[ai][bj][m][1] + b1;
                        const u32x2 w0 = pk4(sig4_(a)), w1 = pk4(sig4_(b)); const u32x4 w = (u32x4){w0.x, w0.y, w1.x, w1.y};
                        *(u32x4*)(GATES + (size_t)(row0 + ai * 128 + m * 16) * 2048 + c0 + bj * 128) = w;
                    }
            }
        }
    }
};

template <int ADD> struct EpiGate {
    static constexpr bool PERM = true, AFTER_DRAIN = false;
    const bf16* GATES; bf16* T; int goff;
    __device__ __forceinline__ void operator()(const f32x4 (&acc)[2][2][4][2], const pg8::Unit& u, int wr, int wc, int fr, int fq) const {
        const int row0 = u.pm * 256 + wr * 64 + fr, col0 = u.pn * 256 + wc * 32 + 8 * fq;
#pragma unroll
        for (int ai = 0; ai < 2; ++ai)
#pragma unroll
            for (int m = 0; m < 4; ++m)
#pragma unroll
                for (int bj = 0; bj < 2; ++bj) {
                    const size_t r = (size_t)(row0 + ai * 128 + m * 16);
                    const u32x4 g = *(const u32x4*)(GATES + r * 2048 + goff + col0 + bj * 128);
                    bf16* tp = T + r * D + col0 + bj * 128;
                    const f32x4 a = acc[ai][bj][m][0], b = acc[ai][bj][m][1];
                    float o[8];
                    o[0] = bflo(g.x) * a[0]; o[1] = bfhi(g.x) * a[1]; o[2] = bflo(g.y) * a[2]; o[3] = bfhi(g.y) * a[3];
                    o[4] = bflo(g.z) * b[0]; o[5] = bfhi(g.z) * b[1]; o[6] = bflo(g.w) * b[2]; o[7] = bfhi(g.w) * b[3];
                    if (ADD) { const u32x4 t = *(const u32x4*)tp;
                        o[0] += bflo(t.x); o[1] += bfhi(t.x); o[2] += bflo(t.y); o[3] += bfhi(t.y); o[4] += bflo(t.z); o[5] += bfhi(t.z); o[6] += bflo(t.w); o[7] += bfhi(t.w); }
                    u32x4 w; w.x = pk2(o[0], o[1]); w.y = pk2(o[2], o[3]); w.z = pk2(o[4], o[5]); w.w = pk2(o[6], o[7]);
                    *(u32x4*)tp = w;
                }
    }
};


struct KSplitOrder {
    int G, c;
    __device__ bool next(int i, pg8::Unit& u) const { const int L = i * G + c; if (L >= 352) return false; u.pk = L >> 5; u.pm = 128 + ((L & 31) >> 2); u.pn = L & 3; return true; }
    __device__ __forceinline__ void a_ready(const pg8::Unit&) const {}
    __device__ __forceinline__ void done(const pg8::Unit&) const {}
};
struct EpiPart {
    static constexpr bool PERM = false, AFTER_DRAIN = false;
    float* part;
    __device__ __forceinline__ void operator()(const f32x4 (&acc)[2][2][4][2], const pg8::Unit& u, int wr, int wc, int fr, int fq) const {
        const int prow = (u.pm - 128) * 256 + wr * 64 + fr, col0 = u.pn * 256 + wc * 32 + 4 * fq;
        float* base = part + ((size_t)u.pk * MC + prow) * D + col0;
#pragma unroll
        for (int ai = 0; ai < 2; ++ai)
#pragma unroll
            for (int m = 0; m < 4; ++m)
#pragma unroll
                for (int bj = 0; bj < 2; ++bj)
#pragma unroll
                    for (int n = 0; n < 2; ++n) *(f32x4*)(base + (size_t)(ai * 128 + m * 16) * D + bj * 128 + n * 16) = acc[ai][bj][m][n];
    }
};

__device__ __forceinline__ void conv_tile(LAS unsigned char* lds, const float* src, int srcN, int k0, int n0, bf16* dst, int dstK, int drow0) {
    LAS float* T = (LAS float*)lds;
    const int tid = tid_opaque();
#pragma unroll
    for (int i = 0; i < 4; ++i) {
        const int kk = (tid >> 5) + 16 * i, n4 = tid & 31;
        const f32x4 v = *(const f32x4*)(src + (size_t)(k0 + kk) * srcN + n0 + 4 * n4);
#pragma unroll
        for (int j = 0; j < 4; ++j) T[kk * 129 + 4 * n4 + j] = v[j];
    }
    __syncthreads();
    {
        const int nn = tid >> 2, kq = tid & 3;
        float f[16];
#pragma unroll
        for (int j = 0; j < 16; ++j) f[j] = T[(16 * kq + j) * 129 + nn];
        u32x4 w0, w1;
        w0.x = pk2(f[0], f[1]); w0.y = pk2(f[2], f[3]); w0.z = pk2(f[4], f[5]); w0.w = pk2(f[6], f[7]);
        w1.x = pk2(f[8], f[9]); w1.y = pk2(f[10], f[11]); w1.z = pk2(f[12], f[13]); w1.w = pk2(f[14], f[15]);
        bf16* dp = dst + (size_t)(drow0 + nn) * dstK + k0 + 16 * kq;
        *(u32x4*)dp = w0; *(u32x4*)(dp + 8) = w1;
    }
    __syncthreads();
}
__device__ __forceinline__ void conv_job_item(LAS unsigned char* lds, int it, const float* src, int K, int N, bf16* dst, int roff, int pair_from, int NH) {
    const int nt = N / 128; const int kt = it / nt, ntile = it % nt; const int n0 = ntile * 128;
    int drow0;
    if (pair_from < 0 || n0 < pair_from) drow0 = roff + n0;
    else { const int n1 = n0 - pair_from; drow0 = roff + pair_from + ((n1 < NH) ? 256 * (n1 / 128) : 256 * ((n1 - NH) / 128) + 128); }
    conv_tile(lds, src, N, kt * 64, n0, dst, K, drow0);
}

template <bool MODU, bool OUT_BF16, bool CPART = false, bool ADDD = false, bool SRCB = false>
__device__ __forceinline__ void normmod_phase(const float* srcL, const float* srcC, int nrows, const float* gain, const float* mod, int ishift, int iscale, bf16* ub, float* of, const float* part = nullptr, int igate = 0, const bf16* dlt = nullptr) {
    const int tido = tid_opaque(); const int lane = tido & 63, wv = tido >> 6;
    f32x4 gn[4];
#pragma unroll
    for (int j = 0; j < 4; ++j) gn[j] = *(const f32x4*)(gain + 256 * j + 4 * lane);
    for (int row = blockIdx.x * 8 + wv; row < nrows; row += gridDim.x * 8) {
        const float* src = (row < ML) ? srcL + (size_t)row * D : srcC + (size_t)(row - ML) * D;
        f32x4 x[4]; float ss = 0.f;
#pragma unroll
        for (int j = 0; j < 4; ++j) {
            if (SRCB && row < ML) { const u32x2 t = *(const u32x2*)((const bf16*)srcL + (size_t)row * D + 256 * j + 4 * lane); x[j] = (f32x4){bflo(t.x), bfhi(t.x), bflo(t.y), bfhi(t.y)}; }
            else x[j] = *(const f32x4*)(src + 256 * j + 4 * lane);
            if constexpr (ADDD) { const u32x2 t = *(const u32x2*)(dlt + (size_t)row * D + 256 * j + 4 * lane); x[j] += (f32x4){bflo(t.x), bfhi(t.x), bflo(t.y), bfhi(t.y)}; }
            if constexpr (CPART) { if (row >= ML) {
                f32x4 sp = *(const f32x4*)(part + (size_t)(row - ML) * D + 256 * j + 4 * lane);
#pragma unroll
                for (int pk = 1; pk < 11; ++pk) sp += *(const f32x4*)(part + ((size_t)pk * MC + (row - ML)) * D + 256 * j + 4 * lane);
                x[j] += sp * (*(const f32x4*)(mod + (size_t)8 * NMODC + igate * D + 256 * j + 4 * lane) * 0.5f); } }
            ss += x[j][0] * x[j][0] + x[j][1] * x[j][1] + x[j][2] * x[j][2] + x[j][3] * x[j][3]; }
#pragma unroll
        for (int o = 32; o >= 1; o >>= 1) ss += __shfl_xor(ss, o);
        const float rinv = rsqrtf(ss * (1.0f / D) + EPS);
        const int mrow = (row < ML) ? (row >> 12) : 8;
#pragma unroll
        for (int j = 0; j < 4; ++j) {
            f32x4 y = x[j] * rinv * gn[j];
            if constexpr (MODU) { const f32x4 sh = *(const f32x4*)(mod + (size_t)mrow * NMODC + ishift * D + 256 * j + 4 * lane), sc = *(const f32x4*)(mod + (size_t)mrow * NMODC + iscale * D + 256 * j + 4 * lane);
                y = y * (sc + 1.0f) + sh; }
            if constexpr (OUT_BF16) { u32x2 w; w.x = pk2(y[0], y[1]); w.y = pk2(y[2], y[3]); *(u32x2*)(ub + (size_t)row * D + 256 * j + 4 * lane) = w; }
            else *(f32x4*)(of + (size_t)row * D + 256 * j + 4 * lane) = y;
        }
    }
}

__device__ __forceinline__ void adaln_item(LAS unsigned char* lds, int item, const float* wada, const float* bada, float* MOD) {
    LAS float* SC = (LAS float*)lds;
    LAS float* RED = (LAS float*)(lds + 36864);
    const int tid = threadIdx.x, col = tid & 63, kg = tid >> 6, n0 = item * 64;
    float acc[9];
#pragma unroll
    for (int r = 0; r < 9; ++r) acc[r] = 0.f;
    for (int k = kg * 128; k < kg * 128 + 128; ++k) {
        const float w = wada[(size_t)k * NMODC + n0 + col];
#pragma unroll
        for (int r = 0; r < 9; ++r) acc[r] += SC[r * 1024 + k] * w;
    }
#pragma unroll
    for (int r = 0; r < 9; ++r) RED[(kg * 9 + r) * 64 + col] = acc[r];
    __syncthreads();
    for (int idx = tid; idx < 576; idx += 512) {
        const int r = idx >> 6, c = idx & 63; float s = bada[n0 + c];
#pragma unroll
        for (int g = 0; g < 8; ++g) s += RED[(g * 9 + r) * 64 + c];
        MOD[(size_t)r * NMODC + n0 + c] = s;
    }
    __syncthreads();
}

__device__ __forceinline__ void aop_rows(int row_begin, int row_end, int row_step, bf16* OF, const bf16* OB, const bf16* SG, const float* hgn) {
    const int lane = tid_opaque() & 63;
    float gn[16];
#pragma unroll
    for (int j = 0; j < 4; ++j) { const f32x4 t = *(const f32x4*)(hgn + (lane & 7) * 16 + 4 * j); gn[4 * j] = t[0]; gn[4 * j + 1] = t[1]; gn[4 * j + 2] = t[2]; gn[4 * j + 3] = t[3]; }
    for (int row = row_begin; row < row_end; row += row_step) {
        const size_t off = (size_t)row * D + 16 * lane;
        const u32x4 f0 = *(const u32x4*)(OF + off), f1 = *(const u32x4*)(OF + off + 8);
        const u32x4 b0 = *(const u32x4*)(OB + off), b1 = *(const u32x4*)(OB + off + 8);
        const u32x4 s0 = *(const u32x4*)(SG + off), s1 = *(const u32x4*)(SG + off + 8);
        float o[16], sg[16];
#pragma unroll
        for (int j = 0; j < 4; ++j) {
            o[2 * j] = bflo(f0[j]) + bflo(b0[j]); o[2 * j + 1] = bfhi(f0[j]) + bfhi(b0[j]);
            o[8 + 2 * j] = bflo(f1[j]) + bflo(b1[j]); o[8 + 2 * j + 1] = bfhi(f1[j]) + bfhi(b1[j]);
            sg[2 * j] = bflo(s0[j]); sg[2 * j + 1] = bfhi(s0[j]); sg[8 + 2 * j] = bflo(s1[j]); sg[8 + 2 * j + 1] = bfhi(s1[j]);
        }
        float ss = 0.f;
#pragma unroll
        for (int j = 0; j < 16; ++j) ss += o[j] * o[j];
        ss += __shfl_xor(ss, 1); ss += __shfl_xor(ss, 2); ss += __shfl_xor(ss, 4);
        const float rinv = rsqrtf(ss * (1.0f / 128.0f) + EPS);
        float a[16];
#pragma unroll
        for (int j = 0; j < 16; ++j) a[j] = o[j] * rinv * gn[j] * sg[j];
        u32x4 w0, w1;
        w0.x = pk2(a[0], a[1]); w0.y = pk2(a[2], a[3]); w0.z = pk2(a[4], a[5]); w0.w = pk2(a[6], a[7]);
        w1.x = pk2(a[8], a[9]); w1.y = pk2(a[10], a[11]); w1.z = pk2(a[12], a[13]); w1.w = pk2(a[14], a[15]);
        *(u32x4*)(OF + off) = w0; *(u32x4*)(OF + off + 8) = w1;
    }
}

__device__ __forceinline__ void conv_items(LAS unsigned char* lds, int item_begin, int item_end, int item_step, const bf16* GLU, const float* wdw, const float* bdw, const float* lng, const float* lnb, bf16* BOP) {
    constexpr int TT = 16;
    LAS float* P1 = (LAS float*)lds;
    LAS float* P2 = (LAS float*)(lds + 65536);
    LAS float* ST = (LAS float*)(lds + 131072);
    const int tid = tid_opaque(), c = 2 * tid;
    float w[31][2];
#pragma unroll
    for (int j = 0; j < 31; ++j) { w[j][0] = wdw[j * D + c]; w[j][1] = wdw[j * D + c + 1]; }
    const float bd0 = bdw[c], bd1 = bdw[c + 1], g0 = lng[c], g1 = lng[c + 1], b0 = lnb[c], b1 = lnb[c + 1];
    for (int item = item_begin; item < item_end; item += item_step) {
        const int b = item / (SEQ / TT), t0 = (item % (SEQ / TT)) * TT;
        float y[TT][2];
        unsigned xw[TT + 30];
#pragma unroll
        for (int r = 0; r < TT + 30; ++r) {
            const int pos = t0 - 15 + r;
            xw[r] = 0u;
            if (pos >= 0 && pos < SEQ) xw[r] = *(const unsigned*)(GLU + (size_t)(b * SEQ + pos) * D + c);
        }
        typedef float f32x2_t __attribute__((ext_vector_type(2)));
        f32x2_t xf[TT + 30];
#pragma unroll
        for (int r = 0; r < TT + 30; ++r) { xf[r].x = bflo(xw[r]); xf[r].y = bfhi(xw[r]); }
#pragma unroll
        for (int t = 0; t < TT; ++t) {
            f32x2_t a2; a2.x = bd0; a2.y = bd1;
#pragma unroll
            for (int j = 0; j < 31; ++j) { f32x2_t w2; w2.x = w[j][0]; w2.y = w[j][1]; a2 = __builtin_elementwise_fma(xf[t + j], w2, a2); }
            y[t][0] = a2.x; y[t][1] = a2.y;
        }
#pragma unroll
        for (int t = 0; t < TT; ++t) { P1[t * 512 + tid] = y[t][0] + y[t][1]; P2[t * 512 + tid] = y[t][0] * y[t][0] + y[t][1] * y[t][1]; }
        __syncthreads();
        {
            const int t = tid >> 5, part = tid & 31; float s = 0.f, q = 0.f;
#pragma unroll
            for (int j = 0; j < 4; ++j) { const f32x4 a = *(const LAS f32x4*)(P1 + t * 512 + part * 16 + 4 * j), bq = *(const LAS f32x4*)(P2 + t * 512 + part * 16 + 4 * j);
                s += (a[0] + a[1]) + (a[2] + a[3]); q += (bq[0] + bq[1]) + (bq[2] + bq[3]); }
#pragma unroll
            for (int o = 16; o >= 1; o >>= 1) { s += __shfl_xor(s, o); q += __shfl_xor(q, o); }
            if (part == 0) { const float mean = s * (1.0f / D); const float var = fmaxf(q * (1.0f / D) - mean * mean, 0.f); ST[2 * t] = mean; ST[2 * t + 1] = rsqrtf(var + EPS); }
        }
        __syncthreads();
#pragma unroll
        for (int t = 0; t < TT; ++t) {
            const float mean = ST[2 * t], rstd = ST[2 * t + 1];
            const float v0 = (y[t][0] - mean) * rstd * g0 + b0, v1 = (y[t][1] - mean) * rstd * g1 + b1;
            *(unsigned*)(BOP + (size_t)(b * SEQ + t0 + t) * D + c) = pk2(siluf_(v0), siluf_(v1));
        }
        __syncthreads();
    }
}

__device__ __forceinline__ size_t scan_rowbase(int ci, int t, int dir, int b) {
    const bool ctx = ci < 8; const int lc = ctx ? ci : ci - 8, nch = ctx ? 8 : 128;
    const int p0 = dir ? (nch - 1 - lc) * 32 : lc * 32; const int pos = dir ? p0 + 31 - t : p0 + t;
    return ctx ? (size_t)(ML + b * CTXL + pos) : (size_t)(b * SEQ + pos);
}
constexpr int S2_QS = 0, S2_KS = 26112, S2_KET = 43520, S2_VT = 74240, S2_DEC = 89600, S2_AS = 91136, S2_ST = 96256;
constexpr int QROW = 272, SROW = 80;
struct ScanRegs { u32x4 q, g, v; };
struct ScanCtx { const bf16* Q; const f16* G; const bf16* V; bf16* O; int b, h, dvh, dir, w, lane, l15, q4, tau, cg; };

__device__ __forceinline__ void scan_issue(const ScanCtx& c, int ci, ScanRegs& r) {
    const size_t row = scan_rowbase(ci, c.tau, c.dir, c.b);
    const size_t qrow = (ci >= 8) ? row : (size_t)(c.b * SEQ + c.tau);
    const int d0 = 16 * c.w + 8 * c.cg;
    r.g = *(const u32x4*)(c.G + row * D + c.h * 128 + d0);
    r.q = *(const u32x4*)(c.Q + qrow * D + c.h * 128 + d0);
    r.v = *(const u32x4*)(c.V + row * D + c.h * 128 + c.dvh * 64 + 8 * c.w);
}
template <int CTRL, int ROWMASK> __device__ __forceinline__ float dpp_mul_(float x) {
    const int y = __builtin_amdgcn_update_dpp(0x3f800000, __float_as_int(x), CTRL, ROWMASK, 0xF, false);
    return x * __int_as_float(y);
}
__device__ __forceinline__ void scan_E(LAS unsigned char* lds, const ScanCtx& c, int ci, const ScanRegs& r) {
    const bool lat = ci >= 8; const int s3 = ci % 3, s2 = ci & 1; const int tau = c.tau, d0 = 16 * c.w + 8 * c.cg;
    float f[8], P[8];
    { const f16x8 gh = __builtin_bit_cast(f16x8, r.g);
#pragma unroll
      for (int j = 0; j < 8; ++j) { P[j] = __builtin_amdgcn_exp2f((float)gh[j]); f[j] = 1.0f - P[j]; } }
#define DPP8(ctrl) "v_mul_f32_dpp %0, %0, %0 " ctrl "\n\tv_mul_f32_dpp %1, %1, %1 " ctrl "\n\tv_mul_f32_dpp %2, %2, %2 " ctrl "\n\tv_mul_f32_dpp %3, %3, %3 " ctrl "\n\t" \
                   "v_mul_f32_dpp %4, %4, %4 " ctrl "\n\tv_mul_f32_dpp %5, %5, %5 " ctrl "\n\tv_mul_f32_dpp %6, %6, %6 " ctrl "\n\tv_mul_f32_dpp %7, %7, %7 " ctrl "\n\t"
    asm volatile("s_nop 1\n\t"
                 DPP8("row_shr:1 row_mask:0xf bank_mask:0xf") DPP8("row_shr:2 row_mask:0xf bank_mask:0xf") DPP8("row_shr:4 row_mask:0xf bank_mask:0xf")
                 DPP8("row_shr:8 row_mask:0xf bank_mask:0xf") DPP8("row_bcast:15 row_mask:0xa bank_mask:0xf") "s_nop 1"
                 : "+v"(P[0]), "+v"(P[1]), "+v"(P[2]), "+v"(P[3]), "+v"(P[4]), "+v"(P[5]), "+v"(P[6]), "+v"(P[7]));
#undef DPP8
    float kt[8], qg[8];
    const unsigned qw[4] = {r.q.x, r.q.y, r.q.z, r.q.w};
#pragma unroll
    for (int j = 0; j < 8; ++j) {
        const float k = f[j];
        float pc; asm("v_max_f32 %0, %1, %2" : "=v"(pc) : "v"(P[j]), "v"(1e-30f));
        kt[j] = k * __builtin_amdgcn_rcpf(pc);
        const float qv = (j & 1) ? bfhi(qw[j >> 1]) : bflo(qw[j >> 1]);
        qg[j] = qv * P[j];
    }
    u32x4 wk; wk.x = pk2(kt[0], kt[1]); wk.y = pk2(kt[2], kt[3]); wk.z = pk2(kt[4], kt[5]); wk.w = pk2(kt[6], kt[7]);
    *(LAS u32x4*)(lds + S2_KS + s2 * 8704 + tau * QROW + d0 * 2) = wk;
    if (lat) { u32x4 wq; wq.x = pk2(qg[0], qg[1]); wq.y = pk2(qg[2], qg[3]); wq.z = pk2(qg[4], qg[5]); wq.w = pk2(qg[6], qg[7]);
        *(LAS u32x4*)(lds + S2_QS + s3 * 8704 + tau * QROW + d0 * 2) = wq; }
    { const unsigned kw[4] = {wk.x, wk.y, wk.z, wk.w};
#pragma unroll
      for (int j = 0; j < 4; ++j) {
        *(LAS unsigned short*)(lds + S2_KET + s3 * 10240 + (d0 + 2 * j) * SROW + tau * 2) = (unsigned short)(kw[j] & 0xffffu);
        *(LAS unsigned short*)(lds + S2_KET + s3 * 10240 + (d0 + 2 * j + 1) * SROW + tau * 2) = (unsigned short)(kw[j] >> 16); } }
    if (tau == 31) { LAS float* DC = (LAS float*)(lds + S2_DEC + s3 * 512);
        *(LAS f32x4*)(DC + d0) = (f32x4){P[0], P[1], P[2], P[3]};
        *(LAS f32x4*)(DC + d0 + 4) = (f32x4){P[4], P[5], P[6], P[7]}; }
    if (c.lane < 32) { const unsigned vw[4] = {r.v.x, r.v.y, r.v.z, r.v.w};
#pragma unroll
        for (int j = 0; j < 4; ++j) {
            *(LAS unsigned short*)(lds + S2_VT + s3 * 5120 + (8 * c.w + 2 * j) * SROW + tau * 2) = (unsigned short)(vw[j] & 0xffffu);
            *(LAS unsigned short*)(lds + S2_VT + s3 * 5120 + (8 * c.w + 2 * j + 1) * SROW + tau * 2) = (unsigned short)(vw[j] >> 16); } }
}
__device__ __forceinline__ void scan_A(LAS unsigned char* lds, const ScanCtx& c, int ci) {
    if (c.w >= 3) return;
    const int s3 = ci % 3, s2 = ci & 1; const int l15 = c.l15, q4 = c.q4;
    const LAS unsigned char* QS = lds + S2_QS + s3 * 8704; const LAS unsigned char* KS = lds + S2_KS + s2 * 8704;
    const int ti = (c.w == 0) ? 0 : 1, sj = (c.w == 2) ? 1 : 0;
    f32x4 a4 = (f32x4){0.f, 0.f, 0.f, 0.f};
#pragma unroll
    for (int kk = 0; kk < 4; ++kk) {
        const bf16x8 xa = *(const LAS bf16x8*)(KS + (sj * 16 + l15) * QROW + kk * 64 + q4 * 16);
        const bf16x8 yb = *(const LAS bf16x8*)(QS + (ti * 16 + l15) * QROW + kk * 64 + q4 * 16);
        a4 = __builtin_amdgcn_mfma_f32_16x16x32_bf16(xa, yb, a4, 0, 0, 0);
    }
    const int t = ti * 16 + l15, s0 = sj * 16 + 4 * q4;
    const float m0 = (s0 <= t) ? a4[0] : 0.f, m1 = (s0 + 1 <= t) ? a4[1] : 0.f, m2 = (s0 + 2 <= t) ? a4[2] : 0.f, m3 = (s0 + 3 <= t) ? a4[3] : 0.f;
    u32x2 wa; wa.x = pk2(m0, m1); wa.y = pk2(m2, m3);
    *(LAS u32x2*)(lds + S2_AS + s2 * 2560 + t * SROW + s0 * 2) = wa;
}
__device__ __forceinline__ void scan_M(LAS unsigned char* lds, const ScanCtx& c, int ci, f32x4 (&accS)[4]) {
    const bool lat = ci >= 8; const int s3 = ci % 3, s2 = ci & 1; const int l15 = c.l15, q4 = c.q4, w = c.w;
    const LAS unsigned char* QS = lds + S2_QS + s3 * 8704; const LAS unsigned char* KET = lds + S2_KET + s3 * 10240; const LAS unsigned char* VT = lds + S2_VT + s3 * 5120;
    const LAS unsigned char* STr = lds + S2_ST + s2 * 17408; LAS unsigned char* STw = lds + S2_ST + (s2 ^ 1) * 17408;
    const int tt = w >> 2, et = w & 3;
    if (lat) {
        f32x4 acco = (f32x4){0.f, 0.f, 0.f, 0.f};
#pragma unroll
        for (int kk = 0; kk < 4; ++kk) {
            const bf16x8 xa = *(const LAS bf16x8*)(STr + (et * 16 + l15) * QROW + kk * 64 + q4 * 16);
            const bf16x8 yb = *(const LAS bf16x8*)(QS + (tt * 16 + l15) * QROW + kk * 64 + q4 * 16);
            acco = __builtin_amdgcn_mfma_f32_16x16x32_bf16(xa, yb, acco, 0, 0, 0);
        }
        {
            const bf16x8 xa = *(const LAS bf16x8*)(VT + (et * 16 + l15) * SROW + q4 * 16);
            const bf16x8 yb = *(const LAS bf16x8*)(lds + S2_AS + s2 * 2560 + (tt * 16 + l15) * SROW + q4 * 16);
            acco = __builtin_amdgcn_mfma_f32_16x16x32_bf16(xa, yb, acco, 0, 0, 0);
        }
        const size_t r = scan_rowbase(ci, tt * 16 + l15, c.dir, c.b);
        u32x2 wo; wo.x = pk2(acco[0], acco[1]); wo.y = pk2(acco[2], acco[3]);
        { bf16* op = c.O + r * D + c.h * 128 + c.dvh * 64 + et * 16 + 4 * q4;
          asm volatile("global_store_dwordx2 %0, %1, off" :: "v"(op), "v"(wo) : "memory"); }
    }
    {
        const f32x4 dc = *(const LAS f32x4*)(lds + S2_DEC + s3 * 512 + (16 * w + 4 * q4) * 4);
        const bf16x8 xa = *(const LAS bf16x8*)(KET + (16 * w + l15) * SROW + q4 * 16);
#pragma unroll
        for (int i = 0; i < 4; ++i) {
            const bf16x8 yb = *(const LAS bf16x8*)(VT + (16 * i + l15) * SROW + q4 * 16);
            accS[i] = __builtin_amdgcn_mfma_f32_16x16x32_bf16(xa, yb, accS[i], 0, 0, 0) * dc;
        }
#pragma unroll
        for (int i = 0; i < 4; ++i) {
            u32x2 ws_; ws_.x = pk2(accS[i][0], accS[i][1]); ws_.y = pk2(accS[i][2], accS[i][3]);
            *(LAS u32x2*)(STw + (16 * i + l15) * QROW + (16 * w + 4 * q4) * 2) = ws_;
        }
    }
}
__device__ __forceinline__ void scan_item(LAS unsigned char* lds, int item, const bf16* Q, const f16* GF, const f16* GB, const bf16* V, bf16* OF, bf16* OB) {
    const int tid = tid_opaque(), lane = tid & 63;
    ScanCtx c;
    c.dvh = item & 1; c.dir = (item >> 1) & 1; c.h = (item >> 2) & 7; c.b = item >> 5;
    c.Q = Q; c.G = c.dir ? GB : GF; c.V = V; c.O = c.dir ? OB : OF;
    c.w = __builtin_amdgcn_readfirstlane(tid >> 6); c.lane = lane; c.l15 = lane & 15; c.q4 = lane >> 4; c.tau = lane & 31; c.cg = lane >> 5;
    for (int i = tid; i < (5120 + 34816) / 4; i += 512) ((LAS unsigned*)(lds + S2_AS))[i] = 0u;
    f32x4 accS[4];
#pragma unroll
    for (int i = 0; i < 4; ++i) accS[i] = (f32x4){0.f, 0.f, 0.f, 0.f};
    ScanRegs r0, r1, r2, r3;
    r0.q = r1.q = r2.q = r3.q = (u32x4){0u, 0u, 0u, 0u}; r0.v = r1.v = r2.v = r3.v = (u32x4){0u, 0u, 0u, 0u};
    scan_issue(c, 0, r0); scan_issue(c, 1, r1); scan_issue(c, 2, r2); scan_issue(c, 3, r3);
    __syncthreads();
#define SCAN_STEP(T_, R_) do { const int T = (T_); \
        __builtin_amdgcn_s_setprio(2); if (T >= 2) scan_M(lds, c, T - 2, accS); __builtin_amdgcn_s_setprio(0); \
        if (T >= 9) scan_A(lds, c, T - 1); \
        scan_E(lds, c, T, R_); { const int nx = (T + 4 < 136) ? T + 4 : 135; scan_issue(c, nx, R_); } \
        __syncthreads(); } while (0)
    for (int T0 = 0; T0 < 136; T0 += 4) { SCAN_STEP(T0, r0); SCAN_STEP(T0 + 1, r1); SCAN_STEP(T0 + 2, r2); SCAN_STEP(T0 + 3, r3); }
    scan_M(lds, c, 134, accS); scan_A(lds, c, 135); __syncthreads();
    scan_M(lds, c, 135, accS); __syncthreads();
    asm volatile("s_waitcnt vmcnt(0)" ::: "memory");
#undef SCAN_STEP
}

#define XB_TMO      128
#define XB_XCNT(j)  (256  + 64 * (j))
#define XB_XSUB(j)  (1280 + 64 * (j))
#define XB_XGEN(j)  (2304 + 64 * (j))
#define XB_TOP      3328
#define XB_TOPGEN   3392
#define XCD_BAR_WORDS 3456
#define XB_SPIN_CAP (1u << 18)

__device__ __forceinline__ unsigned xb_ld(unsigned* p)              { return __hip_atomic_load(p, __ATOMIC_RELAXED, __HIP_MEMORY_SCOPE_AGENT); }
__device__ __forceinline__ unsigned xb_add(unsigned* p, unsigned v) { return __hip_atomic_fetch_add(p, v, __ATOMIC_RELAXED, __HIP_MEMORY_SCOPE_AGENT); }
__device__ __forceinline__ unsigned xb_xcc_id() { return (unsigned)__builtin_amdgcn_s_getreg((3 << 11) | 20) & 0xFu; }
#define XB_SPIN(cond, bar) do { unsigned _sp = 0; while (cond) { __builtin_amdgcn_s_sleep(1); \
    if ((++_sp & 255u) == 0u) { if (xb_ld(&(bar)[XB_TMO])) break; if (_sp > XB_SPIN_CAP) { atomicAdd(&(bar)[XB_TMO], 1u); break; } } } } while (0)

struct XcdBarrier {
    unsigned* bar; unsigned x;
    volatile LAS unsigned* st;
};

__device__ __forceinline__ XcdBarrier xcd_barrier_post(unsigned* bar, volatile LAS unsigned* st) {
    XcdBarrier b; b.bar = bar; b.x = xb_xcc_id(); b.st = st;
    if (threadIdx.x == 0) (void)xb_add(&bar[XB_XCNT(b.x)], 1u);
    return b;
}
__device__ __forceinline__ void xcd_barrier_complete(unsigned* bar, unsigned x, unsigned& nloc, unsigned& nx) {
    const unsigned G = gridDim.x * gridDim.y * gridDim.z;
    unsigned sum, cnt, mine, sp = 0u;
    for (;;) {
        sum = 0u; cnt = 0u; mine = 0u;
#pragma unroll
        for (unsigned j = 0; j < 16; ++j) { const unsigned c = xb_ld(&bar[XB_XCNT(j)]); sum += c; cnt += (c > 0u) ? 1u : 0u; mine = (j == x) ? c : mine; }
        if (sum == G) break;
        __builtin_amdgcn_s_sleep(1);
        if ((++sp & 255u) == 0u) { if (xb_ld(&bar[XB_TMO])) break; if (sp > XB_SPIN_CAP) { atomicAdd(&bar[XB_TMO], 1u); break; } }
    }
    nloc = mine > 0u ? mine : 1u; nx = cnt > 0u ? cnt : 1u;
}

__device__ __forceinline__ void xcd_barrier(const XcdBarrier& b) {
    asm volatile("s_waitcnt vmcnt(0)" ::: "memory");
    __syncthreads();
    if (threadIdx.x == 0) {
        unsigned* bar = b.bar;
        __builtin_amdgcn_s_waitcnt(0);
        unsigned nloc = b.st[0], nx = b.st[1];
        if (nloc == 0u) { xcd_barrier_complete(bar, b.x, nloc, nx); b.st[0] = nloc; b.st[1] = nx; }
        const unsigned old = xb_add(&bar[XB_XSUB(b.x)], 1u);
        const unsigned gen = old / nloc;
        if (old + 1u == (gen + 1u) * nloc) {
            __builtin_amdgcn_fence(__ATOMIC_RELEASE, "agent");
            asm volatile("s_waitcnt vmcnt(0)" ::: "memory");
            const unsigned og = xb_add(&bar[XB_TOP], 1u);
            const unsigned tg = og / nx;
            if (og + 1u == (tg + 1u) * nx) xb_add(&bar[XB_TOPGEN], 1u);
            else XB_SPIN(xb_ld(&bar[XB_TOPGEN]) == tg, bar);
            __builtin_amdgcn_fence(__ATOMIC_ACQUIRE, "agent");
            xb_add(&bar[XB_XGEN(b.x)], 1u);
            asm volatile("s_waitcnt vmcnt(0)" ::: "memory");
        } else {
            XB_SPIN(xb_ld(&bar[XB_XGEN(b.x)]) == gen, bar);
            __builtin_amdgcn_fence(__ATOMIC_ACQUIRE, "agent");
            asm volatile("s_waitcnt vmcnt(0)" ::: "memory");
        }
    }
    __syncthreads();
}

__global__ void __launch_bounds__(512, 2) mega(Params P) {
    extern __shared__ __attribute__((aligned(16))) unsigned char lds_raw[];
    LAS unsigned char* lds = (LAS unsigned char*)lds_raw;
#define GRID_SYNC() xcd_barrier(xbar)
    if (threadIdx.x < 2) ((volatile LAS unsigned*)(lds + 131072 + 1024))[threadIdx.x] = 0u;
    __syncthreads();
    XcdBarrier xbar = xcd_barrier_post((unsigned*)(P.ws + WS_BAR), (volatile LAS unsigned*)(lds + 131072 + 1024));
    const int tid = threadIdx.x, G = gridDim.x, bid = blockIdx.x;
    unsigned char* ws = P.ws;
    bf16* WUP = (bf16*)(ws + WS_WUP); bf16* WDN = (bf16*)(ws + WS_WDN); bf16* WIN = (bf16*)(ws + WS_WIN);
    bf16* WPA = (bf16*)(ws + WS_WPA); bf16* WPB = (bf16*)(ws + WS_WPB); bf16* WO = (bf16*)(ws + WS_WO);
    float* MOD = (float*)(ws + WS_MOD); float* LBF = MOD + 9 * NMODC; float* LBB = LBF + 1024;
    bf16* U = (bf16*)(ws + WS_U);
    bf16* H = (bf16*)(ws + R_H); float* HC1 = (float*)(ws + R_HC1);
    bf16* Qb = (bf16*)(ws + R_Q); f16* GFb = (f16*)(ws + R_GF); f16* GBb = (f16*)(ws + R_GB); bf16* Vb = (bf16*)(ws + R_V);
    bf16* OFb = (bf16*)(ws + R_OF); bf16* OBb = (bf16*)(ws + R_OB);
    bf16* SGb = (bf16*)(ws + R_SG); bf16* GLUb = (bf16*)(ws + R_GLU); bf16* GATESb = (bf16*)(ws + R_GATES);
    bf16* BOP = U; bf16* Tb = OBb;
    bf16* H2B = OFb;
    bf16* DLT = (bf16*)(ws + WS_R + 192 * MiB);
    float* PART = (float*)(ws + WS_R + 192 * MiB);
    float* OUT = P.out;
    bf16* H1B = (bf16*)OUT;

    {
        if (bid < 144) {
            LAS float* SC = (LAS float*)lds;
            for (int i = tid; i < 9 * 1024; i += 512) { const float v = (i < 8192) ? P.in[I_C][i] : P.in[I_CCTX][i - 8192]; SC[i] = siluf_(v); }
            __syncthreads();
            for (int item = bid; item < 144; item += G) adaln_item(lds, item, P.in[I_WADA], P.in[I_BADA], MOD);
        }
        if (bid == G - 1) {
            const float* l = P.in[I_LBL];
            for (int d = tid; d < 1024; d += 512) { LBF[d] = 1.0f / (1.0f + __expf(l[2048 + d] - l[d])); LBB[d] = 1.0f / (1.0f + __expf(l[3072 + d] - l[1024 + d])); }
        }
        for (int it = (bid + 112) % G; it < 2592; it += G) {
            if (it < 704) conv_job_item(lds, it, P.in[I_W1U], 1024, 5632, WUP, 0, 0, 2816);
            else if (it < 1056) conv_job_item(lds, it - 704, P.in[I_W1D], 2816, 1024, WDN, 0, -1, 0);
            else if (it < 1952) conv_job_item(lds, it - 1056, P.in[I_WIN], 1024, 7168, WIN, 0, 5120, 1024);
            else if (it < 2208) conv_job_item(lds, it - 1952, P.in[I_WG], 1024, 2048, WIN, 7168, -1, 0);
            else if (it < 2336) conv_job_item(lds, it - 2208, P.in[I_WPA], 1024, 1024, WPA, 0, -1, 0);
            else if (it < 2464) conv_job_item(lds, it - 2336, P.in[I_WPB], 1024, 1024, WPB, 0, -1, 0);
            else conv_job_item(lds, it - 2464, P.in[I_WO], 1024, 1024, WO, 0, -1, 0);
        }
    }
    GRID_SYNC();
    normmod_phase<true, true>(P.in[I_X], P.in[I_CTX], MT, P.in[I_NF1], MOD, 0, 1, U, OUT);
    GRID_SYNC();
    { pg8::Gemm g{U, WUP, MT, 2 * FF, D, D}; pg8::StaticOrder S; S.init(MT, 2 * FF, G, bid); EpiSwiglu E{H, FF}; pg8::gemm_phase<EpiSwiglu, pg8::StaticOrder, GEMM_ALIGN, GEMM_SP2>(lds, g, S, E, nullptr); }
    GRID_SYNC();
    { pg8::Gemm g{H, WDN, ML, D, FF, FF}; pg8::StaticOrder S; S.init(ML, D, G, bid); EpiResB<false> E{P.in[I_X], H1B, MOD, 2, 0.5f}; pg8::gemm_phase<EpiResB<false>, pg8::StaticOrder, GEMM_ALIGN, GEMM_SP2>(lds, g, S, E, nullptr); }
    { pg8::Gemm g{H, WDN, MT, D, 256, FF}; KSplitOrder S{G, bid}; EpiPart E{PART}; pg8::gemm_phase<EpiPart, KSplitOrder, GEMM_ALIGN, GEMM_SP2>(lds, g, S, E, nullptr); }
    GRID_SYNC();
    normmod_phase<true, true, true, false, true>((const float*)H1B, P.in[I_CTX], MT, P.in[I_NMIX], MOD, 3, 4, U, OUT, PART, 2);
    GRID_SYNC();
    { pg8::Gemm g{U, WIN, MT, 4096, D, D}; pg8::StaticOrder S; S.init(MT, 4096, G, bid); EpiMix1 E{Qb, GFb, GBb, Vb, LBF, LBB}; pg8::gemm_phase<EpiMix1, pg8::StaticOrder, GEMM_ALIGN, GEMM_SP2>(lds, g, S, E, nullptr); }
    GRID_SYNC();
    for (int item = bid; item < 256; item += G) scan_item(lds, item, Qb, GFb, GBb, Vb, OFb, OBb);
    GRID_SYNC();
    { pg8::Gemm g{U, WIN + (size_t)4096 * D, ML, 5120, D, D}; pg8::StaticOrder S; S.init(ML, 5120, G, bid); EpiMix2 E{SGb, GLUb, GATESb, P.in[I_BG]}; pg8::gemm_phase<EpiMix2, pg8::StaticOrder, GEMM_ALIGN, GEMM_SP2>(lds, g, S, E, nullptr); }
    GRID_SYNC();
    {
        conv_items(lds, bid, 2048, G, GLUb, P.in[I_WDW], P.in[I_BDW], P.in[I_LNG], P.in[I_LNB], BOP);
        aop_rows(bid * 8 + (tid >> 6), ML, G * 8, OFb, OBb, SGb, P.in[I_HGN]);
        for (int it = bid; it < 1056; it += G) {
            if (it < 704) conv_job_item(lds, it, P.in[I_W2U], 1024, 5632, WUP, 0, 0, 2816);
            else conv_job_item(lds, it - 704, P.in[I_W2D], 2816, 1024, WDN, 0, -1, 0);
        }
    }
    GRID_SYNC();
    { pg8::Gemm g{OFb, WPA, ML, D, D, D}; pg8::StaticOrder S; S.init(ML, D, G, bid); EpiGate<0> E{GATESb, Tb, 0}; pg8::gemm_phase<EpiGate<0>, pg8::StaticOrder, GEMM_ALIGN, GEMM_SP2>(lds, g, S, E, nullptr); }
    GRID_SYNC();
    { pg8::Gemm g{BOP, WPB, ML, D, D, D}; pg8::StaticOrder S; S.init(ML, D, G, bid); EpiGate<1> E{GATESb, Tb, 1024}; pg8::gemm_phase<EpiGate<1>, pg8::StaticOrder, GEMM_ALIGN, GEMM_SP2>(lds, g, S, E, nullptr); }
    GRID_SYNC();
    { pg8::Gemm g{Tb, WO, ML, D, D, D}; pg8::StaticOrder S; S.init(ML, D, G, bid); EpiResB<true> E{(const float*)H1B, H2B, MOD, 5, 1.0f}; pg8::gemm_phase<EpiResB<true>, pg8::StaticOrder, GEMM_ALIGN, GEMM_SP2>(lds, g, S, E, nullptr); }
    GRID_SYNC();
    normmod_phase<true, true, false, false, true>((const float*)H2B, HC1, ML, P.in[I_NF2], MOD, 6, 7, U, OUT);
    GRID_SYNC();
    { pg8::Gemm g{U, WUP, ML, 2 * FF, D, D}; pg8::StaticOrder S; S.init(ML, 2 * FF, G, bid); EpiSwiglu E{H, FF}; pg8::gemm_phase<EpiSwiglu, pg8::StaticOrder, GEMM_ALIGN, GEMM_SP2>(lds, g, S, E, nullptr); }
    GRID_SYNC();
    { pg8::Gemm g{H, WDN, ML, D, FF, FF}; pg8::StaticOrder S; S.init(ML, D, G, bid); EpiDelta E{DLT, MOD, 8, 0.5f}; pg8::gemm_phase<EpiDelta, pg8::StaticOrder, GEMM_ALIGN, GEMM_SP2>(lds, g, S, E, nullptr); }
    GRID_SYNC();
    normmod_phase<false, false, false, true, true>((const float*)H2B, HC1, ML, P.in[I_FN], MOD, 0, 0, U, OUT, nullptr, 0, DLT);
}

extern "C" void kernel_launch(void* const* d_in, const int* in_sizes, int n_in, void* d_out, int out_size, void* d_ws, size_t ws_size, hipStream_t stream) {
    static int grid = 0;
    if (grid == 0) {
        if (n_in != 26 || ws_size < WS_NEED) { fprintf(stderr, "kernel_launch: n_in %d ws %zu (need %zu)\n", n_in, ws_size, (size_t)WS_NEED); grid = -1; return; }
        int dev = 0, cus = 0, per_cu = 0;
        hipGetDevice(&dev); hipDeviceGetAttribute(&cus, hipDeviceAttributeMultiprocessorCount, dev);
        if (hipFuncSetAttribute((const void*)mega, hipFuncAttributeMaxDynamicSharedMemorySize, LDS_BYTES) != hipSuccess) { fprintf(stderr, "hipFuncSetAttribute failed\n"); grid = -1; return; }
        if (hipOccupancyMaxActiveBlocksPerMultiprocessor(&per_cu, (const void*)mega, 512, LDS_BYTES) != hipSuccess || per_cu < 1) { fprintf(stderr, "occupancy query: %d\n", per_cu); grid = -1; return; }
        grid = cus;
    }
    if (grid < 0) return;
    if (hipMemsetAsync((char*)d_ws + WS_BAR, 0, XCD_BAR_WORDS * sizeof(unsigned), stream) != hipSuccess) { fprintf(stderr, "memset failed\n"); return; }
    Params p{};
    for (int i = 0; i < 26; ++i) p.in[i] = (const float*)d_in[i];
    p.out = (float*)d_out; p.ws = (unsigned char*)d_ws;
    void* args[] = {&p};
    hipError_t e = hipLaunchCooperativeKernel((const void*)mega, dim3(grid), dim3(512), args, LDS_BYTES, stream);
    if (e != hipSuccess) fprintf(stderr, "cooperative launch failed: %s (grid %d)\n", hipGetErrorString(e), grid);
}
```

```cpp
#include <hip/hip_runtime.h>
#include <cstdio>
#define GEMM_ALIGN true
#define GEMM_SP2 true
namespace pg8 {
#define PG8_LAS __attribute__((address_space(3)))
typedef unsigned short bf16_t;
typedef short bf16x8 __attribute__((ext_vector_type(8)));
typedef float f32x4 __attribute__((ext_vector_type(4)));
typedef unsigned u32x4 __attribute__((ext_vector_type(4)));
constexpr int BM = 256, BK = 64, HALF = 128, HTB = HALF * BK * 2  , STAGE_BYTES = 8 * HTB, NXCD = 8, WGM = 8;

__host__ __device__ __forceinline__ int lds_byte(int r, int c) { const int st = (r >> 4) * 2 + (c >> 5), rr = r & 15, cc = c & 31, ob = rr * 64 + cc * 2; return st * 1024 + (ob ^ (((ob >> 9) & 1) << 5)); }
__host__ __device__ __forceinline__ void stage_rc(int b, int& R, int& C) { const int st = b / 1024, sb = b % 1024, swz = sb ^ (((sb >> 9) & 1) << 5); R = (st >> 1) * 16 + swz / 64; C = (st & 1) * 32 + (swz % 64) / 2; }
__host__ __device__ __forceinline__ int perm32(int rho) { const int n = rho >> 4, i = rho & 15; return 8 * (i >> 2) + 4 * n + (i & 3); }

struct Unit { int pm, pn, pk; };
struct Gemm { const bf16_t* A; const bf16_t* Bt; int M, N, K, Kp; };

struct StaticOrder {
    int nM, nN, nwg, G, c;
    __host__ __device__ void init(int M, int N, int G_, int c_) { nM = M / BM; nN = N / BM; nwg = nM * nN; G = G_; c = c_; }
    __host__ __device__ bool next(int i, Unit& u) const {
        const long L = (long)i * G + c; if (L >= nwg) return false;
        int wgid = (int)L; { const int q = nwg / NXCD, r = nwg % NXCD, xcd = wgid % NXCD, off = wgid / NXCD; wgid = (xcd < r ? xcd * (q + 1) : r * (q + 1) + (xcd - r) * q) + off; }
        const int nig = WGM * nN, gid = wgid / nig, fm = gid * WGM, gsz = (nM - fm) < WGM ? (nM - fm) : WGM;
        u.pm = fm + ((wgid % nig) % gsz); u.pn = (wgid % nig) / gsz; u.pk = 0; return true;
    }
    __device__ __forceinline__ void a_ready(const Unit&) const {}
    __device__ __forceinline__ void done(const Unit&) const {}
};
__device__ __forceinline__ unsigned cvt_pk_bf16(float lo, float hi) { unsigned r; asm volatile("v_cvt_pk_bf16_f32 %0, %1, %2" : "=v"(r) : "v"(lo), "v"(hi)); return r; }
template <class Epi, class Sched, bool ALIGN_EPI = false, bool SP2 = false, bool STAMP = false>
__device__ __forceinline__ void gemm_phase(PG8_LAS unsigned char* lds, const Gemm g, const Sched& S, const Epi& E, unsigned long long* stamps) {
    int tid_ = threadIdx.x; asm volatile("" : "+v"(tid_));
    const int tid = tid_, wid = __builtin_amdgcn_readfirstlane(tid >> 6), lane = tid & 63, wr = wid >> 2, wc = wid & 3, fr = lane & 15, fq = lane >> 4;
    const int K = g.Kp, nt = g.K / BK;
    int ts_lo = 0, ts_hi = 0, nts = 0; const unsigned long long rt_entry = STAMP ? (unsigned long long)wall_clock64() : 0ull;
#define PG8_STAMP() do { if (STAMP && wid == 0 && nts < 64) { const unsigned long long _c = (unsigned long long)clock64(); \
        ts_lo = (lane == nts) ? (int)(unsigned)_c : ts_lo; ts_hi = (lane == nts) ? (int)(unsigned)(_c >> 32) : ts_hi; ++nts; } } while (0)
    PG8_STAMP();
    unsigned voffA[2], voffB[2];
#pragma unroll
    for (int i = 0; i < 2; ++i) { int R, C; stage_rc(tid * 16 + i * 8192, R, C); const int Rb = Epi::PERM ? ((R & ~31) + perm32(R & 31)) : R;
        voffA[i] = (unsigned)(R * K + C) * 2u; voffB[i] = (unsigned)(Rb * K + C) * 2u; }
    const size_t kstep = (size_t)(BK * 2);
    const size_t hstep = (size_t)HALF * K * 2;
    const size_t tstep = 2 * hstep;
    const unsigned ldsw = (unsigned)wid * 1024u;
    const int aoff = lds_byte(wr * 64 + fr, fq * 8), boff = lds_byte(wc * 32 + fr, fq * 8);
#define PG8_SA(b, h) (((b) * 2 + (h)) * HTB)
#define PG8_SB(b, h) ((4 + (b) * 2 + (h)) * HTB)
#define PG8_STAGE(bufoff, gbase, voff) do { _Pragma("unroll") for (int _i = 0; _i < 2; ++_i) \
        __builtin_amdgcn_global_load_lds((const unsigned*)((const char*)(gbase) + (voff)[_i]), (PG8_LAS unsigned*)(lds + (bufoff) + ldsw + _i * 8192), 16, 0, 0); } while (0)
#define PG8_LDA(dst, b, h) do { _Pragma("unroll") for (int m = 0; m < 4; ++m) _Pragma("unroll") for (int k = 0; k < 2; ++k) dst[m][k] = *(const PG8_LAS bf16x8*)(lds + PG8_SA(b, h) + aoff + m * 2048 + k * 1024); } while (0)
#define PG8_LDB(dst, b, h) do { _Pragma("unroll") for (int n = 0; n < 2; ++n) _Pragma("unroll") for (int k = 0; k < 2; ++k) dst[n][k] = *(const PG8_LAS bf16x8*)(lds + PG8_SB(b, h) + boff + n * 2048 + k * 1024); } while (0)
#define PG8_MMA(ai, bj, At, Bt) do { __builtin_amdgcn_s_setprio(1); _Pragma("unroll") for (int m = 0; m < 4; ++m) _Pragma("unroll") for (int n = 0; n < 2; ++n) _Pragma("unroll") for (int k = 0; k < 2; ++k) \
        acc[ai][bj][m][n] = __builtin_amdgcn_mfma_f32_16x16x32_bf16(Bt[n][k], At[m][k], acc[ai][bj][m][n], 0, 0, 0); __builtin_amdgcn_s_setprio(0); } while (0)
#define PG8_WAIT_V(n) asm volatile("s_waitcnt vmcnt(" #n ")" ::: "memory")
#define PG8_WAIT_L(n) asm volatile("s_waitcnt lgkmcnt(" #n ")" ::: "memory")
#define PG8_BAR __builtin_amdgcn_s_barrier()
#define PG8_SCHED __builtin_amdgcn_sched_barrier(0)
    Unit cur, nxt; int ui = 0;
    if (!S.next(0, cur)) return;
    f32x4 acc[2][2][4][2];
#pragma unroll
    for (int a = 0; a < 2; ++a)
#pragma unroll
        for (int b = 0; b < 2; ++b)
#pragma unroll
            for (int m = 0; m < 4; ++m)
#pragma unroll
                for (int n = 0; n < 2; ++n) acc[a][b][m][n] = (f32x4){0.f, 0.f, 0.f, 0.f};
    bf16x8 At[4][2], B0[2][2], B1[2][2];
    const size_t pstep = (size_t)g.K * 2;
    const char* cA = (const char*)g.A + (size_t)cur.pm * tstep + (size_t)cur.pk * pstep; const char* cB = (const char*)g.Bt + (size_t)cur.pn * tstep + (size_t)cur.pk * pstep;
    S.a_ready(cur);
    if constexpr (SP2) {
        PG8_STAGE(PG8_SB(0, 0), cB, voffB); PG8_STAGE(PG8_SB(0, 1), cB + hstep, voffB); PG8_STAGE(PG8_SA(0, 0), cA, voffA); PG8_STAGE(PG8_SA(0, 1), cA + hstep, voffA);
        if (wr == 1) PG8_BAR;
        PG8_WAIT_V(2); PG8_BAR;
    } else {
        PG8_STAGE(PG8_SB(0, 0), cB, voffB); PG8_STAGE(PG8_SA(0, 0), cA, voffA); PG8_STAGE(PG8_SB(0, 1), cB + hstep, voffB); PG8_STAGE(PG8_SA(0, 1), cA + hstep, voffA);
        if (wr == 1) PG8_BAR;
        PG8_WAIT_V(4); PG8_BAR;
    }
    PG8_STAGE(PG8_SB(1, 0), cB + kstep, voffB); PG8_STAGE(PG8_SA(1, 0), cA + kstep, voffA); PG8_STAGE(PG8_SB(1, 1), cB + hstep + kstep, voffB);
    PG8_WAIT_V(6); PG8_BAR;
    PG8_STAMP();
    for (;;) {
        const bool has_next = S.next(ui + 1, nxt);
        const char* nA = has_next ? (const char*)g.A + (size_t)nxt.pm * tstep + (size_t)nxt.pk * pstep : cA; const char* nB = has_next ? (const char*)g.Bt + (size_t)nxt.pn * tstep + (size_t)nxt.pk * pstep : cB;
        for (int t = 0; t < nt; t += 2) {
            const bool last = (t == nt - 2);
            const char* a1 = cA + (size_t)(t + 1) * kstep;
            const char* a2 = last ? nA : cA + (size_t)(t + 2) * kstep; const char* b2 = last ? nB : cB + (size_t)(t + 2) * kstep;
            const char* a3 = a2 + kstep; const char* b3 = b2 + kstep;
            if (last && has_next) S.a_ready(nxt);
            if constexpr (SP2) {
            PG8_LDB(B0, 0, 0); PG8_LDB(B1, 0, 1); PG8_SCHED; PG8_LDA(At, 0, 0); PG8_STAGE(PG8_SA(1, 1), a1 + hstep, voffA);
            PG8_WAIT_V(8); PG8_WAIT_L(0); PG8_BAR; PG8_MMA(0, 0, At, B0); PG8_MMA(0, 1, At, B1); PG8_BAR; PG8_SCHED;
            PG8_LDA(At, 0, 1); PG8_STAGE(PG8_SB(0, 0), b2, voffB); PG8_STAGE(PG8_SB(0, 1), b2 + hstep, voffB); PG8_STAGE(PG8_SA(0, 0), a2, voffA);
            PG8_WAIT_V(8); PG8_WAIT_L(0); PG8_BAR; PG8_MMA(1, 0, At, B0); PG8_MMA(1, 1, At, B1); PG8_BAR; PG8_SCHED;
            PG8_LDB(B0, 1, 0); PG8_LDB(B1, 1, 1); PG8_SCHED; PG8_LDA(At, 1, 0); PG8_STAGE(PG8_SA(0, 1), a2 + hstep, voffA);
            PG8_WAIT_V(8); PG8_WAIT_L(0); PG8_BAR; PG8_MMA(0, 0, At, B0); PG8_MMA(0, 1, At, B1); PG8_BAR; PG8_SCHED;
            PG8_LDA(At, 1, 1); PG8_STAGE(PG8_SB(1, 0), b3, voffB); PG8_STAGE(PG8_SB(1, 1), b3 + hstep, voffB); PG8_STAGE(PG8_SA(1, 0), a3, voffA);
            PG8_WAIT_V(8); PG8_WAIT_L(0); PG8_BAR; PG8_MMA(1, 0, At, B0); PG8_MMA(1, 1, At, B1); PG8_BAR; PG8_SCHED;
            } else {
            PG8_LDB(B0, 0, 0); PG8_SCHED; PG8_LDA(At, 0, 0); PG8_STAGE(PG8_SA(1, 1), a1 + hstep, voffA);
            PG8_WAIT_L(8); PG8_BAR; PG8_WAIT_L(0); PG8_MMA(0, 0, At, B0); PG8_BAR; PG8_SCHED;
            PG8_LDB(B1, 0, 1); PG8_STAGE(PG8_SB(0, 0), b2, voffB);
            PG8_BAR; PG8_WAIT_L(0); PG8_MMA(0, 1, At, B1); PG8_BAR;
            PG8_LDA(At, 0, 1); PG8_STAGE(PG8_SA(0, 0), a2, voffA);
            PG8_BAR; PG8_WAIT_L(0); PG8_MMA(1, 0, At, B0); PG8_BAR; PG8_SCHED;
            PG8_STAGE(PG8_SB(0, 1), b2 + hstep, voffB);
            PG8_WAIT_V(6); PG8_BAR; PG8_MMA(1, 1, At, B1); PG8_BAR;
            PG8_LDB(B0, 1, 0); PG8_SCHED; PG8_LDA(At, 1, 0); PG8_STAGE(PG8_SA(0, 1), a2 + hstep, voffA);
            PG8_WAIT_L(8); PG8_BAR; PG8_WAIT_L(0); PG8_MMA(0, 0, At, B0); PG8_BAR; PG8_SCHED;
            PG8_LDB(B1, 1, 1); PG8_STAGE(PG8_SB(1, 0), b3, voffB);
            PG8_BAR; PG8_WAIT_L(0); PG8_MMA(0, 1, At, B1); PG8_BAR;
            PG8_LDA(At, 1, 1); PG8_STAGE(PG8_SA(1, 0), a3, voffA);
            PG8_BAR; PG8_WAIT_L(0); PG8_MMA(1, 0, At, B0); PG8_BAR; PG8_SCHED;
            PG8_STAGE(PG8_SB(1, 1), b3 + hstep, voffB);
            PG8_WAIT_V(6); PG8_BAR; PG8_MMA(1, 1, At, B1); PG8_BAR;
            }
        }
        PG8_STAMP();
        if constexpr (ALIGN_EPI) { if (wr == 0) PG8_BAR; }
        if constexpr (!Epi::AFTER_DRAIN) { E(acc, cur, wr, wc, fr, fq); S.done(cur); }
        PG8_STAMP();
        if (!has_next) break;
#pragma unroll
        for (int a = 0; a < 2; ++a)
#pragma unroll
            for (int b = 0; b < 2; ++b)
#pragma unroll
                for (int m = 0; m < 4; ++m)
#pragma unroll
                    for (int n = 0; n < 2; ++n) acc[a][b][m][n] = (f32x4){0.f, 0.f, 0.f, 0.f};
        cur = nxt; cA = nA; cB = nB; ++ui;
        if constexpr (ALIGN_EPI) { if (wr == 1) PG8_BAR; }
    }
    PG8_WAIT_V(0);
    if constexpr (!ALIGN_EPI) { if (wr == 0) PG8_BAR; }
    PG8_BAR;
    if constexpr (Epi::AFTER_DRAIN) { E.fused(acc, cur, wr, wc, fr, fq, lds, wid, lane); S.done(cur); }
    PG8_STAMP();
    if (STAMP && wid == 0) { stamps[lane] = lane < nts ? (((unsigned long long)(unsigned)ts_hi << 32) | (unsigned)ts_lo) : 0ull;
        if (lane == 62) stamps[62] = rt_entry; if (lane == 63) stamps[63] = (unsigned long long)wall_clock64(); }
#undef PG8_STAMP
#undef PG8_SA
#undef PG8_SB
#undef PG8_STAGE
#undef PG8_LDA
#undef PG8_LDB
#undef PG8_MMA
#undef PG8_WAIT_V
#undef PG8_WAIT_L
#undef PG8_BAR
#undef PG8_SCHED
}
}

#define LAS __attribute__((address_space(3)))
typedef unsigned short bf16;
typedef _Float16 f16;
typedef pg8::f32x4 f32x4;
typedef pg8::u32x4 u32x4;
typedef pg8::bf16x8 bf16x8;
typedef unsigned u32x2 __attribute__((ext_vector_type(2)));
typedef _Float16 f16x8 __attribute__((ext_vector_type(8)));
typedef _Float16 f16x4 __attribute__((ext_vector_type(4)));

constexpr int D = 1024, NB = 8, SEQ = 4096, CTXL = 256, ML = NB * SEQ, MC = NB * CTXL, MT = ML + MC, FF = 2816, NMODC = 9 * D;
constexpr float EPS = 1e-6f;
constexpr size_t MiB = 1ull << 20;
constexpr size_t WS_WUP = 0, WS_WDN = 11 * MiB, WS_WIN = 17 * MiB, WS_WPA = 35 * MiB, WS_WPB = 37 * MiB, WS_WO = 39 * MiB, WS_MOD = 41 * MiB,
                 WS_U = 42 * MiB, WS_R = 110 * MiB, WS_BAR = 41 * MiB + 512 * 1024;
constexpr size_t R_H = WS_R, R_HC1 = WS_R + 187 * MiB;
constexpr size_t R_Q = WS_R, R_GF = WS_R + 64 * MiB, R_GB = WS_R + 132 * MiB, R_V = WS_R + 200 * MiB, R_OF = WS_R + 268 * MiB, R_OB = WS_R + 332 * MiB;
constexpr size_t R_SG = WS_R, R_GLU = WS_R + 64 * MiB, R_GATES = WS_R + 128 * MiB;
constexpr size_t WS_NEED = WS_R + 396 * MiB;
constexpr int LDS_BYTES = 131072 + 4096;

struct Params { const float* in[26]; float* out; unsigned char* ws; };
enum { I_X = 0, I_C, I_CTX, I_CCTX, I_WADA, I_BADA, I_NF1, I_W1U, I_W1D, I_NMIX, I_WIN, I_LBL, I_HGN, I_WDW, I_BDW, I_LNG, I_LNB, I_WPA, I_WPB, I_WG, I_BG, I_WO,
       I_NF2, I_W2U, I_W2D, I_FN };

__device__ __forceinline__ int tid_opaque() { int t = threadIdx.x; asm volatile("" : "+v"(t)); return t; }
__device__ __forceinline__ float bf2f(unsigned short b) { return __uint_as_float(((unsigned)b) << 16); }
__device__ __forceinline__ float bflo(unsigned w) { return __uint_as_float(w << 16); }
__device__ __forceinline__ float bfhi(unsigned w) { return __uint_as_float(w & 0xffff0000u); }
typedef __bf16 bf2_t __attribute__((ext_vector_type(2)));
__device__ __forceinline__ unsigned pk2(float lo, float hi) { bf2_t v; v.x = (__bf16)lo; v.y = (__bf16)hi; return __builtin_bit_cast(unsigned, v); }
__device__ __forceinline__ float sigmoidf_(float x) { return __builtin_amdgcn_rcpf(1.0f + __expf(-x)); }
__device__ __forceinline__ float siluf_(float x) { return x * __builtin_amdgcn_rcpf(1.0f + __expf(-x)); }
typedef float f32x2 __attribute__((ext_vector_type(2)));
__device__ __forceinline__ f32x2 sig2_(f32x2 x) { const f32x2 t = x * (-1.44269504f); f32x2 e; e.x = __builtin_amdgcn_exp2f(t.x); e.y = __builtin_amdgcn_exp2f(t.y); const f32x2 d = e + 1.0f; f32x2 r; r.x = __builtin_amdgcn_rcpf(d.x); r.y = __builtin_amdgcn_rcpf(d.y); return r; }
__device__ __forceinline__ f32x4 sig4_(f32x4 x) { const f32x2 lo = sig2_(__builtin_shufflevector(x, x, 0, 1)), hi = sig2_(__builtin_shufflevector(x, x, 2, 3)); return (f32x4){lo.x, lo.y, hi.x, hi.y}; }
__device__ __forceinline__ f32x4 silu4_(f32x4 x) { return x * sig4_(x); }
__device__ __forceinline__ u32x2 pk4(f32x4 v) { u32x2 w; w.x = pk2(v[0], v[1]); w.y = pk2(v[2], v[3]); return w; }

struct EpiSwiglu {
    static constexpr bool PERM = true, AFTER_DRAIN = false;
    bf16* H; int ldh;
    __device__ __forceinline__ void operator()(const f32x4 (&acc)[2][2][4][2], const pg8::Unit& u, int wr, int wc, int fr, int fq) const {
        const int row0 = u.pm * 256 + wr * 64 + fr, col0 = u.pn * 128 + wc * 32 + 8 * fq;
#pragma unroll
        for (int ai = 0; ai < 2; ++ai)
#pragma unroll
            for (int m = 0; m < 4; ++m) {
                bf16* rowp = H + (size_t)(row0 + ai * 128 + m * 16) * ldh + col0;
                const u32x2 w0 = pk4(silu4_(acc[ai][0][m][0]) * acc[ai][1][m][0]), w1 = pk4(silu4_(acc[ai][0][m][1]) * acc[ai][1][m][1]);
                *(u32x4*)rowp = (u32x4){w0.x, w0.y, w1.x, w1.y};
            }
    }
};

struct EpiRes {
    static constexpr bool PERM = false, AFTER_DRAIN = false;
    const float* baseL; float* outL; const float* baseC; float* outC; const float* mod; int gidx; float coef;
    __device__ __forceinline__ void operator()(const f32x4 (&acc)[2][2][4][2], const pg8::Unit& u, int wr, int wc, int fr, int fq) const {
        const bool lat = u.pm < 128;
        const int prow = (lat ? u.pm : u.pm - 128) * 256 + wr * 64 + fr;
        const float* base = lat ? baseL : baseC; float* out = lat ? outL : outC;
        const float* gate = mod + (size_t)(lat ? (u.pm >> 4) : 8) * NMODC + gidx * D;
        const int col0 = u.pn * 256 + wc * 32 + 4 * fq;
        f32x4 gv[2][2];
#pragma unroll
        for (int bj = 0; bj < 2; ++bj)
#pragma unroll
            for (int n = 0; n < 2; ++n) gv[bj][n] = *(const f32x4*)(gate + col0 + bj * 128 + n * 16) * coef;
#pragma unroll
        for (int ai = 0; ai < 2; ++ai)
#pragma unroll
            for (int m = 0; m < 4; ++m) {
                const size_t off = (size_t)(prow + ai * 128 + m * 16) * D + col0;
#pragma unroll
                for (int bj = 0; bj < 2; ++bj)
#pragma unroll
                    for (int n = 0; n < 2; ++n) {
                        const f32x4 bs = *(const f32x4*)(base + off + bj * 128 + n * 16);
                        *(f32x4*)(out + off + bj * 128 + n * 16) = bs + gv[bj][n] * acc[ai][bj][m][n];
                    }
            }
    }
};


template <bool BASEB> struct EpiResB {
    static constexpr bool PERM = false, AFTER_DRAIN = false;
    const float* base; bf16* outb; const float* mod; int gidx; float coef;
    __device__ __forceinline__ void operator()(const f32x4 (&acc)[2][2][4][2], const pg8::Unit& u, int wr, int wc, int fr, int fq) const {
        const int prow = u.pm * 256 + wr * 64 + fr;
        const float* gate = mod + (size_t)(u.pm >> 4) * NMODC + gidx * D;
        const int col0 = u.pn * 256 + wc * 32 + 4 * fq;
        f32x4 gv[2][2];
#pragma unroll
        for (int bj = 0; bj < 2; ++bj)
#pragma unroll
            for (int n = 0; n < 2; ++n) gv[bj][n] = *(const f32x4*)(gate + col0 + bj * 128 + n * 16) * coef;
#pragma unroll
        for (int ai = 0; ai < 2; ++ai)
#pragma unroll
            for (int m = 0; m < 4; ++m) {
                const size_t off = (size_t)(prow + ai * 128 + m * 16) * D + col0;
#pragma unroll
                for (int bj = 0; bj < 2; ++bj)
#pragma unroll
                    for (int n = 0; n < 2; ++n) {
                        f32x4 bs;
                        if constexpr (BASEB) { const u32x2 t = *(const u32x2*)((const bf16*)base + off + bj * 128 + n * 16); bs = (f32x4){bflo(t.x), bfhi(t.x), bflo(t.y), bfhi(t.y)}; }
                        else bs = *(const f32x4*)(base + off + bj * 128 + n * 16);
                        *(u32x2*)(outb + off + bj * 128 + n * 16) = pk4(bs + gv[bj][n] * acc[ai][bj][m][n]);
                    }
            }
    }
};

struct EpiDelta {
    static constexpr bool PERM = true, AFTER_DRAIN = false;
    bf16* delta; const float* mod; int gidx; float coef;
    __device__ __forceinline__ void operator()(const f32x4 (&acc)[2][2][4][2], const pg8::Unit& u, int wr, int wc, int fr, int fq) const {
        const int row0 = u.pm * 256 + wr * 64 + fr, col0 = u.pn * 256 + wc * 32 + 8 * fq;
        const float* gate = mod + (size_t)(u.pm >> 4) * NMODC + gidx * D;
#pragma unroll
        for (int bj = 0; bj < 2; ++bj) {
            const f32x4 g0 = *(const f32x4*)(gate + col0 + bj * 128) * coef, g1 = *(const f32x4*)(gate + col0 + bj * 128 + 4) * coef;
#pragma unroll
            for (int ai = 0; ai < 2; ++ai)
#pragma unroll
                for (int m = 0; m < 4; ++m) {
                    const u32x2 w0 = pk4(acc[ai][bj][m][0] * g0), w1 = pk4(acc[ai][bj][m][1] * g1);
                    *(u32x4*)(delta + (size_t)(row0 + ai * 128 + m * 16) * D + col0 + bj * 128) = (u32x4){w0.x, w0.y, w1.x, w1.y};
                }
        }
    }
};

struct EpiMix1 {
    static constexpr bool PERM = true, AFTER_DRAIN = false;
    bf16* Q; f16* GF; f16* GB; bf16* V; const float* lbf; const float* lbb;
    __device__ __forceinline__ void operator()(const f32x4 (&acc)[2][2][4][2], const pg8::Unit& u, int wr, int wc, int fr, int fq) const {
        const int seg = u.pn >> 2;
        const int row0 = u.pm * 256 + wr * 64 + fr, col0 = (u.pn & 3) * 256 + wc * 32 + 8 * fq;
        if (seg == 0) {
            if (u.pm >= 128) return;
#pragma unroll
            for (int ai = 0; ai < 2; ++ai)
#pragma unroll
                for (int m = 0; m < 4; ++m)
#pragma unroll
                    for (int bj = 0; bj < 2; ++bj) {
                        const f32x4 a = acc[ai][bj][m][0], b = acc[ai][bj][m][1];
                        const u32x2 w0 = pk4(silu4_(a)), w1 = pk4(silu4_(b)); const u32x4 w = (u32x4){w0.x, w0.y, w1.x, w1.y};
                        *(u32x4*)(Q + (size_t)(row0 + ai * 128 + m * 16) * D + col0 + bj * 128) = w;
                    }
        } else if (seg == 3) {
#pragma unroll
            for (int ai = 0; ai < 2; ++ai)
#pragma unroll
                for (int m = 0; m < 4; ++m)
#pragma unroll
                    for (int bj = 0; bj < 2; ++bj) {
                        const f32x4 a = acc[ai][bj][m][0], b = acc[ai][bj][m][1];
                        u32x4 w; w.x = pk2(a[0], a[1]); w.y = pk2(a[2], a[3]); w.z = pk2(b[0], b[1]); w.w = pk2(b[2], b[3]);
                        *(u32x4*)(V + (size_t)(row0 + ai * 128 + m * 16) * D + col0 + bj * 128) = w;
                    }
        } else {
            const float* lb = (seg == 1) ? lbf : lbb; f16* G = (seg == 1) ? GF : GB;
#pragma unroll
            for (int bj = 0; bj < 2; ++bj) {
                const f32x4 l0 = *(const f32x4*)(lb + col0 + bj * 128), l1 = *(const f32x4*)(lb + col0 + bj * 128 + 4);
#pragma unroll
                for (int ai = 0; ai < 2; ++ai)
#pragma unroll
                    for (int m = 0; m < 4; ++m) {
                        const f32x4 a = acc[ai][bj][m][0], b = acc[ai][bj][m][1];
                        f16x8 w;
                        const f32x4 fa = l0 + (1.0f - l0) * sig4_(a), fb = l1 + (1.0f - l1) * sig4_(b);
#pragma unroll
                        for (int j = 0; j < 4; ++j) { w[j] = (f16)__builtin_amdgcn_logf(fa[j]); w[4 + j] = (f16)__builtin_amdgcn_logf(fb[j]); }
                        *(f16x8*)(G + (size_t)(row0 + ai * 128 + m * 16) * D + col0 + bj * 128) = w;
                    }
            }
        }
    }
};

struct EpiMix2 {
    static constexpr bool PERM = true, AFTER_DRAIN = false;
    bf16* SG; bf16* GLU; bf16* GATES; const float* bgate;
    __device__ __forceinline__ void operator()(const f32x4 (&acc)[2][2][4][2], const pg8::Unit& u, int wr, int wc, int fr, int fq) const {
        const int row0 = u.pm * 256 + wr * 64 + fr, cw = wc * 32 + 8 * fq;
        if (u.pn < 4) {
#pragma unroll
            for (int ai = 0; ai < 2; ++ai)
#pragma unroll
                for (int m = 0; m < 4; ++m)
#pragma unroll
                    for (int bj = 0; bj < 2; ++bj) {
                        const f32x4 a = acc[ai][bj][m][0], b = acc[ai][bj][m][1];
                        const u32x2 w0 = pk4(silu4_(a)), w1 = pk4(silu4_(b)); const u32x4 w = (u32x4){w0.x, w0.y, w1.x, w1.y};
                        *(u32x4*)(SG + (size_t)(row0 + ai * 128 + m * 16) * D + u.pn * 256 + bj * 128 + cw) = w;
                    }
        } else if (u.pn < 12) {
            const int c0 = (u.pn - 4) * 128 + cw;
#pragma unroll
            for (int ai = 0; ai < 2; ++ai)
#pragma unroll
                for (int m = 0; m < 4; ++m) {
                    const u32x2 w0 = pk4(acc[ai][0][m][0] * sig4_(acc[ai][1][m][0])), w1 = pk4(acc[ai][0][m][1] * sig4_(acc[ai][1][m][1])); const u32x4 w = (u32x4){w0.x, w0.y, w1.x, w1.y};
                    *(u32x4*)(GLU + (size_t)(row0 + ai * 128 + m * 16) * D + c0) = w;
                }
        } else {
            const int c0 = (u.pn - 12) * 256 + cw;
#pragma unroll
            for (int bj = 0; bj < 2; ++bj) {
                const f32x4 b0 = *(const f32x4*)(bgate + c0 + bj * 128), b1 = *(const f32x4*)(bgate + c0 + bj * 128 + 4);
#pragma unroll
                for (int ai = 0; ai < 2; ++ai)
#pragma unroll
                    for (int m = 0; m < 4; ++m) {
                        const f32x4 a = acc[ai][bj][m][0] + b0, b = acc[ai][bj][m][1] + b1;
                        const u32x2 w0 = pk4(sig4_(a)), w1 = pk4(sig4_(b)); const u32x4 w = (u32x4){w0.x, w0.y, w1.x, w1.y};
                        *(u32x4*)(GATES + (size_t)(row0 + ai * 128 + m * 16) * 2048 + c0 + bj * 128) = w;
                    }
            }
        }
    }
};

template <int ADD> struct EpiGate {
    static constexpr bool PERM = true, AFTER_DRAIN = false;
    const bf16* GATES; bf16* T; int goff;
    __device__ __forceinline__ void operator()(const f32x4 (&acc)[2][2][4][2], const pg8::Unit& u, int wr, int wc, int fr, int fq) const {
        const int row0 = u.pm * 256 + wr * 64 + fr, col0 = u.pn * 256 + wc * 32 + 8 * fq;
#pragma unroll
        for (int ai = 0; ai < 2; ++ai)
#pragma unroll
            for (int m = 0; m < 4; ++m)
#pragma unroll
                for (int bj = 0; bj < 2; ++bj) {
                    const size_t r = (size_t)(row0 + ai * 128 + m * 16);
                    const u32x4 g = *(const u32x4*)(GATES + r * 2048 + goff + col0 + bj * 128);
                    bf16* tp = T + r * D + col0 + bj * 128;
                    const f32x4 a = acc[ai][bj][m][0], b = acc[ai][bj][m][1];
                    float o[8];
                    o[0] = bflo(g.x) * a[0]; o[1] = bfhi(g.x) * a[1]; o[2] = bflo(g.y) * a[2]; o[3] = bfhi(g.y) * a[3];
                    o[4] = bflo(g.z) * b[0]; o[5] = bfhi(g.z) * b[1]; o[6] = bflo(g.w) * b[2]; o[7] = bfhi(g.w) * b[3];
                    if (ADD) { const u32x4 t = *(const u32x4*)tp;
                        o[0] += bflo(t.x); o[1] += bfhi(t.x); o[2] += bflo(t.y); o[3] += bfhi(t.y); o[4] += bflo(t.z); o[5] += bfhi(t.z); o[6] += bflo(t.w); o[7] += bfhi(t.w); }
                    u32x4 w; w.x = pk2(o[0], o[1]); w.y = pk2(o[2], o[3]); w.z = pk2(o[4], o[5]); w.w = pk2(o[6], o[7]);
                    *(u32x4*)tp = w;
                }
    }
};


struct KSplitOrder {
    int G, c;
    __device__ bool next(int i, pg8::Unit& u) const { const int L = i * G + c; if (L >= 352) return false; u.pk = L >> 5; u.pm = 128 + ((L & 31) >> 2); u.pn = L & 3; return true; }
    __device__ __forceinline__ void a_ready(const pg8::Unit&) const {}
    __device__ __forceinline__ void done(const pg8::Unit&) const {}
};
struct EpiPart {
    static constexpr bool PERM = false, AFTER_DRAIN = false;
    bf16* part;
    __device__ __forceinline__ void operator()(const f32x4 (&acc)[2][2][4][2], const pg8::Unit& u, int wr, int wc, int fr, int fq) const {
        const int prow = (u.pm - 128) * 256 + wr * 64 + fr, col0 = u.pn * 256 + wc * 32 + 4 * fq;
        bf16* base = part + ((size_t)u.pk * MC + prow) * D + col0;
#pragma unroll
        for (int ai = 0; ai < 2; ++ai)
#pragma unroll
            for (int m = 0; m < 4; ++m)
#pragma unroll
                for (int bj = 0; bj < 2; ++bj)
#pragma unroll
                    for (int n = 0; n < 2; ++n) *(u32x2*)(base + (size_t)(ai * 128 + m * 16) * D + bj * 128 + n * 16) = pk4(acc[ai][bj][m][n]);
    }
};

__device__ __forceinline__ void conv_tile(LAS unsigned char* lds, const float* src, int srcN, int k0, int n0, bf16* dst, int dstK, int drow0) {
    LAS float* T = (LAS float*)lds;
    const int tid = tid_opaque();
#pragma unroll
    for (int i = 0; i < 4; ++i) {
        const int kk = (tid >> 5) + 16 * i, n4 = tid & 31;
        const f32x4 v = *(const f32x4*)(src + (size_t)(k0 + kk) * srcN + n0 + 4 * n4);
#pragma unroll
        for (int j = 0; j < 4; ++j) T[kk * 129 + 4 * n4 + j] = v[j];
    }
    __syncthreads();
    {
        const int nn = tid >> 2, kq = tid & 3;
        float f[16];
#pragma unroll
        for (int j = 0; j < 16; ++j) f[j] = T[(16 * kq + j) * 129 + nn];
        u32x4 w0, w1;
        w0.x = pk2(f[0], f[1]); w0.y = pk2(f[2], f[3]); w0.z = pk2(f[4], f[5]); w0.w = pk2(f[6], f[7]);
        w1.x = pk2(f[8], f[9]); w1.y = pk2(f[10], f[11]); w1.z = pk2(f[12], f[13]); w1.w = pk2(f[14], f[15]);
        bf16* dp = dst + (size_t)(drow0 + nn) * dstK + k0 + 16 * kq;
        *(u32x4*)dp = w0; *(u32x4*)(dp + 8) = w1;
    }
    __syncthreads();
}
__device__ __forceinline__ void conv_job_item(LAS unsigned char* lds, int it, const float* src, int K, int N, bf16* dst, int roff, int pair_from, int NH) {
    const int nt = N / 128; const int kt = it / nt, ntile = it % nt; const int n0 = ntile * 128;
    int drow0;
    if (pair_from < 0 || n0 < pair_from) drow0 = roff + n0;
    else { const int n1 = n0 - pair_from; drow0 = roff + pair_from + ((n1 < NH) ? 256 * (n1 / 128) : 256 * ((n1 - NH) / 128) + 128); }
    conv_tile(lds, src, N, kt * 64, n0, dst, K, drow0);
}

template <bool MODU, bool OUT_BF16, bool CPART = false, bool ADDD = false, bool SRCB = false>
__device__ __forceinline__ void normmod_phase(const float* srcL, const float* srcC, int nrows, const float* gain, const float* mod, int ishift, int iscale, bf16* ub, float* of, const bf16* part = nullptr, int igate = 0, const bf16* dlt = nullptr) {
    const int tido = tid_opaque(); const int lane = tido & 63, wv = tido >> 6;
    f32x4 gn[4];
#pragma unroll
    for (int j = 0; j < 4; ++j) gn[j] = *(const f32x4*)(gain + 256 * j + 4 * lane);
    for (int row = blockIdx.x * 8 + wv; row < nrows; row += gridDim.x * 8) {
        const float* src = (row < ML) ? srcL + (size_t)row * D : srcC + (size_t)(row - ML) * D;
        f32x4 x[4]; float ss = 0.f;
#pragma unroll
        for (int j = 0; j < 4; ++j) {
            if (SRCB && row < ML) { const u32x2 t = *(const u32x2*)((const bf16*)srcL + (size_t)row * D + 256 * j + 4 * lane); x[j] = (f32x4){bflo(t.x), bfhi(t.x), bflo(t.y), bfhi(t.y)}; }
            else x[j] = *(const f32x4*)(src + 256 * j + 4 * lane);
            if constexpr (ADDD) { const u32x2 t = *(const u32x2*)(dlt + (size_t)row * D + 256 * j + 4 * lane); x[j] += (f32x4){bflo(t.x), bfhi(t.x), bflo(t.y), bfhi(t.y)}; }
            if constexpr (CPART) { if (row >= ML) {
                f32x4 sp = (f32x4){0.f, 0.f, 0.f, 0.f};
#pragma unroll
                for (int pk = 0; pk < 11; ++pk) { const u32x2 t = *(const u32x2*)(part + ((size_t)pk * MC + (row - ML)) * D + 256 * j + 4 * lane); sp += (f32x4){bflo(t.x), bfhi(t.x), bflo(t.y), bfhi(t.y)}; }
                x[j] += sp * (*(const f32x4*)(mod + (size_t)8 * NMODC + igate * D + 256 * j + 4 * lane) * 0.5f); } }
            ss += x[j][0] * x[j][0] + x[j][1] * x[j][1] + x[j][2] * x[j][2] + x[j][3] * x[j][3]; }
#pragma unroll
        for (int o = 32; o >= 1; o >>= 1) ss += __shfl_xor(ss, o);
        const float rinv = rsqrtf(ss * (1.0f / D) + EPS);
        const int mrow = (row < ML) ? (row >> 12) : 8;
#pragma unroll
        for (int j = 0; j < 4; ++j) {
            f32x4 y = x[j] * rinv * gn[j];
            if constexpr (MODU) { const f32x4 sh = *(const f32x4*)(mod + (size_t)mrow * NMODC + ishift * D + 256 * j + 4 * lane), sc = *(const f32x4*)(mod + (size_t)mrow * NMODC + iscale * D + 256 * j + 4 * lane);
                y = y * (sc + 1.0f) + sh; }
            if constexpr (OUT_BF16) { u32x2 w; w.x = pk2(y[0], y[1]); w.y = pk2(y[2], y[3]); *(u32x2*)(ub + (size_t)row * D + 256 * j + 4 * lane) = w; }
            else *(f32x4*)(of + (size_t)row * D + 256 * j + 4 * lane) = y;
        }
    }
}

__device__ __forceinline__ void adaln_item(LAS unsigned char* lds, int item, const float* wada, const float* bada, float* MOD) {
    LAS float* SC = (LAS float*)lds;
    LAS float* RED = (LAS float*)(lds + 36864);
    const int tid = threadIdx.x, col = tid & 63, kg = tid >> 6, n0 = item * 64;
    float acc[9];
#pragma unroll
    for (int r = 0; r < 9; ++r) acc[r] = 0.f;
    for (int k = kg * 128; k < kg * 128 + 128; ++k) {
        const float w = wada[(size_t)k * NMODC + n0 + col];
#pragma unroll
        for (int r = 0; r < 9; ++r) acc[r] += SC[r * 1024 + k] * w;
    }
#pragma unroll
    for (int r = 0; r < 9; ++r) RED[(kg * 9 + r) * 64 + col] = acc[r];
    __syncthreads();
    for (int idx = tid; idx < 576; idx += 512) {
        const int r = idx >> 6, c = idx & 63; float s = bada[n0 + c];
#pragma unroll
        for (int g = 0; g < 8; ++g) s += RED[(g * 9 + r) * 64 + c];
        MOD[(size_t)r * NMODC + n0 + c] = s;
    }
    __syncthreads();
}

__device__ __forceinline__ void aop_rows(int row_begin, int row_end, int row_step, bf16* OF, const bf16* OB, const bf16* SG, const float* hgn) {
    const int lane = tid_opaque() & 63;
    float gn[16];
#pragma unroll
    for (int j = 0; j < 4; ++j) { const f32x4 t = *(const f32x4*)(hgn + (lane & 7) * 16 + 4 * j); gn[4 * j] = t[0]; gn[4 * j + 1] = t[1]; gn[4 * j + 2] = t[2]; gn[4 * j + 3] = t[3]; }
    for (int row = row_begin; row < row_end; row += row_step) {
        const size_t off = (size_t)row * D + 16 * lane;
        const u32x4 f0 = *(const u32x4*)(OF + off), f1 = *(const u32x4*)(OF + off + 8);
        const u32x4 b0 = *(const u32x4*)(OB + off), b1 = *(const u32x4*)(OB + off + 8);
        const u32x4 s0 = *(const u32x4*)(SG + off), s1 = *(const u32x4*)(SG + off + 8);
        float o[16], sg[16];
#pragma unroll
        for (int j = 0; j < 4; ++j) {
            o[2 * j] = bflo(f0[j]) + bflo(b0[j]); o[2 * j + 1] = bfhi(f0[j]) + bfhi(b0[j]);
            o[8 + 2 * j] = bflo(f1[j]) + bflo(b1[j]); o[8 + 2 * j + 1] = bfhi(f1[j]) + bfhi(b1[j]);
            sg[2 * j] = bflo(s0[j]); sg[2 * j + 1] = bfhi(s0[j]); sg[8 + 2 * j] = bflo(s1[j]); sg[8 + 2 * j + 1] = bfhi(s1[j]);
        }
        float ss = 0.f;
#pragma unroll
        for (int j = 0; j < 16; ++j) ss += o[j] * o[j];
        ss += __shfl_xor(ss, 1); ss += __shfl_xor(ss, 2); ss += __shfl_xor(ss, 4);
        const float rinv = rsqrtf(ss * (1.0f / 128.0f) + EPS);
        float a[16];
#pragma unroll
        for (int j = 0; j < 16; ++j) a[j] = o[j] * rinv * gn[j] * sg[j];
        u32x4 w0, w1;
        w0.x = pk2(a[0], a[1]); w0.y = pk2(a[2], a[3]); w0.z = pk2(a[4], a[5]); w0.w = pk2(a[6], a[7]);
        w1.x = pk2(a[8], a[9]); w1.y = pk2(a[10], a[11]); w1.z = pk2(a[12], a[13]); w1.w = pk2(a[14], a[15]);
        *(u32x4*)(OF + off) = w0; *(u32x4*)(OF + off + 8) = w1;
    }
}

__device__ __forceinline__ void conv_items(LAS unsigned char* lds, int item_begin, int item_end, int item_step, const bf16* GLU, const float* wdw, const float* bdw, const float* lng, const float* lnb, bf16* BOP) {
    constexpr int TT = 16;
    LAS float* P1 = (LAS float*)lds;
    LAS float* P2 = (LAS float*)(lds + 65536);
    LAS float* ST = (LAS float*)(lds + 131072);
    const int tid = tid_opaque(), c = 2 * tid;
    float w[31][2];
#pragma unroll
    for (int j = 0; j < 31; ++j) { w[j][0] = wdw[j * D + c]; w[j][1] = wdw[j * D + c + 1]; }
    const float bd0 = bdw[c], bd1 = bdw[c + 1], g0 = lng[c], g1 = lng[c + 1], b0 = lnb[c], b1 = lnb[c + 1];
    for (int item = item_begin; item < item_end; item += item_step) {
        const int b = item / (SEQ / TT), t0 = (item % (SEQ / TT)) * TT;
        float y[TT][2];
        unsigned xw[TT + 30];
#pragma unroll
        for (int r = 0; r < TT + 30; ++r) {
            const int pos = t0 - 15 + r;
            xw[r] = 0u;
            if (pos >= 0 && pos < SEQ) xw[r] = *(const unsigned*)(GLU + (size_t)(b * SEQ + pos) * D + c);
        }
        typedef float f32x2_t __attribute__((ext_vector_type(2)));
        f32x2_t xf[TT + 30];
#pragma unroll
        for (int r = 0; r < TT + 30; ++r) { xf[r].x = bflo(xw[r]); xf[r].y = bfhi(xw[r]); }
#pragma unroll
        for (int t = 0; t < TT; ++t) {
            f32x2_t a2; a2.x = bd0; a2.y = bd1;
#pragma unroll
            for (int j = 0; j < 31; ++j) { f32x2_t w2; w2.x = w[j][0]; w2.y = w[j][1]; a2 = __builtin_elementwise_fma(xf[t + j], w2, a2); }
            y[t][0] = a2.x; y[t][1] = a2.y;
        }
#pragma unroll
        for (int t = 0; t < TT; ++t) { P1[t * 512 + tid] = y[t][0] + y[t][1]; P2[t * 512 + tid] = y[t][0] * y[t][0] + y[t][1] * y[t][1]; }
        __syncthreads();
        {
            const int t = tid >> 5, part = tid & 31; float s = 0.f, q = 0.f;
#pragma unroll
            for (int j = 0; j < 4; ++j) { const f32x4 a = *(const LAS f32x4*)(P1 + t * 512 + part * 16 + 4 * j), bq = *(const LAS f32x4*)(P2 + t * 512 + part * 16 + 4 * j);
                s += (a[0] + a[1]) + (a[2] + a[3]); q += (bq[0] + bq[1]) + (bq[2] + bq[3]); }
#pragma unroll
            for (int o = 16; o >= 1; o >>= 1) { s += __shfl_xor(s, o); q += __shfl_xor(q, o); }
            if (part == 0) { const float mean = s * (1.0f / D); const float var = fmaxf(q * (1.0f / D) - mean * mean, 0.f); ST[2 * t] = mean; ST[2 * t + 1] = rsqrtf(var + EPS); }
        }
        __syncthreads();
#pragma unroll
        for (int t = 0; t < TT; ++t) {
            const float mean = ST[2 * t], rstd = ST[2 * t + 1];
            const float v0 = (y[t][0] - mean) * rstd * g0 + b0, v1 = (y[t][1] - mean) * rstd * g1 + b1;
            *(unsigned*)(BOP + (size_t)(b * SEQ + t0 + t) * D + c) = pk2(siluf_(v0), siluf_(v1));
        }
        __syncthreads();
    }
}

__device__ __forceinline__ size_t scan_rowbase(int ci, int t, int dir, int b) {
    const bool ctx = ci < 8; const int lc = ctx ? ci : ci - 8, nch = ctx ? 8 : 128;
    const int p0 = dir ? (nch - 1 - lc) * 32 : lc * 32; const int pos = dir ? p0 + 31 - t : p0 + t;
    return ctx ? (size_t)(ML + b * CTXL + pos) : (size_t)(b * SEQ + pos);
}
constexpr int S2_QS = 0, S2_KS = 26112, S2_KET = 43520, S2_VT = 74240, S2_DEC = 89600, S2_AS = 91136, S2_ST = 96256;
constexpr int QROW = 272, SROW = 80;
struct ScanRegs { u32x4 q, g, v; };
struct ScanCtx { const bf16* Q; const f16* G; const bf16* V; bf16* O; int b, h, dvh, dir, w, lane, l15, q4, tau, cg; };

__device__ __forceinline__ void scan_issue(const ScanCtx& c, int ci, ScanRegs& r) {
    const size_t row = scan_rowbase(ci, c.tau, c.dir, c.b);
    const size_t qrow = (ci >= 8) ? row : (size_t)(c.b * SEQ + c.tau);
    const int d0 = 16 * c.w + 8 * c.cg;
    r.g = *(const u32x4*)(c.G + row * D + c.h * 128 + d0);
    r.q = *(const u32x4*)(c.Q + qrow * D + c.h * 128 + d0);
    r.v = *(const u32x4*)(c.V + row * D + c.h * 128 + c.dvh * 64 + 8 * c.w);
}
template <int CTRL, int ROWMASK> __device__ __forceinline__ float dpp_mul_(float x) {
    const int y = __builtin_amdgcn_update_dpp(0x3f800000, __float_as_int(x), CTRL, ROWMASK, 0xF, false);
    return x * __int_as_float(y);
}
__device__ __forceinline__ void scan_E(LAS unsigned char* lds, const ScanCtx& c, int ci, const ScanRegs& r) {
    const bool lat = ci >= 8; const int s3 = ci % 3, s2 = ci & 1; const int tau = c.tau, d0 = 16 * c.w + 8 * c.cg;
    float f[8], P[8];
    { const f16x8 gh = __builtin_bit_cast(f16x8, r.g);
#pragma unroll
      for (int j = 0; j < 8; ++j) { P[j] = __builtin_amdgcn_exp2f((float)gh[j]); f[j] = 1.0f - P[j]; } }
#define DPP8(ctrl) "v_mul_f32_dpp %0, %0, %0 " ctrl "\n\tv_mul_f32_dpp %1, %1, %1 " ctrl "\n\tv_mul_f32_dpp %2, %2, %2 " ctrl "\n\tv_mul_f32_dpp %3, %3, %3 " ctrl "\n\t" \
                   "v_mul_f32_dpp %4, %4, %4 " ctrl "\n\tv_mul_f32_dpp %5, %5, %5 " ctrl "\n\tv_mul_f32_dpp %6, %6, %6 " ctrl "\n\tv_mul_f32_dpp %7, %7, %7 " ctrl "\n\t"
    asm volatile("s_nop 1\n\t"
                 DPP8("row_shr:1 row_mask:0xf bank_mask:0xf") DPP8("row_shr:2 row_mask:0xf bank_mask:0xf") DPP8("row_shr:4 row_mask:0xf bank_mask:0xf")
                 DPP8("row_shr:8 row_mask:0xf bank_mask:0xf") DPP8("row_bcast:15 row_mask:0xa bank_mask:0xf") "s_nop 1"
                 : "+v"(P[0]), "+v"(P[1]), "+v"(P[2]), "+v"(P[3]), "+v"(P[4]), "+v"(P[5]), "+v"(P[6]), "+v"(P[7]));
#undef DPP8
    float kt[8], qg[8];
    const unsigned qw[4] = {r.q.x, r.q.y, r.q.z, r.q.w};
#pragma unroll
    for (int j = 0; j < 8; ++j) {
        const float k = f[j];
        float pc; asm("v_max_f32 %0, %1, %2" : "=v"(pc) : "v"(P[j]), "v"(1e-30f));
        kt[j] = k * __builtin_amdgcn_rcpf(pc);
        const float qv = (j & 1) ? bfhi(qw[j >> 1]) : bflo(qw[j >> 1]);
        qg[j] = qv * P[j];
    }
    u32x4 wk; wk.x = pk2(kt[0], kt[1]); wk.y = pk2(kt[2], kt[3]); wk.z = pk2(kt[4], kt[5]); wk.w = pk2(kt[6], kt[7]);
    *(LAS u32x4*)(lds + S2_KS + s2 * 8704 + tau * QROW + d0 * 2) = wk;
    if (lat) { u32x4 wq; wq.x = pk2(qg[0], qg[1]); wq.y = pk2(qg[2], qg[3]); wq.z = pk2(qg[4], qg[5]); wq.w = pk2(qg[6], qg[7]);
        *(LAS u32x4*)(lds + S2_QS + s3 * 8704 + tau * QROW + d0 * 2) = wq; }
    { const unsigned kw[4] = {wk.x, wk.y, wk.z, wk.w};
#pragma unroll
      for (int j = 0; j < 4; ++j) {
        *(LAS unsigned short*)(lds + S2_KET + s3 * 10240 + (d0 + 2 * j) * SROW + tau * 2) = (unsigned short)(kw[j] & 0xffffu);
        *(LAS unsigned short*)(lds + S2_KET + s3 * 10240 + (d0 + 2 * j + 1) * SROW + tau * 2) = (unsigned short)(kw[j] >> 16); } }
    if (tau == 31) { LAS float* DC = (LAS float*)(lds + S2_DEC + s3 * 512);
        *(LAS f32x4*)(DC + d0) = (f32x4){P[0], P[1], P[2], P[3]};
        *(LAS f32x4*)(DC + d0 + 4) = (f32x4){P[4], P[5], P[6], P[7]}; }
    if (c.lane < 32) { const unsigned vw[4] = {r.v.x, r.v.y, r.v.z, r.v.w};
#pragma unroll
        for (int j = 0; j < 4; ++j) {
            *(LAS unsigned short*)(lds + S2_VT + s3 * 5120 + (8 * c.w + 2 * j) * SROW + tau * 2) = (unsigned short)(vw[j] & 0xffffu);
            *(LAS unsigned short*)(lds + S2_VT + s3 * 5120 + (8 * c.w + 2 * j + 1) * SROW + tau * 2) = (unsigned short)(vw[j] >> 16); } }
}
__device__ __forceinline__ void scan_A(LAS unsigned char* lds, const ScanCtx& c, int ci) {
    if (c.w >= 3) return;
    const int s3 = ci % 3, s2 = ci & 1; const int l15 = c.l15, q4 = c.q4;
    const LAS unsigned char* QS = lds + S2_QS + s3 * 8704; const LAS unsigned char* KS = lds + S2_KS + s2 * 8704;
    const int ti = (c.w == 0) ? 0 : 1, sj = (c.w == 2) ? 1 : 0;
    f32x4 a4 = (f32x4){0.f, 0.f, 0.f, 0.f};
#pragma unroll
    for (int kk = 0; kk < 4; ++kk) {
        const bf16x8 xa = *(const LAS bf16x8*)(KS + (sj * 16 + l15) * QROW + kk * 64 + q4 * 16);
        const bf16x8 yb = *(const LAS bf16x8*)(QS + (ti * 16 + l15) * QROW + kk * 64 + q4 * 16);
        a4 = __builtin_amdgcn_mfma_f32_16x16x32_bf16(xa, yb, a4, 0, 0, 0);
    }
    const int t = ti * 16 + l15, s0 = sj * 16 + 4 * q4;
    const float m0 = (s0 <= t) ? a4[0] : 0.f, m1 = (s0 + 1 <= t) ? a4[1] : 0.f, m2 = (s0 + 2 <= t) ? a4[2] : 0.f, m3 = (s0 + 3 <= t) ? a4[3] : 0.f;
    u32x2 wa; wa.x = pk2(m0, m1); wa.y = pk2(m2, m3);
    *(LAS u32x2*)(lds + S2_AS + s2 * 2560 + t * SROW + s0 * 2) = wa;
}
__device__ __forceinline__ void scan_M(LAS unsigned char* lds, const ScanCtx& c, int ci, f32x4 (&accS)[4]) {
    const bool lat = ci >= 8; const int s3 = ci % 3, s2 = ci & 1; const int l15 = c.l15, q4 = c.q4, w = c.w;
    const LAS unsigned char* QS = lds + S2_QS + s3 * 8704; const LAS unsigned char* KET = lds + S2_KET + s3 * 10240; const LAS unsigned char* VT = lds + S2_VT + s3 * 5120;
    const LAS unsigned char* STr = lds + S2_ST + s2 * 17408; LAS unsigned char* STw = lds + S2_ST + (s2 ^ 1) * 17408;
    const int tt = w >> 2, et = w & 3;
    if (lat) {
        f32x4 acco = (f32x4){0.f, 0.f, 0.f, 0.f};
#pragma unroll
        for (int kk = 0; kk < 4; ++kk) {
            const bf16x8 xa = *(const LAS bf16x8*)(STr + (et * 16 + l15) * QROW + kk * 64 + q4 * 16);
            const bf16x8 yb = *(const LAS bf16x8*)(QS + (tt * 16 + l15) * QROW + kk * 64 + q4 * 16);
            acco = __builtin_amdgcn_mfma_f32_16x16x32_bf16(xa, yb, acco, 0, 0, 0);
        }
        {
            const bf16x8 xa = *(const LAS bf16x8*)(VT + (et * 16 + l15) * SROW + q4 * 16);
            const bf16x8 yb = *(const LAS bf16x8*)(lds + S2_AS + s2 * 2560 + (tt * 16 + l15) * SROW + q4 * 16);
            acco = __builtin_amdgcn_mfma_f32_16x16x32_bf16(xa, yb, acco, 0, 0, 0);
        }
        const size_t r = scan_rowbase(ci, tt * 16 + l15, c.dir, c.b);
        u32x2 wo; wo.x = pk2(acco[0], acco[1]); wo.y = pk2(acco[2], acco[3]);
        { bf16* op = c.O + r * D + c.h * 128 + c.dvh * 64 + et * 16 + 4 * q4;
          asm volatile("global_store_dwordx2 %0, %1, off" :: "v"(op), "v"(wo) : "memory"); }
    }
    {
        const f32x4 dc = *(const LAS f32x4*)(lds + S2_DEC + s3 * 512 + (16 * w + 4 * q4) * 4);
        const bf16x8 xa = *(const LAS bf16x8*)(KET + (16 * w + l15) * SROW + q4 * 16);
#pragma unroll
        for (int i = 0; i < 4; ++i) {
            const bf16x8 yb = *(const LAS bf16x8*)(VT + (16 * i + l15) * SROW + q4 * 16);
            accS[i] = __builtin_amdgcn_mfma_f32_16x16x32_bf16(xa, yb, accS[i], 0, 0, 0) * dc;
        }
#pragma unroll
        for (int i = 0; i < 4; ++i) {
            u32x2 ws_; ws_.x = pk2(accS[i][0], accS[i][1]); ws_.y = pk2(accS[i][2], accS[i][3]);
            *(LAS u32x2*)(STw + (16 * i + l15) * QROW + (16 * w + 4 * q4) * 2) = ws_;
        }
    }
}
__device__ __forceinline__ void scan_item(LAS unsigned char* lds, int item, const bf16* Q, const f16* GF, const f16* GB, const bf16* V, bf16* OF, bf16* OB) {
    const int tid = tid_opaque(), lane = tid & 63;
    ScanCtx c;
    c.dvh = item & 1; c.dir = (item >> 1) & 1; c.h = (item >> 2) & 7; c.b = item >> 5;
    c.Q = Q; c.G = c.dir ? GB : GF; c.V = V; c.O = c.dir ? OB : OF;
    c.w = __builtin_amdgcn_readfirstlane(tid >> 6); c.lane = lane; c.l15 = lane & 15; c.q4 = lane >> 4; c.tau = lane & 31; c.cg = lane >> 5;
    for (int i = tid; i < (5120 + 34816) / 4; i += 512) ((LAS unsigned*)(lds + S2_AS))[i] = 0u;
    f32x4 accS[4];
#pragma unroll
    for (int i = 0; i < 4; ++i) accS[i] = (f32x4){0.f, 0.f, 0.f, 0.f};
    ScanRegs r0, r1, r2, r3;
    r0.q = r1.q = r2.q = r3.q = (u32x4){0u, 0u, 0u, 0u}; r0.v = r1.v = r2.v = r3.v = (u32x4){0u, 0u, 0u, 0u};
    scan_issue(c, 0, r0); scan_issue(c, 1, r1); scan_issue(c, 2, r2); scan_issue(c, 3, r3);
    __syncthreads();
#define SCAN_STEP(T_, R_) do { const int T = (T_); \
        __builtin_amdgcn_s_setprio(2); if (T >= 2) scan_M(lds, c, T - 2, accS); __builtin_amdgcn_s_setprio(0); \
        if (T >= 9) scan_A(lds, c, T - 1); \
        scan_E(lds, c, T, R_); { const int nx = (T + 4 < 136) ? T + 4 : 135; scan_issue(c, nx, R_); } \
        __syncthreads(); } while (0)
    for (int T0 = 0; T0 < 136; T0 += 4) { SCAN_STEP(T0, r0); SCAN_STEP(T0 + 1, r1); SCAN_STEP(T0 + 2, r2); SCAN_STEP(T0 + 3, r3); }
    scan_M(lds, c, 134, accS); scan_A(lds, c, 135); __syncthreads();
    scan_M(lds, c, 135, accS); __syncthreads();
    asm volatile("s_waitcnt vmcnt(0)" ::: "memory");
#undef SCAN_STEP
}

#define XB_TMO      128
#define XB_XCNT(j)  (256  + 64 * (j))
#define XB_XSUB(j)  (1280 + 64 * (j))
#define XB_XGEN(j)  (2304 + 64 * (j))
#define XB_TOP      3328
#define XB_TOPGEN   3392
#define XCD_BAR_WORDS 3456
#define XB_SPIN_CAP (1u << 18)

__device__ __forceinline__ unsigned xb_ld(unsigned* p)              { return __hip_atomic_load(p, __ATOMIC_RELAXED, __HIP_MEMORY_SCOPE_AGENT); }
__device__ __forceinline__ unsigned xb_add(unsigned* p, unsigned v) { return __hip_atomic_fetch_add(p, v, __ATOMIC_RELAXED, __HIP_MEMORY_SCOPE_AGENT); }
__device__ __forceinline__ unsigned xb_xcc_id() { return (unsigned)__builtin_amdgcn_s_getreg((3 << 11) | 20) & 0xFu; }
#define XB_SPIN(cond, bar) do { unsigned _sp = 0; while (cond) { __builtin_amdgcn_s_sleep(1); \
    if ((++_sp & 255u) == 0u) { if (xb_ld(&(bar)[XB_TMO])) break; if (_sp > XB_SPIN_CAP) { atomicAdd(&(bar)[XB_TMO], 1u); break; } } } } while (0)

struct XcdBarrier {
    unsigned* bar; unsigned x;
    volatile LAS unsigned* st;
};

__device__ __forceinline__ XcdBarrier xcd_barrier_post(unsigned* bar, volatile LAS unsigned* st) {
    XcdBarrier b; b.bar = bar; b.x = xb_xcc_id(); b.st = st;
    if (threadIdx.x == 0) (void)xb_add(&bar[XB_XCNT(b.x)], 1u);
    return b;
}
__device__ __forceinline__ void xcd_barrier_complete(unsigned* bar, unsigned x, unsigned& nloc, unsigned& nx) {
    const unsigned G = gridDim.x * gridDim.y * gridDim.z;
    unsigned sum, cnt, mine, sp = 0u;
    for (;;) {
        sum = 0u; cnt = 0u; mine = 0u;
#pragma unroll
        for (unsigned j = 0; j < 16; ++j) { const unsigned c = xb_ld(&bar[XB_XCNT(j)]); sum += c; cnt += (c > 0u) ? 1u : 0u; mine = (j == x) ? c : mine; }
        if (sum == G) break;
        __builtin_amdgcn_s_sleep(1);
        if ((++sp & 255u) == 0u) { if (xb_ld(&bar[XB_TMO])) break; if (sp > XB_SPIN_CAP) { atomicAdd(&bar[XB_TMO], 1u); break; } }
    }
    nloc = mine > 0u ? mine : 1u; nx = cnt > 0u ? cnt : 1u;
}

__device__ __forceinline__ void xcd_barrier(const XcdBarrier& b) {
    asm volatile("s_waitcnt vmcnt(0)" ::: "memory");
    __syncthreads();
    if (threadIdx.x == 0) {
        unsigned* bar = b.bar;
        __builtin_amdgcn_s_waitcnt(0);
        unsigned nloc = b.st[0], nx = b.st[1];
        if (nloc == 0u) { xcd_barrier_complete(bar, b.x, nloc, nx); b.st[0] = nloc; b.st[1] = nx; }
        const unsigned old = xb_add(&bar[XB_XSUB(b.x)], 1u);
        const unsigned gen = old / nloc;
        if (old + 1u == (gen + 1u) * nloc) {
            __builtin_amdgcn_fence(__ATOMIC_RELEASE, "agent");
            asm volatile("s_waitcnt vmcnt(0)" ::: "memory");
            const unsigned og = xb_add(&bar[XB_TOP], 1u);
            const unsigned tg = og / nx;
            if (og + 1u == (tg + 1u) * nx) xb_add(&bar[XB_TOPGEN], 1u);
            else XB_SPIN(xb_ld(&bar[XB_TOPGEN]) == tg, bar);
            __builtin_amdgcn_fence(__ATOMIC_ACQUIRE, "agent");
            xb_add(&bar[XB_XGEN(b.x)], 1u);
            asm volatile("s_waitcnt vmcnt(0)" ::: "memory");
        } else {
            XB_SPIN(xb_ld(&bar[XB_XGEN(b.x)]) == gen, bar);
            __builtin_amdgcn_fence(__ATOMIC_ACQUIRE, "agent");
            asm volatile("s_waitcnt vmcnt(0)" ::: "memory");
        }
    }
    __syncthreads();
}

__global__ void __launch_bounds__(512, 2) mega(Params P) {
    extern __shared__ __attribute__((aligned(16))) unsigned char lds_raw[];
    LAS unsigned char* lds = (LAS unsigned char*)lds_raw;
#define GRID_SYNC() xcd_barrier(xbar)
    if (threadIdx.x < 2) ((volatile LAS unsigned*)(lds + 131072 + 1024))[threadIdx.x] = 0u;
    __syncthreads();
    XcdBarrier xbar = xcd_barrier_post((unsigned*)(P.ws + WS_BAR), (volatile LAS unsigned*)(lds + 131072 + 1024));
    const int tid = threadIdx.x, G = gridDim.x, bid = blockIdx.x;
    unsigned char* ws = P.ws;
    bf16* WUP = (bf16*)(ws + WS_WUP); bf16* WDN = (bf16*)(ws + WS_WDN); bf16* WIN = (bf16*)(ws + WS_WIN);
    bf16* WPA = (bf16*)(ws + WS_WPA); bf16* WPB = (bf16*)(ws + WS_WPB); bf16* WO = (bf16*)(ws + WS_WO);
    float* MOD = (float*)(ws + WS_MOD); float* LBF = MOD + 9 * NMODC; float* LBB = LBF + 1024;
    bf16* U = (bf16*)(ws + WS_U);
    bf16* H = (bf16*)(ws + R_H); float* HC1 = (float*)(ws + R_HC1);
    bf16* Qb = (bf16*)(ws + R_Q); f16* GFb = (f16*)(ws + R_GF); f16* GBb = (f16*)(ws + R_GB); bf16* Vb = (bf16*)(ws + R_V);
    bf16* OFb = (bf16*)(ws + R_OF); bf16* OBb = (bf16*)(ws + R_OB);
    bf16* SGb = (bf16*)(ws + R_SG); bf16* GLUb = (bf16*)(ws + R_GLU); bf16* GATESb = (bf16*)(ws + R_GATES);
    bf16* BOP = U; bf16* Tb = OBb;
    bf16* H2B = OFb;
    bf16* DLT = (bf16*)(ws + WS_R + 192 * MiB);
    bf16* PART = (bf16*)(ws + WS_R + 192 * MiB);
    float* OUT = P.out;
    bf16* H1B = (bf16*)OUT;

    {
        if (bid < 144) {
            LAS float* SC = (LAS float*)lds;
            for (int i = tid; i < 9 * 1024; i += 512) { const float v = (i < 8192) ? P.in[I_C][i] : P.in[I_CCTX][i - 8192]; SC[i] = siluf_(v); }
            __syncthreads();
            for (int item = bid; item < 144; item += G) adaln_item(lds, item, P.in[I_WADA], P.in[I_BADA], MOD);
        }
        if (bid == G - 1) {
            const float* l = P.in[I_LBL];
            for (int d = tid; d < 1024; d += 512) { LBF[d] = 1.0f / (1.0f + __expf(l[2048 + d] - l[d])); LBB[d] = 1.0f / (1.0f + __expf(l[3072 + d] - l[1024 + d])); }
        }
        for (int it = (bid + 112) % G; it < 2592; it += G) {
            if (it < 704) conv_job_item(lds, it, P.in[I_W1U], 1024, 5632, WUP, 0, 0, 2816);
            else if (it < 1056) conv_job_item(lds, it - 704, P.in[I_W1D], 2816, 1024, WDN, 0, -1, 0);
            else if (it < 1952) conv_job_item(lds, it - 1056, P.in[I_WIN], 1024, 7168, WIN, 0, 5120, 1024);
            else if (it < 2208) conv_job_item(lds, it - 1952, P.in[I_WG], 1024, 2048, WIN, 7168, -1, 0);
            else if (it < 2336) conv_job_item(lds, it - 2208, P.in[I_WPA], 1024, 1024, WPA, 0, -1, 0);
            else if (it < 2464) conv_job_item(lds, it - 2336, P.in[I_WPB], 1024, 1024, WPB, 0, -1, 0);
            else conv_job_item(lds, it - 2464, P.in[I_WO], 1024, 1024, WO, 0, -1, 0);
        }
    }
    GRID_SYNC();
    normmod_phase<true, true>(P.in[I_X], P.in[I_CTX], MT, P.in[I_NF1], MOD, 0, 1, U, OUT);
    GRID_SYNC();
    { pg8::Gemm g{U, WUP, MT, 2 * FF, D, D}; pg8::StaticOrder S; S.init(MT, 2 * FF, G, bid); EpiSwiglu E{H, FF}; pg8::gemm_phase<EpiSwiglu, pg8::StaticOrder, GEMM_ALIGN, GEMM_SP2>(lds, g, S, E, nullptr); }
    GRID_SYNC();
    { pg8::Gemm g{H, WDN, ML, D, FF, FF}; pg8::StaticOrder S; S.init(ML, D, G, bid); EpiResB<false> E{P.in[I_X], H1B, MOD, 2, 0.5f}; pg8::gemm_phase<EpiResB<false>, pg8::StaticOrder, GEMM_ALIGN, GEMM_SP2>(lds, g, S, E, nullptr); }
    { pg8::Gemm g{H, WDN, MT, D, 256, FF}; KSplitOrder S{G, bid}; EpiPart E{PART}; pg8::gemm_phase<EpiPart, KSplitOrder, GEMM_ALIGN, GEMM_SP2>(lds, g, S, E, nullptr); }
    GRID_SYNC();
    normmod_phase<true, true, true, false, true>((const float*)H1B, P.in[I_CTX], MT, P.in[I_NMIX], MOD, 3, 4, U, OUT, PART, 2);
    GRID_SYNC();
    { pg8::Gemm g{U, WIN, MT, 4096, D, D}; pg8::StaticOrder S; S.init(MT, 4096, G, bid); EpiMix1 E{Qb, GFb, GBb, Vb, LBF, LBB}; pg8::gemm_phase<EpiMix1, pg8::StaticOrder, GEMM_ALIGN, GEMM_SP2>(lds, g, S, E, nullptr); }
    GRID_SYNC();
    for (int item = bid; item < 256; item += G) scan_item(lds, item, Qb, GFb, GBb, Vb, OFb, OBb);
    GRID_SYNC();
    { pg8::Gemm g{U, WIN + (size_t)4096 * D, ML, 5120, D, D}; pg8::StaticOrder S; S.init(ML, 5120, G, bid); EpiMix2 E{SGb, GLUb, GATESb, P.in[I_BG]}; pg8::gemm_phase<EpiMix2, pg8::StaticOrder, GEMM_ALIGN, GEMM_SP2>(lds, g, S, E, nullptr); }
    GRID_SYNC();
    {
        conv_items(lds, bid, 2048, G, GLUb, P.in[I_WDW], P.in[I_BDW], P.in[I_LNG], P.in[I_LNB], BOP);
        aop_rows(bid * 8 + (tid >> 6), ML, G * 8, OFb, OBb, SGb, P.in[I_HGN]);
        for (int it = bid; it < 1056; it += G) {
            if (it < 704) conv_job_item(lds, it, P.in[I_W2U], 1024, 5632, WUP, 0, 0, 2816);
            else conv_job_item(lds, it - 704, P.in[I_W2D], 2816, 1024, WDN, 0, -1, 0);
        }
    }
    GRID_SYNC();
    { pg8::Gemm g{OFb, WPA, ML, D, D, D}; pg8::StaticOrder S; S.init(ML, D, G, bid); EpiGate<0> E{GATESb, Tb, 0}; pg8::gemm_phase<EpiGate<0>, pg8::StaticOrder, GEMM_ALIGN, GEMM_SP2>(lds, g, S, E, nullptr); }
    GRID_SYNC();
    { pg8::Gemm g{BOP, WPB, ML, D, D, D}; pg8::StaticOrder S; S.init(ML, D, G, bid); EpiGate<1> E{GATESb, Tb, 1024}; pg8::gemm_phase<EpiGate<1>, pg8::StaticOrder, GEMM_ALIGN, GEMM_SP2>(lds, g, S, E, nullptr); }
    GRID_SYNC();
    { pg8::Gemm g{Tb, WO, ML, D, D, D}; pg8::StaticOrder S; S.init(ML, D, G, bid); EpiResB<true> E{(const float*)H1B, H2B, MOD, 5, 1.0f}; pg8::gemm_phase<EpiResB<true>, pg8::StaticOrder, GEMM_ALIGN, GEMM_SP2>(lds, g, S, E, nullptr); }
    GRID_SYNC();
    normmod_phase<true, true, false, false, true>((const float*)H2B, HC1, ML, P.in[I_NF2], MOD, 6, 7, U, OUT);
    GRID_SYNC();
    { pg8::Gemm g{U, WUP, ML, 2 * FF, D, D}; pg8::StaticOrder S; S.init(ML, 2 * FF, G, bid); EpiSwiglu E{H, FF}; pg8::gemm_phase<EpiSwiglu, pg8::StaticOrder, GEMM_ALIGN, GEMM_SP2>(lds, g, S, E, nullptr); }
    GRID_SYNC();
    { pg8::Gemm g{H, WDN, ML, D, FF, FF}; pg8::StaticOrder S; S.init(ML, D, G, bid); EpiDelta E{DLT, MOD, 8, 0.5f}; pg8::gemm_phase<EpiDelta, pg8::StaticOrder, GEMM_ALIGN, GEMM_SP2>(lds, g, S, E, nullptr); }
    GRID_SYNC();
    normmod_phase<false, false, false, true, true>((const float*)H2B, HC1, ML, P.in[I_FN], MOD, 0, 0, U, OUT, nullptr, 0, DLT);
}

extern "C" void kernel_launch(void* const* d_in, const int* in_sizes, int n_in, void* d_out, int out_size, void* d_ws, size_t ws_size, hipStream_t stream) {
    static int grid = 0;
    if (grid == 0) {
        if (n_in != 26 || ws_size < WS_NEED) { fprintf(stderr, "kernel_launch: n_in %d ws %zu (need %zu)\n", n_in, ws_size, (size_t)WS_NEED); grid = -1; return; }
        int dev = 0, cus = 0, per_cu = 0;
        hipGetDevice(&dev); hipDeviceGetAttribute(&cus, hipDeviceAttributeMultiprocessorCount, dev);
        if (hipFuncSetAttribute((const void*)mega, hipFuncAttributeMaxDynamicSharedMemorySize, LDS_BYTES) != hipSuccess) { fprintf(stderr, "hipFuncSetAttribute failed\n"); grid = -1; return; }
        if (hipOccupancyMaxActiveBlocksPerMultiprocessor(&per_cu, (const void*)mega, 512, LDS_BYTES) != hipSuccess || per_cu < 1) { fprintf(stderr, "occupancy query: %d\n", per_cu); grid = -1; return; }
        grid = cus;
    }
    if (grid < 0) return;
    if (hipMemsetAsync((char*)d_ws + WS_BAR, 0, XCD_BAR_WORDS * sizeof(unsigned), stream) != hipSuccess) { fprintf(stderr, "memset failed\n"); return; }
    Params p{};
    for (int i = 0; i < 26; ++i) p.in[i] = (const float*)d_in[i];
    p.out = (float*)d_out; p.ws = (unsigned char*)d_ws;
    void* args[] = {&p};
    hipError_t e = hipLaunchCooperativeKernel((const void*)mega, dim3(grid), dim3(512), args, LDS_BYTES, stream);
    if (e != hipSuccess) fprintf(stderr, "cooperative launch failed: %s (grid %d)\n", hipGetErrorString(e), grid);
}
```

```cpp
#include <hip/hip_runtime.h>
#include <cstdio>
#define GEMM_ALIGN true
#define GEMM_SP2 true
namespace pg8 {
#define PG8_LAS __attribute__((address_space(3)))
typedef unsigned short bf16_t;
typedef short bf16x8 __attribute__((ext_vector_type(8)));
typedef float f32x4 __attribute__((ext_vector_type(4)));
typedef unsigned u32x4 __attribute__((ext_vector_type(4)));
constexpr int BM = 256, BK = 64, HALF = 128, HTB = HALF * BK * 2  , STAGE_BYTES = 8 * HTB, NXCD = 8, WGM = 8;

__host__ __device__ __forceinline__ int lds_byte(int r, int c) { const int st = (r >> 4) * 2 + (c >> 5), rr = r & 15, cc = c & 31, ob = rr * 64 + cc * 2; return st * 1024 + (ob ^ (((ob >> 9) & 1) << 5)); }
__host__ __device__ __forceinline__ void stage_rc(int b, int& R, int& C) { const int st = b / 1024, sb = b % 1024, swz = sb ^ (((sb >> 9) & 1) << 5); R = (st >> 1) * 16 + swz / 64; C = (st & 1) * 32 + (swz % 64) / 2; }
__host__ __device__ __forceinline__ int perm32(int rho) { const int n = rho >> 4, i = rho & 15; return 8 * (i >> 2) + 4 * n + (i & 3); }

struct Unit { int pm, pn, pk; };
struct Gemm { const bf16_t* A; const bf16_t* Bt; int M, N, K, Kp; };

struct StaticOrder {
    int nM, nN, nwg, G, c;
    __host__ __device__ void init(int M, int N, int G_, int c_) { nM = M / BM; nN = N / BM; nwg = nM * nN; G = G_; c = c_; }
    __host__ __device__ bool next(int i, Unit& u) const {
        const long L = (long)i * G + c; if (L >= nwg) return false;
        int wgid = (int)L; { const int q = nwg / NXCD, r = nwg % NXCD, xcd = wgid % NXCD, off = wgid / NXCD; wgid = (xcd < r ? xcd * (q + 1) : r * (q + 1) + (xcd - r) * q) + off; }
        const int nig = WGM * nN, gid = wgid / nig, fm = gid * WGM, gsz = (nM - fm) < WGM ? (nM - fm) : WGM;
        u.pm = fm + ((wgid % nig) % gsz); u.pn = (wgid % nig) / gsz; u.pk = 0; return true;
    }
    __device__ __forceinline__ void a_ready(const Unit&) const {}
    __device__ __forceinline__ void done(const Unit&) const {}
};
__device__ __forceinline__ unsigned cvt_pk_bf16(float lo, float hi) { unsigned r; asm volatile("v_cvt_pk_bf16_f32 %0, %1, %2" : "=v"(r) : "v"(lo), "v"(hi)); return r; }
template <class Epi, class Sched, bool ALIGN_EPI = false, bool SP2 = false, bool STAMP = false>
__device__ __forceinline__ void gemm_phase(PG8_LAS unsigned char* lds, const Gemm g, const Sched& S, const Epi& E, unsigned long long* stamps) {
    int tid_ = threadIdx.x; asm volatile("" : "+v"(tid_));
    const int tid = tid_, wid = __builtin_amdgcn_readfirstlane(tid >> 6), lane = tid & 63, wr = wid >> 2, wc = wid & 3, fr = lane & 15, fq = lane >> 4;
    const int K = g.Kp, nt = g.K / BK;
    int ts_lo = 0, ts_hi = 0, nts = 0; const unsigned long long rt_entry = STAMP ? (unsigned long long)wall_clock64() : 0ull;
#define PG8_STAMP() do { if (STAMP && wid == 0 && nts < 64) { const unsigned long long _c = (unsigned long long)clock64(); \
        ts_lo = (lane == nts) ? (int)(unsigned)_c : ts_lo; ts_hi = (lane == nts) ? (int)(unsigned)(_c >> 32) : ts_hi; ++nts; } } while (0)
    PG8_STAMP();
    unsigned voffA[2], voffB[2];
#pragma unroll
    for (int i = 0; i < 2; ++i) { int R, C; stage_rc(tid * 16 + i * 8192, R, C); const int Rb = Epi::PERM ? ((R & ~31) + perm32(R & 31)) : R;
        voffA[i] = (unsigned)(R * K + C) * 2u; voffB[i] = (unsigned)(Rb * K + C) * 2u; }
    const size_t kstep = (size_t)(BK * 2);
    const size_t hstep = (size_t)HALF * K * 2;
    const size_t tstep = 2 * hstep;
    const unsigned ldsw = (unsigned)wid * 1024u;
    const int aoff = lds_byte(wr * 64 + fr, fq * 8), boff = lds_byte(wc * 32 + fr, fq * 8);
#define PG8_SA(b, h) (((b) * 2 + (h)) * HTB)
#define PG8_SB(b, h) ((4 + (b) * 2 + (h)) * HTB)
#define PG8_STAGE(bufoff, gbase, voff) do { _Pragma("unroll") for (int _i = 0; _i < 2; ++_i) \
        __builtin_amdgcn_global_load_lds((const unsigned*)((const char*)(gbase) + (voff)[_i]), (PG8_LAS unsigned*)(lds + (bufoff) + ldsw + _i * 8192), 16, 0, 0); } while (0)
#define PG8_LDA(dst, b, h) do { _Pragma("unroll") for (int m = 0; m < 4; ++m) _Pragma("unroll") for (int k = 0; k < 2; ++k) dst[m][k] = *(const PG8_LAS bf16x8*)(lds + PG8_SA(b, h) + aoff + m * 2048 + k * 1024); } while (0)
#define PG8_LDB(dst, b, h) do { _Pragma("unroll") for (int n = 0; n < 2; ++n) _Pragma("unroll") for (int k = 0; k < 2; ++k) dst[n][k] = *(const PG8_LAS bf16x8*)(lds + PG8_SB(b, h) + boff + n * 2048 + k * 1024); } while (0)
#define PG8_MMA(ai, bj, At, Bt) do { __builtin_amdgcn_s_setprio(1); _Pragma("unroll") for (int m = 0; m < 4; ++m) _Pragma("unroll") for (int n = 0; n < 2; ++n) _Pragma("unroll") for (int k = 0; k < 2; ++k) \
        acc[ai][bj][m][n] = __builtin_amdgcn_mfma_f32_16x16x32_bf16(Bt[n][k], At[m][k], acc[ai][bj][m][n], 0, 0, 0); __builtin_amdgcn_s_setprio(0); } while (0)
#define PG8_WAIT_V(n) asm volatile("s_waitcnt vmcnt(" #n ")" ::: "memory")
#define PG8_WAIT_L(n) asm volatile("s_waitcnt lgkmcnt(" #n ")" ::: "memory")
#define PG8_BAR __builtin_amdgcn_s_barrier()
#define PG8_SCHED __builtin_amdgcn_sched_barrier(0)
    Unit cur, nxt; int ui = 0;
    if (!S.next(0, cur)) return;
    f32x4 acc[2][2][4][2];
#pragma unroll
    for (int a = 0; a < 2; ++a)
#pragma unroll
        for (int b = 0; b < 2; ++b)
#pragma unroll
            for (int m = 0; m < 4; ++m)
#pragma unroll
                for (int n = 0; n < 2; ++n) acc[a][b][m][n] = (f32x4){0.f, 0.f, 0.f, 0.f};
    bf16x8 At[4][2], B0[2][2], B1[2][2];
    const size_t pstep = (size_t)g.K * 2;
    const char* cA = (const char*)g.A + (size_t)cur.pm * tstep + (size_t)cur.pk * pstep; const char* cB = (const char*)g.Bt + (size_t)cur.pn * tstep + (size_t)cur.pk * pstep;
    S.a_ready(cur);
    if constexpr (SP2) {
        PG8_STAGE(PG8_SB(0, 0), cB, voffB); PG8_STAGE(PG8_SB(0, 1), cB + hstep, voffB); PG8_STAGE(PG8_SA(0, 0), cA, voffA); PG8_STAGE(PG8_SA(0, 1), cA + hstep, voffA);
        if (wr == 1) PG8_BAR;
        PG8_WAIT_V(2); PG8_BAR;
    } else {
        PG8_STAGE(PG8_SB(0, 0), cB, voffB); PG8_STAGE(PG8_SA(0, 0), cA, voffA); PG8_STAGE(PG8_SB(0, 1), cB + hstep, voffB); PG8_STAGE(PG8_SA(0, 1), cA + hstep, voffA);
        if (wr == 1) PG8_BAR;
        PG8_WAIT_V(4); PG8_BAR;
    }
    PG8_STAGE(PG8_SB(1, 0), cB + kstep, voffB); PG8_STAGE(PG8_SA(1, 0), cA + kstep, voffA); PG8_STAGE(PG8_SB(1, 1), cB + hstep + kstep, voffB);
    PG8_WAIT_V(6); PG8_BAR;
    PG8_STAMP();
    for (;;) {
        const bool has_next = S.next(ui + 1, nxt);
        const char* nA = has_next ? (const char*)g.A + (size_t)nxt.pm * tstep + (size_t)nxt.pk * pstep : cA; const char* nB = has_next ? (const char*)g.Bt + (size_t)nxt.pn * tstep + (size_t)nxt.pk * pstep : cB;
        for (int t = 0; t < nt; t += 2) {
            const bool last = (t == nt - 2);
            const char* a1 = cA + (size_t)(t + 1) * kstep;
            const char* a2 = last ? nA : cA + (size_t)(t + 2) * kstep; const char* b2 = last ? nB : cB + (size_t)(t + 2) * kstep;
            const char* a3 = a2 + kstep; const char* b3 = b2 + kstep;
            if (last && has_next) S.a_ready(nxt);
            if constexpr (SP2) {
            PG8_LDB(B0, 0, 0); PG8_LDB(B1, 0, 1); PG8_SCHED; PG8_LDA(At, 0, 0); PG8_STAGE(PG8_SA(1, 1), a1 + hstep, voffA);
            PG8_WAIT_V(8); PG8_WAIT_L(0); PG8_BAR; PG8_MMA(0, 0, At, B0); PG8_MMA(0, 1, At, B1); PG8_BAR; PG8_SCHED;
            PG8_LDA(At, 0, 1); PG8_STAGE(PG8_SB(0, 0), b2, voffB); PG8_STAGE(PG8_SB(0, 1), b2 + hstep, voffB); PG8_STAGE(PG8_SA(0, 0), a2, voffA);
            PG8_WAIT_V(8); PG8_WAIT_L(0); PG8_BAR; PG8_MMA(1, 0, At, B0); PG8_MMA(1, 1, At, B1); PG8_BAR; PG8_SCHED;
            PG8_LDB(B0, 1, 0); PG8_LDB(B1, 1, 1); PG8_SCHED; PG8_LDA(At, 1, 0); PG8_STAGE(PG8_SA(0, 1), a2 + hstep, voffA);
            PG8_WAIT_V(8); PG8_WAIT_L(0); PG8_BAR; PG8_MMA(0, 0, At, B0); PG8_MMA(0, 1, At, B1); PG8_BAR; PG8_SCHED;
            PG8_LDA(At, 1, 1); PG8_STAGE(PG8_SB(1, 0), b3, voffB); PG8_STAGE(PG8_SB(1, 1), b3 + hstep, voffB); PG8_STAGE(PG8_SA(1, 0), a3, voffA);
            PG8_WAIT_V(8); PG8_WAIT_L(0); PG8_BAR; PG8_MMA(1, 0, At, B0); PG8_MMA(1, 1, At, B1); PG8_BAR; PG8_SCHED;
            } else {
            PG8_LDB(B0, 0, 0); PG8_SCHED; PG8_LDA(At, 0, 0); PG8_STAGE(PG8_SA(1, 1), a1 + hstep, voffA);
            PG8_WAIT_L(8); PG8_BAR; PG8_WAIT_L(0); PG8_MMA(0, 0, At, B0); PG8_BAR; PG8_SCHED;
            PG8_LDB(B1, 0, 1); PG8_STAGE(PG8_SB(0, 0), b2, voffB);
            PG8_BAR; PG8_WAIT_L(0); PG8_MMA(0, 1, At, B1); PG8_BAR;
            PG8_LDA(At, 0, 1); PG8_STAGE(PG8_SA(0, 0), a2, voffA);
            PG8_BAR; PG8_WAIT_L(0); PG8_MMA(1, 0, At, B0); PG8_BAR; PG8_SCHED;
            PG8_STAGE(PG8_SB(0, 1), b2 + hstep, voffB);
            PG8_WAIT_V(6); PG8_BAR; PG8_MMA(1, 1, At, B1); PG8_BAR;
            PG8_LDB(B0, 1, 0); PG8_SCHED; PG8_LDA(At, 1, 0); PG8_STAGE(PG8_SA(0, 1), a2 + hstep, voffA);
            PG8_WAIT_L(8); PG8_BAR; PG8_WAIT_L(0); PG8_MMA(0, 0, At, B0); PG8_BAR; PG8_SCHED;
            PG8_LDB(B1, 1, 1); PG8_STAGE(PG8_SB(1, 0), b3, voffB);
            PG8_BAR; PG8_WAIT_L(0); PG8_MMA(0, 1, At, B1); PG8_BAR;
            PG8_LDA(At, 1, 1); PG8_STAGE(PG8_SA(1, 0), a3, voffA);
            PG8_BAR; PG8_WAIT_L(0); PG8_MMA(1, 0, At, B0); PG8_BAR; PG8_SCHED;
            PG8_STAGE(PG8_SB(1, 1), b3 + hstep, voffB);
            PG8_WAIT_V(6); PG8_BAR; PG8_MMA(1, 1, At, B1); PG8_BAR;
            }
        }
        PG8_STAMP();
        if constexpr (ALIGN_EPI) { if (wr == 0) PG8_BAR; }
        if constexpr (!Epi::AFTER_DRAIN) { E(acc, cur, wr, wc, fr, fq); S.done(cur); }
        PG8_STAMP();
        if (!has_next) break;
#pragma unroll
        for (int a = 0; a < 2; ++a)
#pragma unroll
            for (int b = 0; b < 2; ++b)
#pragma unroll
                for (int m = 0; m < 4; ++m)
#pragma unroll
                    for (int n = 0; n < 2; ++n) acc[a][b][m][n] = (f32x4){0.f, 0.f, 0.f, 0.f};
        cur = nxt; cA = nA; cB = nB; ++ui;
        if constexpr (ALIGN_EPI) { if (wr == 1) PG8_BAR; }
    }
    PG8_WAIT_V(0);
    if constexpr (!ALIGN_EPI) { if (wr == 0) PG8_BAR; }
    PG8_BAR;
    if constexpr (Epi::AFTER_DRAIN) { E.fused(acc, cur, wr, wc, fr, fq, lds, wid, lane); S.done(cur); }
    PG8_STAMP();
    if (STAMP && wid == 0) { stamps[lane] = lane < nts ? (((unsigned long long)(unsigned)ts_hi << 32) | (unsigned)ts_lo) : 0ull;
        if (lane == 62) stamps[62] = rt_entry; if (lane == 63) stamps[63] = (unsigned long long)wall_clock64(); }
#undef PG8_STAMP
#undef PG8_SA
#undef PG8_SB
#undef PG8_STAGE
#undef PG8_LDA
#undef PG8_LDB
#undef PG8_MMA
#undef PG8_WAIT_V
#undef PG8_WAIT_L
#undef PG8_BAR
#undef PG8_SCHED
}
}

#define LAS __attribute__((address_space(3)))
typedef unsigned short bf16;
typedef _Float16 f16;
typedef pg8::f32x4 f32x4;
typedef pg8::u32x4 u32x4;
typedef pg8::bf16x8 bf16x8;
typedef unsigned u32x2 __attribute__((ext_vector_type(2)));
typedef _Float16 f16x8 __attribute__((ext_vector_type(8)));
typedef _Float16 f16x4 __attribute__((ext_vector_type(4)));

constexpr int D = 1024, NB = 8, SEQ = 4096, CTXL = 256, ML = NB * SEQ, MC = NB * CTXL, MT = ML + MC, FF = 2816, NMODC = 9 * D;
constexpr float EPS = 1e-6f;
constexpr size_t MiB = 1ull << 20;
constexpr size_t WS_WUP = 0, WS_WDN = 11 * MiB, WS_WIN = 17 * MiB, WS_WPA = 35 * MiB, WS_WPB = 37 * MiB, WS_WO = 39 * MiB, WS_MOD = 41 * MiB,
                 WS_U = 42 * MiB, WS_R = 110 * MiB, WS_BAR = 41 * MiB + 512 * 1024;
constexpr size_t R_H = WS_R, R_HC1 = WS_R + 187 * MiB;
constexpr size_t R_Q = WS_R, R_GF = WS_R + 64 * MiB, R_GB = WS_R + 132 * MiB, R_V = WS_R + 200 * MiB, R_OF = WS_R + 268 * MiB, R_OB = WS_R + 332 * MiB;
constexpr size_t R_SG = WS_R, R_GLU = WS_R + 64 * MiB, R_GATES = WS_R + 128 * MiB;
constexpr size_t WS_NEED = WS_R + 396 * MiB;
constexpr int LDS_BYTES = 131072 + 4096;

struct Params { const float* in[26]; float* out; unsigned char* ws; };
enum { I_X = 0, I_C, I_CTX, I_CCTX, I_WADA, I_BADA, I_NF1, I_W1U, I_W1D, I_NMIX, I_WIN, I_LBL, I_HGN, I_WDW, I_BDW, I_LNG, I_LNB, I_WPA, I_WPB, I_WG, I_BG, I_WO,
       I_NF2, I_W2U, I_W2D, I_FN };

__device__ __forceinline__ int tid_opaque() { int t = threadIdx.x; asm volatile("" : "+v"(t)); return t; }
__device__ __forceinline__ float bf2f(unsigned short b) { return __uint_as_float(((unsigned)b) << 16); }
__device__ __forceinline__ float bflo(unsigned w) { return __uint_as_float(w << 16); }
__device__ __forceinline__ float bfhi(unsigned w) { return __uint_as_float(w & 0xffff0000u); }
typedef __bf16 bf2_t __attribute__((ext_vector_type(2)));
__device__ __forceinline__ unsigned pk2(float lo, float hi) { bf2_t v; v.x = (__bf16)lo; v.y = (__bf16)hi; return __builtin_bit_cast(unsigned, v); }
__device__ __forceinline__ float sigmoidf_(float x) { return __builtin_amdgcn_rcpf(1.0f + __expf(-x)); }
__device__ __forceinline__ float siluf_(float x) { return x * __builtin_amdgcn_rcpf(1.0f + __expf(-x)); }
typedef float f32x2 __attribute__((ext_vector_type(2)));
__device__ __forceinline__ f32x2 sig2_(f32x2 x) { const f32x2 t = x * (-1.44269504f); f32x2 e; e.x = __builtin_amdgcn_exp2f(t.x); e.y = __builtin_amdgcn_exp2f(t.y); const f32x2 d = e + 1.0f; f32x2 r; r.x = __builtin_amdgcn_rcpf(d.x); r.y = __builtin_amdgcn_rcpf(d.y); return r; }
__device__ __forceinline__ f32x4 sig4_(f32x4 x) { const f32x2 lo = sig2_(__builtin_shufflevector(x, x, 0, 1)), hi = sig2_(__builtin_shufflevector(x, x, 2, 3)); return (f32x4){lo.x, lo.y, hi.x, hi.y}; }
__device__ __forceinline__ f32x4 silu4_(f32x4 x) { return x * sig4_(x); }
__device__ __forceinline__ u32x2 pk4(f32x4 v) { u32x2 w; w.x = pk2(v[0], v[1]); w.y = pk2(v[2], v[3]); return w; }

struct EpiSwiglu {
    static constexpr bool PERM = true, AFTER_DRAIN = false;
    bf16* H; int ldh;
    __device__ __forceinline__ void operator()(const f32x4 (&acc)[2][2][4][2], const pg8::Unit& u, int wr, int wc, int fr, int fq) const {
        const int row0 = u.pm * 256 + wr * 64 + fr, col0 = u.pn * 128 + wc * 32 + 8 * fq;
#pragma unroll
        for (int ai = 0; ai < 2; ++ai)
#pragma unroll
            for (int m = 0; m < 4; ++m) {
                bf16* rowp = H + (size_t)(row0 + ai * 128 + m * 16) * ldh + col0;
                const u32x2 w0 = pk4(silu4_(acc[ai][0][m][0]) * acc[ai][1][m][0]), w1 = pk4(silu4_(acc[ai][0][m][1]) * acc[ai][1][m][1]);
                *(u32x4*)rowp = (u32x4){w0.x, w0.y, w1.x, w1.y};
            }
    }
};

struct EpiRes {
    static constexpr bool PERM = false, AFTER_DRAIN = false;
    const float* baseL; float* outL; const float* baseC; float* outC; const float* mod; int gidx; float coef;
    __device__ __forceinline__ void operator()(const f32x4 (&acc)[2][2][4][2], const pg8::Unit& u, int wr, int wc, int fr, int fq) const {
        const bool lat = u.pm < 128;
        const int prow = (lat ? u.pm : u.pm - 128) * 256 + wr * 64 + fr;
        const float* base = lat ? baseL : baseC; float* out = lat ? outL : outC;
        const float* gate = mod + (size_t)(lat ? (u.pm >> 4) : 8) * NMODC + gidx * D;
        const int col0 = u.pn * 256 + wc * 32 + 4 * fq;
        f32x4 gv[2][2];
#pragma unroll
        for (int bj = 0; bj < 2; ++bj)
#pragma unroll
            for (int n = 0; n < 2; ++n) gv[bj][n] = *(const f32x4*)(gate + col0 + bj * 128 + n * 16) * coef;
#pragma unroll
        for (int ai = 0; ai < 2; ++ai)
#pragma unroll
            for (int m = 0; m < 4; ++m) {
                const size_t off = (size_t)(prow + ai * 128 + m * 16) * D + col0;
#pragma unroll
                for (int bj = 0; bj < 2; ++bj)
#pragma unroll
                    for (int n = 0; n < 2; ++n) {
                        const f32x4 bs = *(const f32x4*)(base + off + bj * 128 + n * 16);
                        *(f32x4*)(out + off + bj * 128 + n * 16) = bs + gv[bj][n] * acc[ai][bj][m][n];
                    }
            }
    }
};


template <bool BASEB> struct EpiResB {
    static constexpr bool PERM = false, AFTER_DRAIN = false;
    const float* base; bf16* outb; const float* mod; int gidx; float coef;
    __device__ __forceinline__ void operator()(const f32x4 (&acc)[2][2][4][2], const pg8::Unit& u, int wr, int wc, int fr, int fq) const {
        const int prow = u.pm * 256 + wr * 64 + fr;
        const float* gate = mod + (size_t)(u.pm >> 4) * NMODC + gidx * D;
        const int col0 = u.pn * 256 + wc * 32 + 4 * fq;
        f32x4 gv[2][2];
#pragma unroll
        for (int bj = 0; bj < 2; ++bj)
#pragma unroll
            for (int n = 0; n < 2; ++n) gv[bj][n] = *(const f32x4*)(gate + col0 + bj * 128 + n * 16) * coef;
#pragma unroll
        for (int ai = 0; ai < 2; ++ai)
#pragma unroll
            for (int m = 0; m < 4; ++m) {
                const size_t off = (size_t)(prow + ai * 128 + m * 16) * D + col0;
#pragma unroll
                for (int bj = 0; bj < 2; ++bj)
#pragma unroll
                    for (int n = 0; n < 2; ++n) {
                        f32x4 bs;
                        if constexpr (BASEB) { const u32x2 t = *(const u32x2*)((const bf16*)base + off + bj * 128 + n * 16); bs = (f32x4){bflo(t.x), bfhi(t.x), bflo(t.y), bfhi(t.y)}; }
                        else bs = *(const f32x4*)(base + off + bj * 128 + n * 16);
                        *(u32x2*)(outb + off + bj * 128 + n * 16) = pk4(bs + gv[bj][n] * acc[ai][bj][m][n]);
                    }
            }
    }
};

struct EpiDelta {
    static constexpr bool PERM = true, AFTER_DRAIN = false;
    bf16* delta; const float* mod; int gidx; float coef;
    __device__ __forceinline__ void operator()(const f32x4 (&acc)[2][2][4][2], const pg8::Unit& u, int wr, int wc, int fr, int fq) const {
        const int row0 = u.pm * 256 + wr * 64 + fr, col0 = u.pn * 256 + wc * 32 + 8 * fq;
        const float* gate = mod + (size_t)(u.pm >> 4) * NMODC + gidx * D;
#pragma unroll
        for (int bj = 0; bj < 2; ++bj) {
            const f32x4 g0 = *(const f32x4*)(gate + col0 + bj * 128) * coef, g1 = *(const f32x4*)(gate + col0 + bj * 128 + 4) * coef;
#pragma unroll
            for (int ai = 0; ai < 2; ++ai)
#pragma unroll
                for (int m = 0; m < 4; ++m) {
                    const u32x2 w0 = pk4(acc[ai][bj][m][0] * g0), w1 = pk4(acc[ai][bj][m][1] * g1);
                    *(u32x4*)(delta + (size_t)(row0 + ai * 128 + m * 16) * D + col0 + bj * 128) = (u32x4){w0.x, w0.y, w1.x, w1.y};
                }
        }
    }
};

struct EpiMix1 {
    static constexpr bool PERM = true, AFTER_DRAIN = false;
    bf16* Q; f16* GF; f16* GB; bf16* V; const float* lbf; const float* lbb;
    __device__ __forceinline__ void operator()(const f32x4 (&acc)[2][2][4][2], const pg8::Unit& u, int wr, int wc, int fr, int fq) const {
        const int seg = u.pn >> 2;
        const int row0 = u.pm * 256 + wr * 64 + fr, col0 = (u.pn & 3) * 256 + wc * 32 + 8 * fq;
        if (seg == 0) {
            if (u.pm >= 128) return;
#pragma unroll
            for (int ai = 0; ai < 2; ++ai)
#pragma unroll
                for (int m = 0; m < 4; ++m)
#pragma unroll
                    for (int bj = 0; bj < 2; ++bj) {
                        const f32x4 a = acc[ai][bj][m][0], b = acc[ai][bj][m][1];
                        const u32x2 w0 = pk4(silu4_(a)), w1 = pk4(silu4_(b)); const u32x4 w = (u32x4){w0.x, w0.y, w1.x, w1.y};
                        *(u32x4*)(Q + (size_t)(row0 + ai * 128 + m * 16) * D + col0 + bj * 128) = w;
                    }
        } else if (seg == 3) {
#pragma unroll
            for (int ai = 0; ai < 2; ++ai)
#pragma unroll
                for (int m = 0; m < 4; ++m)
#pragma unroll
                    for (int bj = 0; bj < 2; ++bj) {
                        const f32x4 a = acc[ai][bj][m][0], b = acc[ai][bj][m][1];
                        u32x4 w; w.x = pk2(a[0], a[1]); w.y = pk2(a[2], a[3]); w.z = pk2(b[0], b[1]); w.w = pk2(b[2], b[3]);
                        *(u32x4*)(V + (size_t)(row0 + ai * 128 + m * 16) * D + col0 + bj * 128) = w;
                    }
        } else {
            const float* lb = (seg == 1) ? lbf : lbb; f16* G = (seg == 1) ? GF : GB;
#pragma unroll
            for (int bj = 0; bj < 2; ++bj) {
                const f32x4 l0 = *(const f32x4*)(lb + col0 + bj * 128), l1 = *(const f32x4*)(lb + col0 + bj * 128 + 4);
#pragma unroll
                for (int ai = 0; ai < 2; ++ai)
#pragma unroll
                    for (int m = 0; m < 4; ++m) {
                        const f32x4 a = acc[ai][bj][m][0], b = acc[ai][bj][m][1];
                        f16x8 w;
                        const f32x4 fa = l0 + (1.0f - l0) * sig4_(a), fb = l1 + (1.0f - l1) * sig4_(b);
#pragma unroll
                        for (int j = 0; j < 4; ++j) { w[j] = (f16)__builtin_amdgcn_logf(fa[j]); w[4 + j] = (f16)__builtin_amdgcn_logf(fb[j]); }
                        *(f16x8*)(G + (size_t)(row0 + ai * 128 + m * 16) * D + col0 + bj * 128) = w;
                    }
            }
        }
    }
};

struct EpiMix2 {
    static constexpr bool PERM = true, AFTER_DRAIN = false;
    bf16* SG; bf16* GLU; bf16* GATES; const float* bgate;
    __device__ __forceinline__ void operator()(const f32x4 (&acc)[2][2][4][2], const pg8::Unit& u, int wr, int wc, int fr, int fq) const {
        const int row0 = u.pm * 256 + wr * 64 + fr, cw = wc * 32 + 8 * fq;
        if (u.pn < 4) {
#pragma unroll
            for (int ai = 0; ai < 2; ++ai)
#pragma unroll
                for (int m = 0; m < 4; ++m)
#pragma unroll
                    for (int bj = 0; bj < 2; ++bj) {
                        const f32x4 a = acc[ai][bj][m][0], b = acc[ai][bj][m][1];
                        const u32x2 w0 = pk4(silu4_(a)), w1 = pk4(silu4_(b)); const u32x4 w = (u32x4){w0.x, w0.y, w1.x, w1.y};
                        *(u32x4*)(SG + (size_t)(row0 + ai * 128 + m * 16) * D + u.pn * 256 + bj * 128 + cw) = w;
                    }
        } else if (u.pn < 12) {
            const int c0 = (u.pn - 4) * 128 + cw;
#pragma unroll
            for (int ai = 0; ai < 2; ++ai)
#pragma unroll
                for (int m = 0; m < 4; ++m) {
                    const u32x2 w0 = pk4(acc[ai][0][m][0] * sig4_(acc[ai][1][m][0])), w1 = pk4(acc[ai][0][m][1] * sig4_(acc[ai][1][m][1])); const u32x4 w = (u32x4){w0.x, w0.y, w1.x, w1.y};
                    *(u32x4*)(GLU + (size_t)(row0 + ai * 128 + m * 16) * D + c0) = w;
                }
        } else {
            const int c0 = (u.pn - 12) * 256 + cw;
#pragma unroll
            for (int bj = 0; bj < 2; ++bj) {
                const f32x4 b0 = *(const f32x4*)(bgate + c0 + bj * 128), b1 = *(const f32x4*)(bgate + c0 + bj * 128 + 4);
#pragma unroll
                for (int ai = 0; ai < 2; ++ai)
#pragma unroll
                    for (int m = 0; m < 4; ++m) {
                        const f32x4 a = acc[ai][bj][m][0] + b0, b = acc[ai][bj][m][1] + b1;
                        const u32x2 w0 = pk4(sig4_(a)), w1 = pk4(sig4_(b)); const u32x4 w = (u32x4){w0.x, w0.y, w1.x, w1.y};
                        *(u32x4*)(GATES + (size_t)(row0 + ai * 128 + m * 16) * 2048 + c0 + bj * 128) = w;
                    }
            }
        }
    }
};

template <int ADD> struct EpiGate {
    static constexpr bool PERM = true, AFTER_DRAIN = false;
    const bf16* GATES; bf16* T; int goff;
    __device__ __forceinline__ void operator()(const f32x4 (&acc)[2][2][4][2], const pg8::Unit& u, int wr, int wc, int fr, int fq) const {
        const int row0 = u.pm * 256 + wr * 64 + fr, col0 = u.pn * 256 + wc * 32 + 8 * fq;
#pragma unroll
        for (int ai = 0; ai < 2; ++ai)
#pragma unroll
            for (int m = 0; m < 4; ++m)
#pragma unroll
                for (int bj = 0; bj < 2; ++bj) {
                    const size_t r = (size_t)(row0 + ai * 128 + m * 16);
                    const u32x4 g = *(const u32x4*)(GATES + r * 2048 + goff + col0 + bj * 128);
                    bf16* tp = T + r * D + col0 + bj * 128;
                    const f32x4 a = acc[ai][bj][m][0], b = acc[ai][bj][m][1];
                    float o[8];
                    o[0] = bflo(g.x) * a[0]; o[1] = bfhi(g.x) * a[1]; o[2] = bflo(g.y) * a[2]; o[3] = bfhi(g.y) * a[3];
                    o[4] = bflo(g.z) * b[0]; o[5] = bfhi(g.z) * b[1]; o[6] = bflo(g.w) * b[2]; o[7] = bfhi(g.w) * b[3];
                    if (ADD) { const u32x4 t = *(const u32x4*)tp;
                        o[0] += bflo(t.x); o[1] += bfhi(t.x); o[2] += bflo(t.y); o[3] += bfhi(t.y); o[4] += bflo(t.z); o[5] += bfhi(t.z); o[6] += bflo(t.w); o[7] += bfhi(t.w); }
                    u32x4 w; w.x = pk2(o[0], o[1]); w.y = pk2(o[2], o[3]); w.z = pk2(o[4], o[5]); w.w = pk2(o[6], o[7]);
                    *(u32x4*)tp = w;
                }
    }
};


struct KSplitOrder {
    int G, c;
    __device__ bool next(int i, pg8::Unit& u) const { const int L = i * G + c; if (L >= 352) return false; u.pk = L >> 5; u.pm = 128 + ((L & 31) >> 2); u.pn = L & 3; return true; }
    __device__ __forceinline__ void a_ready(const pg8::Unit&) const {}
    __device__ __forceinline__ void done(const pg8::Unit&) const {}
};
struct EpiPart {
    static constexpr bool PERM = false, AFTER_DRAIN = false;
    bf16* part;
    __device__ __forceinline__ void operator()(const f32x4 (&acc)[2][2][4][2], const pg8::Unit& u, int wr, int wc, int fr, int fq) const {
        const int prow = (u.pm - 128) * 256 + wr * 64 + fr, col0 = u.pn * 256 + wc * 32 + 4 * fq;
        bf16* base = part + ((size_t)u.pk * MC + prow) * D + col0;
#pragma unroll
        for (int ai = 0; ai < 2; ++ai)
#pragma unroll
            for (int m = 0; m < 4; ++m)
#pragma unroll
                for (int bj = 0; bj < 2; ++bj)
#pragma unroll
                    for (int n = 0; n < 2; ++n) *(u32x2*)(base + (size_t)(ai * 128 + m * 16) * D + bj * 128 + n * 16) = pk4(acc[ai][bj][m][n]);
    }
};

__device__ __forceinline__ void conv_tile(LAS unsigned char* lds, const float* src, int srcN, int k0, int n0, bf16* dst, int dstK, int drow0) {
    LAS float* T = (LAS float*)lds;
    const int tid = tid_opaque();
#pragma unroll
    for (int i = 0; i < 4; ++i) {
        const int kk = (tid >> 5) + 16 * i, n4 = tid & 31;
        const f32x4 v = *(const f32x4*)(src + (size_t)(k0 + kk) * srcN + n0 + 4 * n4);
#pragma unroll
        for (int j = 0; j < 4; ++j) T[kk * 129 + 4 * n4 + j] = v[j];
    }
    __syncthreads();
    {
        const int nn = tid >> 2, kq = tid & 3;
        float f[16];
#pragma unroll
        for (int j = 0; j < 16; ++j) f[j] = T[(16 * kq + j) * 129 + nn];
        u32x4 w0, w1;
        w0.x = pk2(f[0], f[1]); w0.y = pk2(f[2], f[3]); w0.z = pk2(f[4], f[5]); w0.w = pk2(f[6], f[7]);
        w1.x = pk2(f[8], f[9]); w1.y = pk2(f[10], f[11]); w1.z = pk2(f[12], f[13]); w1.w = pk2(f[14], f[15]);
        bf16* dp = dst + (size_t)(drow0 + nn) * dstK + k0 + 16 * kq;
        *(u32x4*)dp = w0; *(u32x4*)(dp + 8) = w1;
    }
    __syncthreads();
}
__device__ __forceinline__ void conv_job_item(LAS unsigned char* lds, int it, const float* src, int K, int N, bf16* dst, int roff, int pair_from, int NH) {
    const int nt = N / 128; const int kt = it / nt, ntile = it % nt; const int n0 = ntile * 128;
    int drow0;
    if (pair_from < 0 || n0 < pair_from) drow0 = roff + n0;
    else { const int n1 = n0 - pair_from; drow0 = roff + pair_from + ((n1 < NH) ? 256 * (n1 / 128) : 256 * ((n1 - NH) / 128) + 128); }
    conv_tile(lds, src, N, kt * 64, n0, dst, K, drow0);
}

template <bool MODU, bool OUT_BF16, bool CPART = false, bool ADDD = false, bool SRCB = false>
__device__ __forceinline__ void normmod_phase(const float* srcL, const float* srcC, int nrows, const float* gain, const float* mod, int ishift, int iscale, bf16* ub, float* of, const bf16* part = nullptr, int igate = 0, const bf16* dlt = nullptr) {
    const int tido = tid_opaque(); const int lane = tido & 63, wv = tido >> 6;
    f32x4 gn[4];
#pragma unroll
    for (int j = 0; j < 4; ++j) gn[j] = *(const f32x4*)(gain + 256 * j + 4 * lane);
    for (int row = blockIdx.x * 8 + wv; row < nrows; row += gridDim.x * 8) {
        const float* src = (row < ML) ? srcL + (size_t)row * D : srcC + (size_t)(row - ML) * D;
        f32x4 x[4]; float ss = 0.f;
#pragma unroll
        for (int j = 0; j < 4; ++j) {
            if (SRCB && row < ML) { const u32x2 t = *(const u32x2*)((const bf16*)srcL + (size_t)row * D + 256 * j + 4 * lane); x[j] = (f32x4){bflo(t.x), bfhi(t.x), bflo(t.y), bfhi(t.y)}; }
            else x[j] = *(const f32x4*)(src + 256 * j + 4 * lane);
            if constexpr (ADDD) { const u32x2 t = *(const u32x2*)(dlt + (size_t)row * D + 256 * j + 4 * lane); x[j] += (f32x4){bflo(t.x), bfhi(t.x), bflo(t.y), bfhi(t.y)}; }
            if constexpr (CPART) { if (row >= ML) {
                f32x4 sp = (f32x4){0.f, 0.f, 0.f, 0.f};
#pragma unroll
                for (int pk = 0; pk < 11; ++pk) { const u32x2 t = *(const u32x2*)(part + ((size_t)pk * MC + (row - ML)) * D + 256 * j + 4 * lane); sp += (f32x4){bflo(t.x), bfhi(t.x), bflo(t.y), bfhi(t.y)}; }
                x[j] += sp * (*(const f32x4*)(mod + (size_t)8 * NMODC + igate * D + 256 * j + 4 * lane) * 0.5f); } }
            ss += x[j][0] * x[j][0] + x[j][1] * x[j][1] + x[j][2] * x[j][2] + x[j][3] * x[j][3]; }
#pragma unroll
        for (int o = 32; o >= 1; o >>= 1) ss += __shfl_xor(ss, o);
        const float rinv = rsqrtf(ss * (1.0f / D) + EPS);
        const int mrow = (row < ML) ? (row >> 12) : 8;
#pragma unroll
        for (int j = 0; j < 4; ++j) {
            f32x4 y = x[j] * rinv * gn[j];
            if constexpr (MODU) { const f32x4 sh = *(const f32x4*)(mod + (size_t)mrow * NMODC + ishift * D + 256 * j + 4 * lane), sc = *(const f32x4*)(mod + (size_t)mrow * NMODC + iscale * D + 256 * j + 4 * lane);
                y = y * (sc + 1.0f) + sh; }
            if constexpr (OUT_BF16) { u32x2 w; w.x = pk2(y[0], y[1]); w.y = pk2(y[2], y[3]); *(u32x2*)(ub + (size_t)row * D + 256 * j + 4 * lane) = w; }
            else *(f32x4*)(of + (size_t)row * D + 256 * j + 4 * lane) = y;
        }
    }
}

__device__ __forceinline__ void adaln_item(LAS unsigned char* lds, int item, const float* wada, const float* bada, float* MOD) {
    LAS float* SC = (LAS float*)lds;
    LAS float* RED = (LAS float*)(lds + 36864);
    const int tid = threadIdx.x, col = tid & 63, kg = tid >> 6, n0 = item * 64;
    float acc[9];
#pragma unroll
    for (int r = 0; r < 9; ++r) acc[r] = 0.f;
    for (int k = kg * 128; k < kg * 128 + 128; ++k) {
        const float w = wada[(size_t)k * NMODC + n0 + col];
#pragma unroll
        for (int r = 0; r < 9; ++r) acc[r] += SC[r * 1024 + k] * w;
    }
#pragma unroll
    for (int r = 0; r < 9; ++r) RED[(kg * 9 + r) * 64 + col] = acc[r];
    __syncthreads();
    for (int idx = tid; idx < 576; idx += 512) {
        const int r = idx >> 6, c = idx & 63; float s = bada[n0 + c];
#pragma unroll
        for (int g = 0; g < 8; ++g) s += RED[(g * 9 + r) * 64 + c];
        MOD[(size_t)r * NMODC + n0 + c] = s;
    }
    __syncthreads();
}

__device__ __forceinline__ void aop_rows(int row_begin, int row_end, int row_step, bf16* OF, const bf16* OB, const bf16* SG, const float* hgn) {
    const int lane = tid_opaque() & 63;
    float gn[16];
#pragma unroll
    for (int j = 0; j < 4; ++j) { const f32x4 t = *(const f32x4*)(hgn + (lane & 7) * 16 + 4 * j); gn[4 * j] = t[0]; gn[4 * j + 1] = t[1]; gn[4 * j + 2] = t[2]; gn[4 * j + 3] = t[3]; }
    for (int row = row_begin; row < row_end; row += row_step) {
        const size_t off = (size_t)row * D + 16 * lane;
        const u32x4 f0 = *(const u32x4*)(OF + off), f1 = *(const u32x4*)(OF + off + 8);
        const u32x4 b0 = *(const u32x4*)(OB + off), b1 = *(const u32x4*)(OB + off + 8);
        const u32x4 s0 = *(const u32x4*)(SG + off), s1 = *(const u32x4*)(SG + off + 8);
        float o[16], sg[16];
#pragma unroll
        for (int j = 0; j < 4; ++j) {
            o[2 * j] = bflo(f0[j]) + bflo(b0[j]); o[2 * j + 1] = bfhi(f0[j]) + bfhi(b0[j]);
            o[8 + 2 * j] = bflo(f1[j]) + bflo(b1[j]); o[8 + 2 * j + 1] = bfhi(f1[j]) + bfhi(b1[j]);
            sg[2 * j] = bflo(s0[j]); sg[2 * j + 1] = bfhi(s0[j]); sg[8 + 2 * j] = bflo(s1[j]); sg[8 + 2 * j + 1] = bfhi(s1[j]);
        }
        float ss = 0.f;
#pragma unroll
        for (int j = 0; j < 16; ++j) ss += o[j] * o[j];
        ss += __shfl_xor(ss, 1); ss += __shfl_xor(ss, 2); ss += __shfl_xor(ss, 4);
        const float rinv = rsqrtf(ss * (1.0f / 128.0f) + EPS);
        float a[16];
#pragma unroll
        for (int j = 0; j < 16; ++j) a[j] = o[j] * rinv * gn[j] * sg[j];
        u32x4 w0, w1;
        w0.x = pk2(a[0], a[1]); w0.y = pk2(a[2], a[3]); w0.z = pk2(a[4], a[5]); w0.w = pk2(a[6], a[7]);
        w1.x = pk2(a[8], a[9]); w1.y = pk2(a[10], a[11]); w1.z = pk2(a[12], a[13]); w1.w = pk2(a[14], a[15]);
        *(u32x4*)(OF + off) = w0; *(u32x4*)(OF + off + 8) = w1;
    }
}

__device__ __forceinline__ void conv_items(LAS unsigned char* lds, int item_begin, int item_end, int item_step, const bf16* GLU, const float* wdw, const float* bdw, const float* lng, const float* lnb, bf16* BOP) {
    constexpr int TT = 16;
    LAS float* P1 = (LAS float*)lds;
    LAS float* P2 = (LAS float*)(lds + 65536);
    LAS float* ST = (LAS float*)(lds + 131072);
    const int tid = tid_opaque(), c = 2 * tid;
    f32x2 w2[31];
#pragma unroll
    for (int j = 0; j < 31; ++j) w2[j] = *(const f32x2*)(wdw + j * D + c);
    const f32x2 bd = *(const f32x2*)(bdw + c), g2 = *(const f32x2*)(lng + c), b2 = *(const f32x2*)(lnb + c);
    unsigned xw[TT + 30];
#define CONV_ISSUE(item_) do { const int b_ = (item_) / (SEQ / TT), t0_ = ((item_) % (SEQ / TT)) * TT; _Pragma("unroll") for (int r = 0; r < TT + 30; ++r) { \
        const int pos = t0_ - 15 + r; xw[r] = 0u; if (pos >= 0 && pos < SEQ) xw[r] = *(const unsigned*)(GLU + (size_t)(b_ * SEQ + pos) * D + c); } } while (0)
    if (item_begin < item_end) CONV_ISSUE(item_begin);
    for (int item = item_begin; item < item_end; item += item_step) {
        const int b = item / (SEQ / TT), t0 = (item % (SEQ / TT)) * TT;
        f32x2 xf[TT + 30];
#pragma unroll
        for (int r = 0; r < TT + 30; ++r) { xf[r].x = bflo(xw[r]); xf[r].y = bfhi(xw[r]); }
        if (item + item_step < item_end) CONV_ISSUE(item + item_step);
        f32x2 y[TT];
#pragma unroll
        for (int t = 0; t < TT; ++t) {
            f32x2 a2 = bd;
#pragma unroll
            for (int j = 0; j < 31; ++j) a2 = __builtin_elementwise_fma(xf[t + j], w2[j], a2);
            y[t] = a2;
        }
#pragma unroll
        for (int t = 0; t < TT; ++t) { const f32x2 q = y[t] * y[t]; P1[t * 512 + tid] = y[t].x + y[t].y; P2[t * 512 + tid] = q.x + q.y; }
        __syncthreads();
        {
            const int t = tid >> 5, part = tid & 31; float sm = 0.f, q = 0.f;
#pragma unroll
            for (int j = 0; j < 4; ++j) { const f32x4 a = *(const LAS f32x4*)(P1 + t * 512 + part * 16 + 4 * j), bq = *(const LAS f32x4*)(P2 + t * 512 + part * 16 + 4 * j);
                sm += (a[0] + a[1]) + (a[2] + a[3]); q += (bq[0] + bq[1]) + (bq[2] + bq[3]); }
#pragma unroll
            for (int o = 16; o >= 1; o >>= 1) { sm += __shfl_xor(sm, o); q += __shfl_xor(q, o); }
            if (part == 0) { const float mean = sm * (1.0f / D); const float var = fmaxf(q * (1.0f / D) - mean * mean, 0.f); ST[2 * t] = mean; ST[2 * t + 1] = rsqrtf(var + EPS); }
        }
        __syncthreads();
#pragma unroll
        for (int t = 0; t < TT; ++t) {
            const float mean = ST[2 * t], rstd = ST[2 * t + 1];
            const f32x2 v = (y[t] - mean) * (g2 * rstd) + b2;
            const f32x2 o = v * sig2_(v);
            *(unsigned*)(BOP + (size_t)(b * SEQ + t0 + t) * D + c) = pk2(o.x, o.y);
        }
        __syncthreads();
    }
#undef CONV_ISSUE
}

__device__ __forceinline__ size_t scan_rowbase(int ci, int t, int dir, int b) {
    const bool ctx = ci < 8; const int lc = ctx ? ci : ci - 8, nch = ctx ? 8 : 128;
    const int p0 = dir ? (nch - 1 - lc) * 32 : lc * 32; const int pos = dir ? p0 + 31 - t : p0 + t;
    return ctx ? (size_t)(ML + b * CTXL + pos) : (size_t)(b * SEQ + pos);
}
constexpr int S2_QS = 0, S2_KS = 26112, S2_KET = 43520, S2_VT = 74240, S2_DEC = 89600, S2_AS = 91136, S2_ST = 96256;
constexpr int QROW = 272, SROW = 80;
struct ScanRegs { u32x4 q, g, v; };
struct ScanCtx { const bf16* Q; const f16* G; const bf16* V; bf16* O; int b, h, dvh, dir, w, lane, l15, q4, tau, cg; };

__device__ __forceinline__ void scan_issue(const ScanCtx& c, int ci, ScanRegs& r) {
    const size_t row = scan_rowbase(ci, c.tau, c.dir, c.b);
    const size_t qrow = (ci >= 8) ? row : (size_t)(c.b * SEQ + c.tau);
    const int d0 = 16 * c.w + 8 * c.cg;
    r.g = *(const u32x4*)(c.G + row * D + c.h * 128 + d0);
    r.q = *(const u32x4*)(c.Q + qrow * D + c.h * 128 + d0);
    r.v = *(const u32x4*)(c.V + row * D + c.h * 128 + c.dvh * 64 + 8 * c.w);
}
template <int CTRL, int ROWMASK> __device__ __forceinline__ float dpp_mul_(float x) {
    const int y = __builtin_amdgcn_update_dpp(0x3f800000, __float_as_int(x), CTRL, ROWMASK, 0xF, false);
    return x * __int_as_float(y);
}
__device__ __forceinline__ void scan_E(LAS unsigned char* lds, const ScanCtx& c, int ci, const ScanRegs& r) {
    const bool lat = ci >= 8; const int s3 = ci % 3, s2 = ci & 1; const int tau = c.tau, d0 = 16 * c.w + 8 * c.cg;
    float f[8], P[8];
    { const f16x8 gh = __builtin_bit_cast(f16x8, r.g);
#pragma unroll
      for (int j = 0; j < 8; ++j) { P[j] = __builtin_amdgcn_exp2f((float)gh[j]); f[j] = 1.0f - P[j]; } }
#define DPP8(ctrl) "v_mul_f32_dpp %0, %0, %0 " ctrl "\n\tv_mul_f32_dpp %1, %1, %1 " ctrl "\n\tv_mul_f32_dpp %2, %2, %2 " ctrl "\n\tv_mul_f32_dpp %3, %3, %3 " ctrl "\n\t" \
                   "v_mul_f32_dpp %4, %4, %4 " ctrl "\n\tv_mul_f32_dpp %5, %5, %5 " ctrl "\n\tv_mul_f32_dpp %6, %6, %6 " ctrl "\n\tv_mul_f32_dpp %7, %7, %7 " ctrl "\n\t"
    asm volatile("s_nop 1\n\t"
                 DPP8("row_shr:1 row_mask:0xf bank_mask:0xf") DPP8("row_shr:2 row_mask:0xf bank_mask:0xf") DPP8("row_shr:4 row_mask:0xf bank_mask:0xf")
                 DPP8("row_shr:8 row_mask:0xf bank_mask:0xf") DPP8("row_bcast:15 row_mask:0xa bank_mask:0xf") "s_nop 1"
                 : "+v"(P[0]), "+v"(P[1]), "+v"(P[2]), "+v"(P[3]), "+v"(P[4]), "+v"(P[5]), "+v"(P[6]), "+v"(P[7]));
#undef DPP8
    float kt[8], qg[8];
    const unsigned qw[4] = {r.q.x, r.q.y, r.q.z, r.q.w};
#pragma unroll
    for (int j = 0; j < 8; ++j) {
        const float k = f[j];
        float pc; asm("v_max_f32 %0, %1, %2" : "=v"(pc) : "v"(P[j]), "v"(1e-30f));
        kt[j] = k * __builtin_amdgcn_rcpf(pc);
        const float qv = (j & 1) ? bfhi(qw[j >> 1]) : bflo(qw[j >> 1]);
        qg[j] = qv * P[j];
    }
    u32x4 wk; wk.x = pk2(kt[0], kt[1]); wk.y = pk2(kt[2], kt[3]); wk.z = pk2(kt[4], kt[5]); wk.w = pk2(kt[6], kt[7]);
    *(LAS u32x4*)(lds + S2_KS + s2 * 8704 + tau * QROW + d0 * 2) = wk;
    if (lat) { u32x4 wq; wq.x = pk2(qg[0], qg[1]); wq.y = pk2(qg[2], qg[3]); wq.z = pk2(qg[4], qg[5]); wq.w = pk2(qg[6], qg[7]);
        *(LAS u32x4*)(lds + S2_QS + s3 * 8704 + tau * QROW + d0 * 2) = wq; }
    { const unsigned kw[4] = {wk.x, wk.y, wk.z, wk.w};
#pragma unroll
      for (int j = 0; j < 4; ++j) {
        *(LAS unsigned short*)(lds + S2_KET + s3 * 10240 + (d0 + 2 * j) * SROW + tau * 2) = (unsigned short)(kw[j] & 0xffffu);
        *(LAS unsigned short*)(lds + S2_KET + s3 * 10240 + (d0 + 2 * j + 1) * SROW + tau * 2) = (unsigned short)(kw[j] >> 16); } }
    if (tau == 31) { LAS float* DC = (LAS float*)(lds + S2_DEC + s3 * 512);
        *(LAS f32x4*)(DC + d0) = (f32x4){P[0], P[1], P[2], P[3]};
        *(LAS f32x4*)(DC + d0 + 4) = (f32x4){P[4], P[5], P[6], P[7]}; }
    if (c.lane < 32) { const unsigned vw[4] = {r.v.x, r.v.y, r.v.z, r.v.w};
#pragma unroll
        for (int j = 0; j < 4; ++j) {
            *(LAS unsigned short*)(lds + S2_VT + s3 * 5120 + (8 * c.w + 2 * j) * SROW + tau * 2) = (unsigned short)(vw[j] & 0xffffu);
            *(LAS unsigned short*)(lds + S2_VT + s3 * 5120 + (8 * c.w + 2 * j + 1) * SROW + tau * 2) = (unsigned short)(vw[j] >> 16); } }
}
__device__ __forceinline__ void scan_A(LAS unsigned char* lds, const ScanCtx& c, int ci) {
    if (c.w >= 3) return;
    const int s3 = ci % 3, s2 = ci & 1; const int l15 = c.l15, q4 = c.q4;
    const LAS unsigned char* QS = lds + S2_QS + s3 * 8704; const LAS unsigned char* KS = lds + S2_KS + s2 * 8704;
    const int ti = (c.w == 0) ? 0 : 1, sj = (c.w == 2) ? 1 : 0;
    f32x4 a4 = (f32x4){0.f, 0.f, 0.f, 0.f};
#pragma unroll
    for (int kk = 0; kk < 4; ++kk) {
        const bf16x8 xa = *(const LAS bf16x8*)(KS + (sj * 16 + l15) * QROW + kk * 64 + q4 * 16);
        const bf16x8 yb = *(const LAS bf16x8*)(QS + (ti * 16 + l15) * QROW + kk * 64 + q4 * 16);
        a4 = __builtin_amdgcn_mfma_f32_16x16x32_bf16(xa, yb, a4, 0, 0, 0);
    }
    const int t = ti * 16 + l15, s0 = sj * 16 + 4 * q4;
    const float m0 = (s0 <= t) ? a4[0] : 0.f, m1 = (s0 + 1 <= t) ? a4[1] : 0.f, m2 = (s0 + 2 <= t) ? a4[2] : 0.f, m3 = (s0 + 3 <= t) ? a4[3] : 0.f;
    u32x2 wa; wa.x = pk2(m0, m1); wa.y = pk2(m2, m3);
    *(LAS u32x2*)(lds + S2_AS + s2 * 2560 + t * SROW + s0 * 2) = wa;
}
__device__ __forceinline__ void scan_M(LAS unsigned char* lds, const ScanCtx& c, int ci, f32x4 (&accS)[4]) {
    const bool lat = ci >= 8; const int s3 = ci % 3, s2 = ci & 1; const int l15 = c.l15, q4 = c.q4, w = c.w;
    const LAS unsigned char* QS = lds + S2_QS + s3 * 8704; const LAS unsigned char* KET = lds + S2_KET + s3 * 10240; const LAS unsigned char* VT = lds + S2_VT + s3 * 5120;
    const LAS unsigned char* STr = lds + S2_ST + s2 * 17408; LAS unsigned char* STw = lds + S2_ST + (s2 ^ 1) * 17408;
    const int tt = w >> 2, et = w & 3;
    if (lat) {
        f32x4 acco = (f32x4){0.f, 0.f, 0.f, 0.f};
#pragma unroll
        for (int kk = 0; kk < 4; ++kk) {
            const bf16x8 xa = *(const LAS bf16x8*)(STr + (et * 16 + l15) * QROW + kk * 64 + q4 * 16);
            const bf16x8 yb = *(const LAS bf16x8*)(QS + (tt * 16 + l15) * QROW + kk * 64 + q4 * 16);
            acco = __builtin_amdgcn_mfma_f32_16x16x32_bf16(xa, yb, acco, 0, 0, 0);
        }
        {
            const bf16x8 xa = *(const LAS bf16x8*)(VT + (et * 16 + l15) * SROW + q4 * 16);
            const bf16x8 yb = *(const LAS bf16x8*)(lds + S2_AS + s2 * 2560 + (tt * 16 + l15) * SROW + q4 * 16);
            acco = __builtin_amdgcn_mfma_f32_16x16x32_bf16(xa, yb, acco, 0, 0, 0);
        }
        const size_t r = scan_rowbase(ci, tt * 16 + l15, c.dir, c.b);
        u32x2 wo; wo.x = pk2(acco[0], acco[1]); wo.y = pk2(acco[2], acco[3]);
        { bf16* op = c.O + r * D + c.h * 128 + c.dvh * 64 + et * 16 + 4 * q4;
          asm volatile("global_store_dwordx2 %0, %1, off" :: "v"(op), "v"(wo) : "memory"); }
    }
    {
        const f32x4 dc = *(const LAS f32x4*)(lds + S2_DEC + s3 * 512 + (16 * w + 4 * q4) * 4);
        const bf16x8 xa = *(const LAS bf16x8*)(KET + (16 * w + l15) * SROW + q4 * 16);
#pragma unroll
        for (int i = 0; i < 4; ++i) {
            const bf16x8 yb = *(const LAS bf16x8*)(VT + (16 * i + l15) * SROW + q4 * 16);
            accS[i] = __builtin_amdgcn_mfma_f32_16x16x32_bf16(xa, yb, accS[i], 0, 0, 0) * dc;
        }
#pragma unroll
        for (int i = 0; i < 4; ++i) {
            u32x2 ws_; ws_.x = pk2(accS[i][0], accS[i][1]); ws_.y = pk2(accS[i][2], accS[i][3]);
            *(LAS u32x2*)(STw + (16 * i + l15) * QROW + (16 * w + 4 * q4) * 2) = ws_;
        }
    }
}
__device__ __forceinline__ void scan_item(LAS unsigned char* lds, int item, const bf16* Q, const f16* GF, const f16* GB, const bf16* V, bf16* OF, bf16* OB) {
    const int tid = tid_opaque(), lane = tid & 63;
    ScanCtx c;
    c.dvh = item & 1; c.dir = (item >> 1) & 1; c.h = (item >> 2) & 7; c.b = item >> 5;
    c.Q = Q; c.G = c.dir ? GB : GF; c.V = V; c.O = c.dir ? OB : OF;
    c.w = __builtin_amdgcn_readfirstlane(tid >> 6); c.lane = lane; c.l15 = lane & 15; c.q4 = lane >> 4; c.tau = lane & 31; c.cg = lane >> 5;
    for (int i = tid; i < (5120 + 34816) / 4; i += 512) ((LAS unsigned*)(lds + S2_AS))[i] = 0u;
    f32x4 accS[4];
#pragma unroll
    for (int i = 0; i < 4; ++i) accS[i] = (f32x4){0.f, 0.f, 0.f, 0.f};
    ScanRegs r0, r1, r2, r3;
    r0.q = r1.q = r2.q = r3.q = (u32x4){0u, 0u, 0u, 0u}; r0.v = r1.v = r2.v = r3.v = (u32x4){0u, 0u, 0u, 0u};
    scan_issue(c, 0, r0); scan_issue(c, 1, r1); scan_issue(c, 2, r2); scan_issue(c, 3, r3);
    __syncthreads();
#define SCAN_STEP(T_, R_) do { const int T = (T_); \
        __builtin_amdgcn_s_setprio(2); if (T >= 2) scan_M(lds, c, T - 2, accS); __builtin_amdgcn_s_setprio(0); \
        if (T >= 9) scan_A(lds, c, T - 1); \
        scan_E(lds, c, T, R_); { const int nx = (T + 4 < 136) ? T + 4 : 135; scan_issue(c, nx, R_); } \
        __syncthreads(); } while (0)
    for (int T0 = 0; T0 < 136; T0 += 4) { SCAN_STEP(T0, r0); SCAN_STEP(T0 + 1, r1); SCAN_STEP(T0 + 2, r2); SCAN_STEP(T0 + 3, r3); }
    scan_M(lds, c, 134, accS); scan_A(lds, c, 135); __syncthreads();
    scan_M(lds, c, 135, accS); __syncthreads();
    asm volatile("s_waitcnt vmcnt(0)" ::: "memory");
#undef SCAN_STEP
}

#define XB_TMO      128
#define XB_XCNT(j)  (256  + 64 * (j))
#define XB_XSUB(j)  (1280 + 64 * (j))
#define XB_XGEN(j)  (2304 + 64 * (j))
#define XB_TOP      3328
#define XB_TOPGEN   3392
#define XCD_BAR_WORDS 3456
#define XB_SPIN_CAP (1u << 18)

__device__ __forceinline__ unsigned xb_ld(unsigned* p)              { return __hip_atomic_load(p, __ATOMIC_RELAXED, __HIP_MEMORY_SCOPE_AGENT); }
__device__ __forceinline__ unsigned xb_add(unsigned* p, unsigned v) { return __hip_atomic_fetch_add(p, v, __ATOMIC_RELAXED, __HIP_MEMORY_SCOPE_AGENT); }
__device__ __forceinline__ unsigned xb_xcc_id() { return (unsigned)__builtin_amdgcn_s_getreg((3 << 11) | 20) & 0xFu; }
#define XB_SPIN(cond, bar) do { unsigned _sp = 0; while (cond) { __builtin_amdgcn_s_sleep(1); \
    if ((++_sp & 255u) == 0u) { if (xb_ld(&(bar)[XB_TMO])) break; if (_sp > XB_SPIN_CAP) { atomicAdd(&(bar)[XB_TMO], 1u); break; } } } } while (0)

struct XcdBarrier {
    unsigned* bar; unsigned x;
    volatile LAS unsigned* st;
};

__device__ __forceinline__ XcdBarrier xcd_barrier_post(unsigned* bar, volatile LAS unsigned* st) {
    XcdBarrier b; b.bar = bar; b.x = xb_xcc_id(); b.st = st;
    if (threadIdx.x == 0) (void)xb_add(&bar[XB_XCNT(b.x)], 1u);
    return b;
}
__device__ __forceinline__ void xcd_barrier_complete(unsigned* bar, unsigned x, unsigned& nloc, unsigned& nx) {
    const unsigned G = gridDim.x * gridDim.y * gridDim.z;
    unsigned sum, cnt, mine, sp = 0u;
    for (;;) {
        sum = 0u; cnt = 0u; mine = 0u;
#pragma unroll
        for (unsigned j = 0; j < 16; ++j) { const unsigned c = xb_ld(&bar[XB_XCNT(j)]); sum += c; cnt += (c > 0u) ? 1u : 0u; mine = (j == x) ? c : mine; }
        if (sum == G) break;
        __builtin_amdgcn_s_sleep(1);
        if ((++sp & 255u) == 0u) { if (xb_ld(&bar[XB_TMO])) break; if (sp > XB_SPIN_CAP) { atomicAdd(&bar[XB_TMO], 1u); break; } }
    }
    nloc = mine > 0u ? mine : 1u; nx = cnt > 0u ? cnt : 1u;
}

__device__ __forceinline__ void xcd_barrier(const XcdBarrier& b) {
    asm volatile("s_waitcnt vmcnt(0)" ::: "memory");
    __syncthreads();
    if (threadIdx.x == 0) {
        unsigned* bar = b.bar;
        __builtin_amdgcn_s_waitcnt(0);
        unsigned nloc = b.st[0], nx = b.st[1];
        if (nloc == 0u) { xcd_barrier_complete(bar, b.x, nloc, nx); b.st[0] = nloc; b.st[1] = nx; }
        const unsigned old = xb_add(&bar[XB_XSUB(b.x)], 1u);
        const unsigned gen = old / nloc;
        if (old + 1u == (gen + 1u) * nloc) {
            __builtin_amdgcn_fence(__ATOMIC_RELEASE, "agent");
            asm volatile("s_waitcnt vmcnt(0)" ::: "memory");
            const unsigned og = xb_add(&bar[XB_TOP], 1u);
            const unsigned tg = og / nx;
            if (og + 1u == (tg + 1u) * nx) xb_add(&bar[XB_TOPGEN], 1u);
            else XB_SPIN(xb_ld(&bar[XB_TOPGEN]) == tg, bar);
            __builtin_amdgcn_fence(__ATOMIC_ACQUIRE, "agent");
            xb_add(&bar[XB_XGEN(b.x)], 1u);
            asm volatile("s_waitcnt vmcnt(0)" ::: "memory");
        } else {
            XB_SPIN(xb_ld(&bar[XB_XGEN(b.x)]) == gen, bar);
            __builtin_amdgcn_fence(__ATOMIC_ACQUIRE, "agent");
            asm volatile("s_waitcnt vmcnt(0)" ::: "memory");
        }
    }
    __syncthreads();
}

__global__ void __launch_bounds__(512, 2) mega(Params P) {
    extern __shared__ __attribute__((aligned(16))) unsigned char lds_raw[];
    LAS unsigned char* lds = (LAS unsigned char*)lds_raw;
#define GRID_SYNC() xcd_barrier(xbar)
    if (threadIdx.x < 2) ((volatile LAS unsigned*)(lds + 131072 + 1024))[threadIdx.x] = 0u;
    __syncthreads();
    XcdBarrier xbar = xcd_barrier_post((unsigned*)(P.ws + WS_BAR), (volatile LAS unsigned*)(lds + 131072 + 1024));
    const int tid = threadIdx.x, G = gridDim.x, bid = blockIdx.x;
    unsigned char* ws = P.ws;
    bf16* WUP = (bf16*)(ws + WS_WUP); bf16* WDN = (bf16*)(ws + WS_WDN); bf16* WIN = (bf16*)(ws + WS_WIN);
    bf16* WPA = (bf16*)(ws + WS_WPA); bf16* WPB = (bf16*)(ws + WS_WPB); bf16* WO = (bf16*)(ws + WS_WO);
    float* MOD = (float*)(ws + WS_MOD); float* LBF = MOD + 9 * NMODC; float* LBB = LBF + 1024;
    bf16* U = (bf16*)(ws + WS_U);
    bf16* H = (bf16*)(ws + R_H); float* HC1 = (float*)(ws + R_HC1);
    bf16* Qb = (bf16*)(ws + R_Q); f16* GFb = (f16*)(ws + R_GF); f16* GBb = (f16*)(ws + R_GB); bf16* Vb = (bf16*)(ws + R_V);
    bf16* OFb = (bf16*)(ws + R_OF); bf16* OBb = (bf16*)(ws + R_OB);
    bf16* SGb = (bf16*)(ws + R_SG); bf16* GLUb = (bf16*)(ws + R_GLU); bf16* GATESb = (bf16*)(ws + R_GATES);
    bf16* BOP = U; bf16* Tb = OBb;
    bf16* H2B = OFb;
    bf16* DLT = (bf16*)(ws + WS_R + 192 * MiB);
    bf16* PART = (bf16*)(ws + WS_R + 192 * MiB);
    float* OUT = P.out;
    bf16* H1B = (bf16*)OUT;

    {
        if (bid < 144) {
            LAS float* SC = (LAS float*)lds;
            for (int i = tid; i < 9 * 1024; i += 512) { const float v = (i < 8192) ? P.in[I_C][i] : P.in[I_CCTX][i - 8192]; SC[i] = siluf_(v); }
            __syncthreads();
            for (int item = bid; item < 144; item += G) adaln_item(lds, item, P.in[I_WADA], P.in[I_BADA], MOD);
        }
        if (bid == G - 1) {
            const float* l = P.in[I_LBL];
            for (int d = tid; d < 1024; d += 512) { LBF[d] = 1.0f / (1.0f + __expf(l[2048 + d] - l[d])); LBB[d] = 1.0f / (1.0f + __expf(l[3072 + d] - l[1024 + d])); }
        }
        for (int it = (bid + 112) % G; it < 2592; it += G) {
            if (it < 704) conv_job_item(lds, it, P.in[I_W1U], 1024, 5632, WUP, 0, 0, 2816);
            else if (it < 1056) conv_job_item(lds, it - 704, P.in[I_W1D], 2816, 1024, WDN, 0, -1, 0);
            else if (it < 1952) conv_job_item(lds, it - 1056, P.in[I_WIN], 1024, 7168, WIN, 0, 5120, 1024);
            else if (it < 2208) conv_job_item(lds, it - 1952, P.in[I_WG], 1024, 2048, WIN, 7168, -1, 0);
            else if (it < 2336) conv_job_item(lds, it - 2208, P.in[I_WPA], 1024, 1024, WPA, 0, -1, 0);
            else if (it < 2464) conv_job_item(lds, it - 2336, P.in[I_WPB], 1024, 1024, WPB, 0, -1, 0);
            else conv_job_item(lds, it - 2464, P.in[I_WO], 1024, 1024, WO, 0, -1, 0);
        }
    }
    GRID_SYNC();
    normmod_phase<true, true>(P.in[I_X], P.in[I_CTX], MT, P.in[I_NF1], MOD, 0, 1, U, OUT);
    GRID_SYNC();
    { pg8::Gemm g{U, WUP, MT, 2 * FF, D, D}; pg8::StaticOrder S; S.init(MT, 2 * FF, G, bid); EpiSwiglu E{H, FF}; pg8::gemm_phase<EpiSwiglu, pg8::StaticOrder, GEMM_ALIGN, GEMM_SP2>(lds, g, S, E, nullptr); }
    GRID_SYNC();
    { pg8::Gemm g{H, WDN, ML, D, FF, FF}; pg8::StaticOrder S; S.init(ML, D, G, bid); EpiResB<false> E{P.in[I_X], H1B, MOD, 2, 0.5f}; pg8::gemm_phase<EpiResB<false>, pg8::StaticOrder, GEMM_ALIGN, GEMM_SP2>(lds, g, S, E, nullptr); }
    { pg8::Gemm g{H, WDN, MT, D, 256, FF}; KSplitOrder S{G, bid}; EpiPart E{PART}; pg8::gemm_phase<EpiPart, KSplitOrder, GEMM_ALIGN, GEMM_SP2>(lds, g, S, E, nullptr); }
    GRID_SYNC();
    normmod_phase<true, true, true, false, true>((const float*)H1B, P.in[I_CTX], MT, P.in[I_NMIX], MOD, 3, 4, U, OUT, PART, 2);
    GRID_SYNC();
    { pg8::Gemm g{U, WIN, MT, 4096, D, D}; pg8::StaticOrder S; S.init(MT, 4096, G, bid); EpiMix1 E{Qb, GFb, GBb, Vb, LBF, LBB}; pg8::gemm_phase<EpiMix1, pg8::StaticOrder, GEMM_ALIGN, GEMM_SP2>(lds, g, S, E, nullptr); }
    GRID_SYNC();
    for (int item = bid; item < 256; item += G) scan_item(lds, item, Qb, GFb, GBb, Vb, OFb, OBb);
    GRID_SYNC();
    { pg8::Gemm g{U, WIN + (size_t)4096 * D, ML, 5120, D, D}; pg8::StaticOrder S; S.init(ML, 5120, G, bid); EpiMix2 E{SGb, GLUb, GATESb, P.in[I_BG]}; pg8::gemm_phase<EpiMix2, pg8::StaticOrder, GEMM_ALIGN, GEMM_SP2>(lds, g, S, E, nullptr); }
    GRID_SYNC();
    {
        conv_items(lds, bid, 2048, G, GLUb, P.in[I_WDW], P.in[I_BDW], P.in[I_LNG], P.in[I_LNB], BOP);
        aop_rows(bid * 8 + (tid >> 6), ML, G * 8, OFb, OBb, SGb, P.in[I_HGN]);
        for (int it = bid; it < 1056; it += G) {
            if (it < 704) conv_job_item(lds, it, P.in[I_W2U], 1024, 5632, WUP, 0, 0, 2816);
            else conv_job_item(lds, it - 704, P.in[I_W2D], 2816, 1024, WDN, 0, -1, 0);
        }
    }
    GRID_SYNC();
    { pg8::Gemm g{OFb, WPA, ML, D, D, D}; pg8::StaticOrder S; S.init(ML, D, G, bid); EpiGate<0> E{GATESb, Tb, 0}; pg8::gemm_phase<EpiGate<0>, pg8::StaticOrder, GEMM_ALIGN, GEMM_SP2>(lds, g, S, E, nullptr); }
    GRID_SYNC();
    { pg8::Gemm g{BOP, WPB, ML, D, D, D}; pg8::StaticOrder S; S.init(ML, D, G, bid); EpiGate<1> E{GATESb, Tb, 1024}; pg8::gemm_phase<EpiGate<1>, pg8::StaticOrder, GEMM_ALIGN, GEMM_SP2>(lds, g, S, E, nullptr); }
    GRID_SYNC();
    { pg8::Gemm g{Tb, WO, ML, D, D, D}; pg8::StaticOrder S; S.init(ML, D, G, bid); EpiResB<true> E{(const float*)H1B, H2B, MOD, 5, 1.0f}; pg8::gemm_phase<EpiResB<true>, pg8::StaticOrder, GEMM_ALIGN, GEMM_SP2>(lds, g, S, E, nullptr); }
    GRID_SYNC();
    normmod_phase<true, true, false, false, true>((const float*)H2B, HC1, ML, P.in[I_NF2], MOD, 6, 7, U, OUT);
    GRID_SYNC();
    { pg8::Gemm g{U, WUP, ML, 2 * FF, D, D}; pg8::StaticOrder S; S.init(ML, 2 * FF, G, bid); EpiSwiglu E{H, FF}; pg8::gemm_phase<EpiSwiglu, pg8::StaticOrder, GEMM_ALIGN, GEMM_SP2>(lds, g, S, E, nullptr); }
    GRID_SYNC();
    { pg8::Gemm g{H, WDN, ML, D, FF, FF}; pg8::StaticOrder S; S.init(ML, D, G, bid); EpiDelta E{DLT, MOD, 8, 0.5f}; pg8::gemm_phase<EpiDelta, pg8::StaticOrder, GEMM_ALIGN, GEMM_SP2>(lds, g, S, E, nullptr); }
    GRID_SYNC();
    normmod_phase<false, false, false, true, true>((const float*)H2B, HC1, ML, P.in[I_FN], MOD, 0, 0, U, OUT, nullptr, 0, DLT);
}

extern "C" void kernel_launch(void* const* d_in, const int* in_sizes, int n_in, void* d_out, int out_size, void* d_ws, size_t ws_size, hipStream_t stream) {
    static int grid = 0;
    if (grid == 0) {
        if (n_in != 26 || ws_size < WS_NEED) { fprintf(stderr, "kernel_launch: n_in %d ws %zu (need %zu)\n", n_in, ws_size, (size_t)WS_NEED); grid = -1; return; }
        int dev = 0, cus = 0, per_cu = 0;
        hipGetDevice(&dev); hipDeviceGetAttribute(&cus, hipDeviceAttributeMultiprocessorCount, dev);
        if (hipFuncSetAttribute((const void*)mega, hipFuncAttributeMaxDynamicSharedMemorySize, LDS_BYTES) != hipSuccess) { fprintf(stderr, "hipFuncSetAttribute failed\n"); grid = -1; return; }
        if (hipOccupancyMaxActiveBlocksPerMultiprocessor(&per_cu, (const void*)mega, 512, LDS_BYTES) != hipSuccess || per_cu < 1) { fprintf(stderr, "occupancy query: %d\n", per_cu); grid = -1; return; }
        grid = cus;
    }
    if (grid < 0) return;
    if (hipMemsetAsync((char*)d_ws + WS_BAR, 0, XCD_BAR_WORDS * sizeof(unsigned), stream) != hipSuccess) { fprintf(stderr, "memset failed\n"); return; }
    Params p{};
    for (int i = 0; i < 26; ++i) p.in[i] = (const float*)d_in[i];
    p.out = (float*)d_out; p.ws = (unsigned char*)d_ws;
    void* args[] = {&p};
    hipError_t e = hipLaunchCooperativeKernel((const void*)mega, dim3(grid), dim3(512), args, LDS_BYTES, stream);
    if (e != hipSuccess) fprintf(stderr, "cooperative launch failed: %s (grid %d)\n", hipGetErrorString(e), grid);
}
```

```cpp
#include <hip/hip_runtime.h>
#include <cstdio>
#define GEMM_ALIGN true
#define GEMM_SP2 true
namespace pg8 {
#define PG8_LAS __attribute__((address_space(3)))
typedef unsigned short bf16_t;
typedef short bf16x8 __attribute__((ext_vector_type(8)));
typedef float f32x4 __attribute__((ext_vector_type(4)));
typedef unsigned u32x4 __attribute__((ext_vector_type(4)));
constexpr int BM = 256, BK = 64, HALF = 128, HTB = HALF * BK * 2  , STAGE_BYTES = 8 * HTB, NXCD = 8, WGM = 8;

__host__ __device__ __forceinline__ int lds_byte(int r, int c) { const int st = (r >> 4) * 2 + (c >> 5), rr = r & 15, cc = c & 31, ob = rr * 64 + cc * 2; return st * 1024 + (ob ^ (((ob >> 9) & 1) << 5)); }
__host__ __device__ __forceinline__ void stage_rc(int b, int& R, int& C) { const int st = b / 1024, sb = b % 1024, swz = sb ^ (((sb >> 9) & 1) << 5); R = (st >> 1) * 16 + swz / 64; C = (st & 1) * 32 + (swz % 64) / 2; }
__host__ __device__ __forceinline__ int perm32(int rho) { const int n = rho >> 4, i = rho & 15; return 8 * (i >> 2) + 4 * n + (i & 3); }

struct Unit { int pm, pn, pk; };
struct Gemm { const bf16_t* A; const bf16_t* Bt; int M, N, K, Kp; };

struct StaticOrder {
    int nM, nN, nwg, G, c;
    __host__ __device__ void init(int M, int N, int G_, int c_) { nM = M / BM; nN = N / BM; nwg = nM * nN; G = G_; c = c_; }
    __host__ __device__ bool next(int i, Unit& u) const {
        const long L = (long)i * G + c; if (L >= nwg) return false;
        int wgid = (int)L; { const int q = nwg / NXCD, r = nwg % NXCD, xcd = wgid % NXCD, off = wgid / NXCD; wgid = (xcd < r ? xcd * (q + 1) : r * (q + 1) + (xcd - r) * q) + off; }
        const int nig = WGM * nN, gid = wgid / nig, fm = gid * WGM, gsz = (nM - fm) < WGM ? (nM - fm) : WGM;
        u.pm = fm + ((wgid % nig) % gsz); u.pn = (wgid % nig) / gsz; u.pk = 0; return true;
    }
    __device__ __forceinline__ void a_ready(const Unit&) const {}
    __device__ __forceinline__ void done(const Unit&) const {}
};
__device__ __forceinline__ unsigned cvt_pk_bf16(float lo, float hi) { unsigned r; asm volatile("v_cvt_pk_bf16_f32 %0, %1, %2" : "=v"(r) : "v"(lo), "v"(hi)); return r; }
template <class Epi, class Sched, bool ALIGN_EPI = false, bool SP2 = false, bool STAMP = false>
__device__ __forceinline__ void gemm_phase(PG8_LAS unsigned char* lds, const Gemm g, const Sched& S, const Epi& E, unsigned long long* stamps) {
    int tid_ = threadIdx.x; asm volatile("" : "+v"(tid_));
    const int tid = tid_, wid = __builtin_amdgcn_readfirstlane(tid >> 6), lane = tid & 63, wr = wid >> 2, wc = wid & 3, fr = lane & 15, fq = lane >> 4;
    const int K = g.Kp, nt = g.K / BK;
    int ts_lo = 0, ts_hi = 0, nts = 0; const unsigned long long rt_entry = STAMP ? (unsigned long long)wall_clock64() : 0ull;
#define PG8_STAMP() do { if (STAMP && wid == 0 && nts < 64) { const unsigned long long _c = (unsigned long long)clock64(); \
        ts_lo = (lane == nts) ? (int)(unsigned)_c : ts_lo; ts_hi = (lane == nts) ? (int)(unsigned)(_c >> 32) : ts_hi; ++nts; } } while (0)
    PG8_STAMP();
    unsigned voffA[2], voffB[2];
#pragma unroll
    for (int i = 0; i < 2; ++i) { int R, C; stage_rc(tid * 16 + i * 8192, R, C); const int Rb = Epi::PERM ? ((R & ~31) + perm32(R & 31)) : R;
        voffA[i] = (unsigned)(R * K + C) * 2u; voffB[i] = (unsigned)(Rb * K + C) * 2u; }
    const size_t kstep = (size_t)(BK * 2);
    const size_t hstep = (size_t)HALF * K * 2;
    const size_t tstep = 2 * hstep;
    const unsigned ldsw = (unsigned)wid * 1024u;
    const int aoff = lds_byte(wr * 64 + fr, fq * 8), boff = lds_byte(wc * 32 + fr, fq * 8);
#define PG8_SA(b, h) (((b) * 2 + (h)) * HTB)
#define PG8_SB(b, h) ((4 + (b) * 2 + (h)) * HTB)
#define PG8_STAGE(bufoff, gbase, voff) do { _Pragma("unroll") for (int _i = 0; _i < 2; ++_i) \
        __builtin_amdgcn_global_load_lds((const unsigned*)((const char*)(gbase) + (voff)[_i]), (PG8_LAS unsigned*)(lds + (bufoff) + ldsw + _i * 8192), 16, 0, 0); } while (0)
#define PG8_LDA(dst, b, h) do { _Pragma("unroll") for (int m = 0; m < 4; ++m) _Pragma("unroll") for (int k = 0; k < 2; ++k) dst[m][k] = *(const PG8_LAS bf16x8*)(lds + PG8_SA(b, h) + aoff + m * 2048 + k * 1024); } while (0)
#define PG8_LDB(dst, b, h) do { _Pragma("unroll") for (int n = 0; n < 2; ++n) _Pragma("unroll") for (int k = 0; k < 2; ++k) dst[n][k] = *(const PG8_LAS bf16x8*)(lds + PG8_SB(b, h) + boff + n * 2048 + k * 1024); } while (0)
#define PG8_MMA(ai, bj, At, Bt) do { __builtin_amdgcn_s_setprio(1); _Pragma("unroll") for (int m = 0; m < 4; ++m) _Pragma("unroll") for (int n = 0; n < 2; ++n) _Pragma("unroll") for (int k = 0; k < 2; ++k) \
        acc[ai][bj][m][n] = __builtin_amdgcn_mfma_f32_16x16x32_bf16(Bt[n][k], At[m][k], acc[ai][bj][m][n], 0, 0, 0); __builtin_amdgcn_s_setprio(0); } while (0)
#define PG8_WAIT_V(n) asm volatile("s_waitcnt vmcnt(" #n ")" ::: "memory")
#define PG8_WAIT_L(n) asm volatile("s_waitcnt lgkmcnt(" #n ")" ::: "memory")
#define PG8_BAR __builtin_amdgcn_s_barrier()
#define PG8_SCHED __builtin_amdgcn_sched_barrier(0)
    Unit cur, nxt; int ui = 0;
    if (!S.next(0, cur)) return;
    f32x4 acc[2][2][4][2];
#pragma unroll
    for (int a = 0; a < 2; ++a)
#pragma unroll
        for (int b = 0; b < 2; ++b)
#pragma unroll
            for (int m = 0; m < 4; ++m)
#pragma unroll
                for (int n = 0; n < 2; ++n) acc[a][b][m][n] = (f32x4){0.f, 0.f, 0.f, 0.f};
    bf16x8 At[4][2], B0[2][2], B1[2][2];
    const size_t pstep = (size_t)g.K * 2;
    const char* cA = (const char*)g.A + (size_t)cur.pm * tstep + (size_t)cur.pk * pstep; const char* cB = (const char*)g.Bt + (size_t)cur.pn * tstep + (size_t)cur.pk * pstep;
    S.a_ready(cur);
    if constexpr (SP2) {
        PG8_STAGE(PG8_SB(0, 0), cB, voffB); PG8_STAGE(PG8_SB(0, 1), cB + hstep, voffB); PG8_STAGE(PG8_SA(0, 0), cA, voffA); PG8_STAGE(PG8_SA(0, 1), cA + hstep, voffA);
        if (wr == 1) PG8_BAR;
        PG8_WAIT_V(2); PG8_BAR;
    } else {
        PG8_STAGE(PG8_SB(0, 0), cB, voffB); PG8_STAGE(PG8_SA(0, 0), cA, voffA); PG8_STAGE(PG8_SB(0, 1), cB + hstep, voffB); PG8_STAGE(PG8_SA(0, 1), cA + hstep, voffA);
        if (wr == 1) PG8_BAR;
        PG8_WAIT_V(4); PG8_BAR;
    }
    PG8_STAGE(PG8_SB(1, 0), cB + kstep, voffB); PG8_STAGE(PG8_SA(1, 0), cA + kstep, voffA); PG8_STAGE(PG8_SB(1, 1), cB + hstep + kstep, voffB);
    PG8_WAIT_V(6); PG8_BAR;
    PG8_STAMP();
    for (;;) {
        const bool has_next = S.next(ui + 1, nxt);
        const char* nA = has_next ? (const char*)g.A + (size_t)nxt.pm * tstep + (size_t)nxt.pk * pstep : cA; const char* nB = has_next ? (const char*)g.Bt + (size_t)nxt.pn * tstep + (size_t)nxt.pk * pstep : cB;
        for (int t = 0; t < nt; t += 2) {
            const bool last = (t == nt - 2);
            const char* a1 = cA + (size_t)(t + 1) * kstep;
            const char* a2 = last ? nA : cA + (size_t)(t + 2) * kstep; const char* b2 = last ? nB : cB + (size_t)(t + 2) * kstep;
            const char* a3 = a2 + kstep; const char* b3 = b2 + kstep;
            if (last && has_next) S.a_ready(nxt);
            if constexpr (SP2) {
            PG8_LDB(B0, 0, 0); PG8_LDB(B1, 0, 1); PG8_SCHED; PG8_LDA(At, 0, 0); PG8_STAGE(PG8_SA(1, 1), a1 + hstep, voffA);
            PG8_WAIT_V(8); PG8_WAIT_L(0); PG8_BAR; PG8_MMA(0, 0, At, B0); PG8_MMA(0, 1, At, B1); PG8_BAR; PG8_SCHED;
            PG8_LDA(At, 0, 1); PG8_STAGE(PG8_SB(0, 0), b2, voffB); PG8_STAGE(PG8_SB(0, 1), b2 + hstep, voffB); PG8_STAGE(PG8_SA(0, 0), a2, voffA);
            PG8_WAIT_V(8); PG8_WAIT_L(0); PG8_BAR; PG8_MMA(1, 0, At, B0); PG8_MMA(1, 1, At, B1); PG8_BAR; PG8_SCHED;
            PG8_LDB(B0, 1, 0); PG8_LDB(B1, 1, 1); PG8_SCHED; PG8_LDA(At, 1, 0); PG8_STAGE(PG8_SA(0, 1), a2 + hstep, voffA);
            PG8_WAIT_V(8); PG8_WAIT_L(0); PG8_BAR; PG8_MMA(0, 0, At, B0); PG8_MMA(0, 1, At, B1); PG8_BAR; PG8_SCHED;
            PG8_LDA(At, 1, 1); PG8_STAGE(PG8_SB(1, 0), b3, voffB); PG8_STAGE(PG8_SB(1, 1), b3 + hstep, voffB); PG8_STAGE(PG8_SA(1, 0), a3, voffA);
            PG8_WAIT_V(8); PG8_WAIT_L(0); PG8_BAR; PG8_MMA(1, 0, At, B0); PG8_MMA(1, 1, At, B1); PG8_BAR; PG8_SCHED;
            } else {
            PG8_LDB(B0, 0, 0); PG8_SCHED; PG8_LDA(At, 0, 0); PG8_STAGE(PG8_SA(1, 1), a1 + hstep, voffA);
            PG8_WAIT_L(8); PG8_BAR; PG8_WAIT_L(0); PG8_MMA(0, 0, At, B0); PG8_BAR; PG8_SCHED;
            PG8_LDB(B1, 0, 1); PG8_STAGE(PG8_SB(0, 0), b2, voffB);
            PG8_BAR; PG8_WAIT_L(0); PG8_MMA(0, 1, At, B1); PG8_BAR;
            PG8_LDA(At, 0, 1); PG8_STAGE(PG8_SA(0, 0), a2, voffA);
            PG8_BAR; PG8_WAIT_L(0); PG8_MMA(1, 0, At, B0); PG8_BAR; PG8_SCHED;
            PG8_STAGE(PG8_SB(0, 1), b2 + hstep, voffB);
            PG8_WAIT_V(6); PG8_BAR; PG8_MMA(1, 1, At, B1); PG8_BAR;
            PG8_LDB(B0, 1, 0); PG8_SCHED; PG8_LDA(At, 1, 0); PG8_STAGE(PG8_SA(0, 1), a2 + hstep, voffA);
            PG8_WAIT_L(8); PG8_BAR; PG8_WAIT_L(0); PG8_MMA(0, 0, At, B0); PG8_BAR; PG8_SCHED;
            PG8_LDB(B1, 1, 1); PG8_STAGE(PG8_SB(1, 0), b3, voffB);
            PG8_BAR; PG8_WAIT_L(0); PG8_MMA(0, 1, At, B1); PG8_BAR;
            PG8_LDA(At, 1, 1); PG8_STAGE(PG8_SA(1, 0), a3, voffA);
            PG8_BAR; PG8_WAIT_L(0); PG8_MMA(1, 0, At, B0); PG8_BAR; PG8_SCHED;
            PG8_STAGE(PG8_SB(1, 1), b3 + hstep, voffB);
            PG8_WAIT_V(6); PG8_BAR; PG8_MMA(1, 1, At, B1); PG8_BAR;
            }
        }
        PG8_STAMP();
        if constexpr (ALIGN_EPI) { if (wr == 0) PG8_BAR; }
        if constexpr (!Epi::AFTER_DRAIN) { E(acc, cur, wr, wc, fr, fq); S.done(cur); }
        PG8_STAMP();
        if (!has_next) break;
#pragma unroll
        for (int a = 0; a < 2; ++a)
#pragma unroll
            for (int b = 0; b < 2; ++b)
#pragma unroll
                for (int m = 0; m < 4; ++m)
#pragma unroll
                    for (int n = 0; n < 2; ++n) acc[a][b][m][n] = (f32x4){0.f, 0.f, 0.f, 0.f};
        cur = nxt; cA = nA; cB = nB; ++ui;
        if constexpr (ALIGN_EPI) { if (wr == 1) PG8_BAR; }
    }
    PG8_WAIT_V(0);
    if constexpr (!ALIGN_EPI) { if (wr == 0) PG8_BAR; }
    PG8_BAR;
    if constexpr (Epi::AFTER_DRAIN) { E.fused(acc, cur, wr, wc, fr, fq, lds, wid, lane); S.done(cur); }
    PG8_STAMP();
    if (STAMP && wid == 0) { stamps[lane] = lane < nts ? (((unsigned long long)(unsigned)ts_hi << 32) | (unsigned)ts_lo) : 0ull;
        if (lane == 62) stamps[62] = rt_entry; if (lane == 63) stamps[63] = (unsigned long long)wall_clock64(); }
#undef PG8_STAMP
#undef PG8_SA
#undef PG8_SB
#undef PG8_STAGE
#undef PG8_LDA
#undef PG8_LDB
#undef PG8_MMA
#undef PG8_WAIT_V
#undef PG8_WAIT_L
#undef PG8_BAR
#undef PG8_SCHED
}
}

#define LAS __attribute__((address_space(3)))
typedef unsigned short bf16;
typedef _Float16 f16;
typedef pg8::f32x4 f32x4;
typedef pg8::u32x4 u32x4;
typedef pg8::bf16x8 bf16x8;
typedef unsigned u32x2 __attribute__((ext_vector_type(2)));
typedef _Float16 f16x8 __attribute__((ext_vector_type(8)));
typedef _Float16 f16x4 __attribute__((ext_vector_type(4)));

constexpr int D = 1024, NB = 8, SEQ = 4096, CTXL = 256, ML = NB * SEQ, MC = NB * CTXL, MT = ML + MC, FF = 2816, NMODC = 9 * D;
constexpr float EPS = 1e-6f;
constexpr size_t MiB = 1ull << 20;
constexpr size_t WS_WUP = 0, WS_WDN = 11 * MiB, WS_WIN = 17 * MiB, WS_WPA = 35 * MiB, WS_WPB = 37 * MiB, WS_WO = 39 * MiB, WS_MOD = 41 * MiB,
                 WS_U = 42 * MiB, WS_R = 110 * MiB, WS_BAR = 41 * MiB + 512 * 1024;
constexpr size_t R_H = WS_R, R_HC1 = WS_R + 187 * MiB;
constexpr size_t R_Q = WS_R, R_GF = WS_R + 64 * MiB, R_GB = WS_R + 132 * MiB, R_V = WS_R + 200 * MiB, R_OF = WS_R + 268 * MiB, R_OB = WS_R + 332 * MiB;
constexpr size_t R_SG = WS_R, R_GLU = WS_R + 64 * MiB, R_GATES = WS_R + 128 * MiB;
constexpr size_t WS_NEED = WS_R + 396 * MiB;
constexpr int LDS_BYTES = 131072 + 4096;

struct Params { const float* in[26]; float* out; unsigned char* ws; };
enum { I_X = 0, I_C, I_CTX, I_CCTX, I_WADA, I_BADA, I_NF1, I_W1U, I_W1D, I_NMIX, I_WIN, I_LBL, I_HGN, I_WDW, I_BDW, I_LNG, I_LNB, I_WPA, I_WPB, I_WG, I_BG, I_WO,
       I_NF2, I_W2U, I_W2D, I_FN };

__device__ __forceinline__ int tid_opaque() { int t = threadIdx.x; asm volatile("" : "+v"(t)); return t; }
__device__ __forceinline__ float bf2f(unsigned short b) { return __uint_as_float(((unsigned)b) << 16); }
__device__ __forceinline__ float bflo(unsigned w) { return __uint_as_float(w << 16); }
__device__ __forceinline__ float bfhi(unsigned w) { return __uint_as_float(w & 0xffff0000u); }
typedef __bf16 bf2_t __attribute__((ext_vector_type(2)));
__device__ __forceinline__ unsigned pk2(float lo, float hi) { bf2_t v; v.x = (__bf16)lo; v.y = (__bf16)hi; return __builtin_bit_cast(unsigned, v); }
__device__ __forceinline__ float sigmoidf_(float x) { return __builtin_amdgcn_rcpf(1.0f + __expf(-x)); }
__device__ __forceinline__ float siluf_(float x) { return x * __builtin_amdgcn_rcpf(1.0f + __expf(-x)); }
typedef float f32x2 __attribute__((ext_vector_type(2)));
__device__ __forceinline__ f32x2 sig2_(f32x2 x) { const f32x2 t = x * (-1.44269504f); f32x2 e; e.x = __builtin_amdgcn_exp2f(t.x); e.y = __builtin_amdgcn_exp2f(t.y); const f32x2 d = e + 1.0f; f32x2 r; r.x = __builtin_amdgcn_rcpf(d.x); r.y = __builtin_amdgcn_rcpf(d.y); return r; }
__device__ __forceinline__ f32x4 sig4_(f32x4 x) { const f32x2 lo = sig2_(__builtin_shufflevector(x, x, 0, 1)), hi = sig2_(__builtin_shufflevector(x, x, 2, 3)); return (f32x4){lo.x, lo.y, hi.x, hi.y}; }
__device__ __forceinline__ f32x4 silu4_(f32x4 x) { return x * sig4_(x); }
__device__ __forceinline__ u32x2 pk4(f32x4 v) { u32x2 w; w.x = pk2(v[0], v[1]); w.y = pk2(v[2], v[3]); return w; }

struct EpiSwiglu {
    static constexpr bool PERM = true, AFTER_DRAIN = false;
    bf16* H; int ldh;
    __device__ __forceinline__ void operator()(const f32x4 (&acc)[2][2][4][2], const pg8::Unit& u, int wr, int wc, int fr, int fq) const {
        const int row0 = u.pm * 256 + wr * 64 + fr, col0 = u.pn * 128 + wc * 32 + 8 * fq;
#pragma unroll
        for (int ai = 0; ai < 2; ++ai)
#pragma unroll
            for (int m = 0; m < 4; ++m) {
                bf16* rowp = H + (size_t)(row0 + ai * 128 + m * 16) * ldh + col0;
                const u32x2 w0 = pk4(silu4_(acc[ai][0][m][0]) * acc[ai][1][m][0]), w1 = pk4(silu4_(acc[ai][0][m][1]) * acc[ai][1][m][1]);
                *(u32x4*)rowp = (u32x4){w0.x, w0.y, w1.x, w1.y};
            }
    }
};

struct EpiRes {
    static constexpr bool PERM = false, AFTER_DRAIN = false;
    const float* baseL; float* outL; const float* baseC; float* outC; const float* mod; int gidx; float coef;
    __device__ __forceinline__ void operator()(const f32x4 (&acc)[2][2][4][2], const pg8::Unit& u, int wr, int wc, int fr, int fq) const {
        const bool lat = u.pm < 128;
        const int prow = (lat ? u.pm : u.pm - 128) * 256 + wr * 64 + fr;
        const float* base = lat ? baseL : baseC; float* out = lat ? outL : outC;
        const float* gate = mod + (size_t)(lat ? (u.pm >> 4) : 8) * NMODC + gidx * D;
        const int col0 = u.pn * 256 + wc * 32 + 4 * fq;
        f32x4 gv[2][2];
#pragma unroll
        for (int bj = 0; bj < 2; ++bj)
#pragma unroll
            for (int n = 0; n < 2; ++n) gv[bj][n] = *(const f32x4*)(gate + col0 + bj * 128 + n * 16) * coef;
#pragma unroll
        for (int ai = 0; ai < 2; ++ai)
#pragma unroll
            for (int m = 0; m < 4; ++m) {
                const size_t off = (size_t)(prow + ai * 128 + m * 16) * D + col0;
#pragma unroll
                for (int bj = 0; bj < 2; ++bj)
#pragma unroll
                    for (int n = 0; n < 2; ++n) {
                        const f32x4 bs = *(const f32x4*)(base + off + bj * 128 + n * 16);
                        *(f32x4*)(out + off + bj * 128 + n * 16) = bs + gv[bj][n] * acc[ai][bj][m][n];
                    }
            }
    }
};


template <bool BASEB> struct EpiResB {
    static constexpr bool PERM = true, AFTER_DRAIN = false;
    const float* base; bf16* outb; const float* mod; int gidx; float coef;
    __device__ __forceinline__ void operator()(const f32x4 (&acc)[2][2][4][2], const pg8::Unit& u, int wr, int wc, int fr, int fq) const {
        const int row0 = u.pm * 256 + wr * 64 + fr, col0 = u.pn * 256 + wc * 32 + 8 * fq;
        const float* gate = mod + (size_t)(u.pm >> 4) * NMODC + gidx * D;
#pragma unroll
        for (int bj = 0; bj < 2; ++bj) {
            const f32x4 g0 = *(const f32x4*)(gate + col0 + bj * 128) * coef, g1 = *(const f32x4*)(gate + col0 + bj * 128 + 4) * coef;
#pragma unroll
            for (int ai = 0; ai < 2; ++ai)
#pragma unroll
                for (int m = 0; m < 4; ++m) {
                    const size_t off = (size_t)(row0 + ai * 128 + m * 16) * D + col0 + bj * 128;
                    f32x4 b0, b1;
                    if constexpr (BASEB) { const u32x4 t = *(const u32x4*)((const bf16*)base + off); b0 = (f32x4){bflo(t.x), bfhi(t.x), bflo(t.y), bfhi(t.y)}; b1 = (f32x4){bflo(t.z), bfhi(t.z), bflo(t.w), bfhi(t.w)}; }
                    else { b0 = *(const f32x4*)(base + off); b1 = *(const f32x4*)(base + off + 4); }
                    const u32x2 w0 = pk4(b0 + g0 * acc[ai][bj][m][0]), w1 = pk4(b1 + g1 * acc[ai][bj][m][1]);
                    *(u32x4*)(outb + off) = (u32x4){w0.x, w0.y, w1.x, w1.y};
                }
        }
    }
};

struct EpiDelta {
    static constexpr bool PERM = true, AFTER_DRAIN = false;
    bf16* delta; const float* mod; int gidx; float coef;
    __device__ __forceinline__ void operator()(const f32x4 (&acc)[2][2][4][2], const pg8::Unit& u, int wr, int wc, int fr, int fq) const {
        const int row0 = u.pm * 256 + wr * 64 + fr, col0 = u.pn * 256 + wc * 32 + 8 * fq;
        const float* gate = mod + (size_t)(u.pm >> 4) * NMODC + gidx * D;
#pragma unroll
        for (int bj = 0; bj < 2; ++bj) {
            const f32x4 g0 = *(const f32x4*)(gate + col0 + bj * 128) * coef, g1 = *(const f32x4*)(gate + col0 + bj * 128 + 4) * coef;
#pragma unroll
            for (int ai = 0; ai < 2; ++ai)
#pragma unroll
                for (int m = 0; m < 4; ++m) {
                    const u32x2 w0 = pk4(acc[ai][bj][m][0] * g0), w1 = pk4(acc[ai][bj][m][1] * g1);
                    *(u32x4*)(delta + (size_t)(row0 + ai * 128 + m * 16) * D + col0 + bj * 128) = (u32x4){w0.x, w0.y, w1.x, w1.y};
                }
        }
    }
};

struct EpiMix1 {
    static constexpr bool PERM = true, AFTER_DRAIN = false;
    bf16* Q; f16* GF; f16* GB; bf16* V; const float* lbf; const float* lbb;
    __device__ __forceinline__ void operator()(const f32x4 (&acc)[2][2][4][2], const pg8::Unit& u, int wr, int wc, int fr, int fq) const {
        const int seg = u.pn >> 2;
        const int row0 = u.pm * 256 + wr * 64 + fr, col0 = (u.pn & 3) * 256 + wc * 32 + 8 * fq;
        if (seg == 0) {
            if (u.pm >= 128) return;
#pragma unroll
            for (int ai = 0; ai < 2; ++ai)
#pragma unroll
                for (int m = 0; m < 4; ++m)
#pragma unroll
                    for (int bj = 0; bj < 2; ++bj) {
                        const f32x4 a = acc[ai][bj][m][0], b = acc[ai][bj][m][1];
                        const u32x2 w0 = pk4(silu4_(a)), w1 = pk4(silu4_(b)); const u32x4 w = (u32x4){w0.x, w0.y, w1.x, w1.y};
                        *(u32x4*)(Q + (size_t)(row0 + ai * 128 + m * 16) * D + col0 + bj * 128) = w;
                    }
        } else if (seg == 3) {
#pragma unroll
            for (int ai = 0; ai < 2; ++ai)
#pragma unroll
                for (int m = 0; m < 4; ++m)
#pragma unroll
                    for (int bj = 0; bj < 2; ++bj) {
                        const f32x4 a = acc[ai][bj][m][0], b = acc[ai][bj][m][1];
                        u32x4 w; w.x = pk2(a[0], a[1]); w.y = pk2(a[2], a[3]); w.z = pk2(b[0], b[1]); w.w = pk2(b[2], b[3]);
                        *(u32x4*)(V + (size_t)(row0 + ai * 128 + m * 16) * D + col0 + bj * 128) = w;
                    }
        } else {
            const float* lb = (seg == 1) ? lbf : lbb; f16* G = (seg == 1) ? GF : GB;
#pragma unroll
            for (int bj = 0; bj < 2; ++bj) {
                const f32x4 l0 = *(const f32x4*)(lb + col0 + bj * 128), l1 = *(const f32x4*)(lb + col0 + bj * 128 + 4);
#pragma unroll
                for (int ai = 0; ai < 2; ++ai)
#pragma unroll
                    for (int m = 0; m < 4; ++m) {
                        const f32x4 a = acc[ai][bj][m][0], b = acc[ai][bj][m][1];
                        f16x8 w;
                        const f32x4 fa = l0 + (1.0f - l0) * sig4_(a), fb = l1 + (1.0f - l1) * sig4_(b);
#pragma unroll
                        for (int j = 0; j < 4; ++j) { w[j] = (f16)__builtin_amdgcn_logf(fa[j]); w[4 + j] = (f16)__builtin_amdgcn_logf(fb[j]); }
                        *(f16x8*)(G + (size_t)(row0 + ai * 128 + m * 16) * D + col0 + bj * 128) = w;
                    }
            }
        }
    }
};

struct EpiMix2 {
    static constexpr bool PERM = true, AFTER_DRAIN = false;
    bf16* SG; bf16* GLU; bf16* GATES; const float* bgate;
    __device__ __forceinline__ void operator()(const f32x4 (&acc)[2][2][4][2], const pg8::Unit& u, int wr, int wc, int fr, int fq) const {
        const int row0 = u.pm * 256 + wr * 64 + fr, cw = wc * 32 + 8 * fq;
        if (u.pn < 4) {
#pragma unroll
            for (int ai = 0; ai < 2; ++ai)
#pragma unroll
                for (int m = 0; m < 4; ++m)
#pragma unroll
                    for (int bj = 0; bj < 2; ++bj) {
                        const f32x4 a = acc[ai][bj][m][0], b = acc[ai][bj][m][1];
                        const u32x2 w0 = pk4(silu4_(a)), w1 = pk4(silu4_(b)); const u32x4 w = (u32x4){w0.x, w0.y, w1.x, w1.y};
                        *(u32x4*)(SG + (size_t)(row0 + ai * 128 + m * 16) * D + u.pn * 256 + bj * 128 + cw) = w;
                    }
        } else if (u.pn < 12) {
            const int c0 = (u.pn - 4) * 128 + cw;
#pragma unroll
            for (int ai = 0; ai < 2; ++ai)
#pragma unroll
                for (int m = 0; m < 4; ++m) {
                    const u32x2 w0 = pk4(acc[ai][0][m][0] * sig4_(acc[ai][1][m][0])), w1 = pk4(acc[ai][0][m][1] * sig4_(acc[ai][1][m][1])); const u32x4 w = (u32x4){w0.x, w0.y, w1.x, w1.y};
                    *(u32x4*)(GLU + (size_t)(row0 + ai * 128 + m * 16) * D + c0) = w;
                }
        } else {
            const int c0 = (u.pn - 12) * 256 + cw;
#pragma unroll
            for (int bj = 0; bj < 2; ++bj) {
                const f32x4 b0 = *(const f32x4*)(bgate + c0 + bj * 128), b1 = *(const f32x4*)(bgate + c0 + bj * 128 + 4);
#pragma unroll
                for (int ai = 0; ai < 2; ++ai)
#pragma unroll
                    for (int m = 0; m < 4; ++m) {
                        const f32x4 a = acc[ai][bj][m][0] + b0, b = acc[ai][bj][m][1] + b1;
                        const u32x2 w0 = pk4(sig4_(a)), w1 = pk4(sig4_(b)); const u32x4 w = (u32x4){w0.x, w0.y, w1.x, w1.y};
                        *(u32x4*)(GATES + (size_t)(row0 + ai * 128 + m * 16) * 2048 + c0 + bj * 128) = w;
                    }
            }
        }
    }
};

template <int ADD> struct EpiGate {
    static constexpr bool PERM = true, AFTER_DRAIN = false;
    const bf16* GATES; bf16* T; int goff;
    __device__ __forceinline__ void operator()(const f32x4 (&acc)[2][2][4][2], const pg8::Unit& u, int wr, int wc, int fr, int fq) const {
        const int row0 = u.pm * 256 + wr * 64 + fr, col0 = u.pn * 256 + wc * 32 + 8 * fq;
#pragma unroll
        for (int ai = 0; ai < 2; ++ai)
#pragma unroll
            for (int m = 0; m < 4; ++m)
#pragma unroll
                for (int bj = 0; bj < 2; ++bj) {
                    const size_t r = (size_t)(row0 + ai * 128 + m * 16);
                    const u32x4 g = *(const u32x4*)(GATES + r * 2048 + goff + col0 + bj * 128);
                    bf16* tp = T + r * D + col0 + bj * 128;
                    const f32x4 a = acc[ai][bj][m][0], b = acc[ai][bj][m][1];
                    float o[8];
                    o[0] = bflo(g.x) * a[0]; o[1] = bfhi(g.x) * a[1]; o[2] = bflo(g.y) * a[2]; o[3] = bfhi(g.y) * a[3];
                    o[4] = bflo(g.z) * b[0]; o[5] = bfhi(g.z) * b[1]; o[6] = bflo(g.w) * b[2]; o[7] = bfhi(g.w) * b[3];
                    if (ADD) { const u32x4 t = *(const u32x4*)tp;
                        o[0] += bflo(t.x); o[1] += bfhi(t.x); o[2] += bflo(t.y); o[3] += bfhi(t.y); o[4] += bflo(t.z); o[5] += bfhi(t.z); o[6] += bflo(t.w); o[7] += bfhi(t.w); }
                    u32x4 w; w.x = pk2(o[0], o[1]); w.y = pk2(o[2], o[3]); w.z = pk2(o[4], o[5]); w.w = pk2(o[6], o[7]);
                    *(u32x4*)tp = w;
                }
    }
};


struct KSplitOrder {
    int G, c;
    __device__ bool next(int i, pg8::Unit& u) const { const int L = i * G + c; if (L >= 352) return false; u.pk = L >> 5; u.pm = 128 + ((L & 31) >> 2); u.pn = L & 3; return true; }
    __device__ __forceinline__ void a_ready(const pg8::Unit&) const {}
    __device__ __forceinline__ void done(const pg8::Unit&) const {}
};
struct EpiPart {
    static constexpr bool PERM = false, AFTER_DRAIN = false;
    bf16* part;
    __device__ __forceinline__ void operator()(const f32x4 (&acc)[2][2][4][2], const pg8::Unit& u, int wr, int wc, int fr, int fq) const {
        const int prow = (u.pm - 128) * 256 + wr * 64 + fr, col0 = u.pn * 256 + wc * 32 + 4 * fq;
        bf16* base = part + ((size_t)u.pk * MC + prow) * D + col0;
#pragma unroll
        for (int ai = 0; ai < 2; ++ai)
#pragma unroll
            for (int m = 0; m < 4; ++m)
#pragma unroll
                for (int bj = 0; bj < 2; ++bj)
#pragma unroll
                    for (int n = 0; n < 2; ++n) *(u32x2*)(base + (size_t)(ai * 128 + m * 16) * D + bj * 128 + n * 16) = pk4(acc[ai][bj][m][n]);
    }
};

__device__ __forceinline__ void conv_tile(LAS unsigned char* lds, const float* src, int srcN, int k0, int n0, bf16* dst, int dstK, int drow0) {
    LAS float* T = (LAS float*)lds;
    const int tid = tid_opaque();
#pragma unroll
    for (int i = 0; i < 4; ++i) {
        const int kk = (tid >> 5) + 16 * i, n4 = tid & 31;
        const f32x4 v = *(const f32x4*)(src + (size_t)(k0 + kk) * srcN + n0 + 4 * n4);
#pragma unroll
        for (int j = 0; j < 4; ++j) T[kk * 129 + 4 * n4 + j] = v[j];
    }
    __syncthreads();
    {
        const int nn = tid >> 2, kq = tid & 3;
        float f[16];
#pragma unroll
        for (int j = 0; j < 16; ++j) f[j] = T[(16 * kq + j) * 129 + nn];
        u32x4 w0, w1;
        w0.x = pk2(f[0], f[1]); w0.y = pk2(f[2], f[3]); w0.z = pk2(f[4], f[5]); w0.w = pk2(f[6], f[7]);
        w1.x = pk2(f[8], f[9]); w1.y = pk2(f[10], f[11]); w1.z = pk2(f[12], f[13]); w1.w = pk2(f[14], f[15]);
        bf16* dp = dst + (size_t)(drow0 + nn) * dstK + k0 + 16 * kq;
        *(u32x4*)dp = w0; *(u32x4*)(dp + 8) = w1;
    }
    __syncthreads();
}
__device__ __forceinline__ void conv_job_item(LAS unsigned char* lds, int it, const float* src, int K, int N, bf16* dst, int roff, int pair_from, int NH) {
    const int nt = N / 128; const int kt = it / nt, ntile = it % nt; const int n0 = ntile * 128;
    int drow0;
    if (pair_from < 0 || n0 < pair_from) drow0 = roff + n0;
    else { const int n1 = n0 - pair_from; drow0 = roff + pair_from + ((n1 < NH) ? 256 * (n1 / 128) : 256 * ((n1 - NH) / 128) + 128); }
    conv_tile(lds, src, N, kt * 64, n0, dst, K, drow0);
}

template <bool MODU, bool OUT_BF16, bool CPART = false, bool ADDD = false, bool SRCB = false>
__device__ __forceinline__ void normmod_phase(const float* srcL, const float* srcC, int nrows, const float* gain, const float* mod, int ishift, int iscale, bf16* ub, float* of, const bf16* part = nullptr, int igate = 0, const bf16* dlt = nullptr) {
    const int tido = tid_opaque(); const int lane = tido & 63, wv = tido >> 6;
    f32x4 gn[4];
#pragma unroll
    for (int j = 0; j < 4; ++j) gn[j] = *(const f32x4*)(gain + 256 * j + 4 * lane);
    for (int row = blockIdx.x * 8 + wv; row < nrows; row += gridDim.x * 8) {
        const float* src = (row < ML) ? srcL + (size_t)row * D : srcC + (size_t)(row - ML) * D;
        f32x4 x[4]; float ss = 0.f;
#pragma unroll
        for (int j = 0; j < 4; ++j) {
            if (SRCB && row < ML) { const u32x2 t = *(const u32x2*)((const bf16*)srcL + (size_t)row * D + 256 * j + 4 * lane); x[j] = (f32x4){bflo(t.x), bfhi(t.x), bflo(t.y), bfhi(t.y)}; }
            else x[j] = *(const f32x4*)(src + 256 * j + 4 * lane);
            if constexpr (ADDD) { const u32x2 t = *(const u32x2*)(dlt + (size_t)row * D + 256 * j + 4 * lane); x[j] += (f32x4){bflo(t.x), bfhi(t.x), bflo(t.y), bfhi(t.y)}; }
            if constexpr (CPART) { if (row >= ML) {
                f32x4 sp = (f32x4){0.f, 0.f, 0.f, 0.f};
#pragma unroll
                for (int pk = 0; pk < 11; ++pk) { const u32x2 t = *(const u32x2*)(part + ((size_t)pk * MC + (row - ML)) * D + 256 * j + 4 * lane); sp += (f32x4){bflo(t.x), bfhi(t.x), bflo(t.y), bfhi(t.y)}; }
                x[j] += sp * (*(const f32x4*)(mod + (size_t)8 * NMODC + igate * D + 256 * j + 4 * lane) * 0.5f); } }
            ss += x[j][0] * x[j][0] + x[j][1] * x[j][1] + x[j][2] * x[j][2] + x[j][3] * x[j][3]; }
#pragma unroll
        for (int o = 32; o >= 1; o >>= 1) ss += __shfl_xor(ss, o);
        const float rinv = rsqrtf(ss * (1.0f / D) + EPS);
        const int mrow = (row < ML) ? (row >> 12) : 8;
#pragma unroll
        for (int j = 0; j < 4; ++j) {
            f32x4 y = x[j] * rinv * gn[j];
            if constexpr (MODU) { const f32x4 sh = *(const f32x4*)(mod + (size_t)mrow * NMODC + ishift * D + 256 * j + 4 * lane), sc = *(const f32x4*)(mod + (size_t)mrow * NMODC + iscale * D + 256 * j + 4 * lane);
                y = y * (sc + 1.0f) + sh; }
            if constexpr (OUT_BF16) { u32x2 w; w.x = pk2(y[0], y[1]); w.y = pk2(y[2], y[3]); *(u32x2*)(ub + (size_t)row * D + 256 * j + 4 * lane) = w; }
            else *(f32x4*)(of + (size_t)row * D + 256 * j + 4 * lane) = y;
        }
    }
}

__device__ __forceinline__ void adaln_item(LAS unsigned char* lds, int item, const float* wada, const float* bada, float* MOD) {
    LAS float* SC = (LAS float*)lds;
    LAS float* RED = (LAS float*)(lds + 36864);
    const int tid = threadIdx.x, col = tid & 63, kg = tid >> 6, n0 = item * 64;
    float acc[9];
#pragma unroll
    for (int r = 0; r < 9; ++r) acc[r] = 0.f;
    for (int k = kg * 128; k < kg * 128 + 128; ++k) {
        const float w = wada[(size_t)k * NMODC + n0 + col];
#pragma unroll
        for (int r = 0; r < 9; ++r) acc[r] += SC[r * 1024 + k] * w;
    }
#pragma unroll
    for (int r = 0; r < 9; ++r) RED[(kg * 9 + r) * 64 + col] = acc[r];
    __syncthreads();
    for (int idx = tid; idx < 576; idx += 512) {
        const int r = idx >> 6, c = idx & 63; float s = bada[n0 + c];
#pragma unroll
        for (int g = 0; g < 8; ++g) s += RED[(g * 9 + r) * 64 + c];
        MOD[(size_t)r * NMODC + n0 + c] = s;
    }
    __syncthreads();
}

__device__ __forceinline__ void aop_rows(int row_begin, int row_end, int row_step, bf16* OF, const bf16* OB, const bf16* SG, const float* hgn) {
    const int lane = tid_opaque() & 63;
    float gn[16];
#pragma unroll
    for (int j = 0; j < 4; ++j) { const f32x4 t = *(const f32x4*)(hgn + (lane & 7) * 16 + 4 * j); gn[4 * j] = t[0]; gn[4 * j + 1] = t[1]; gn[4 * j + 2] = t[2]; gn[4 * j + 3] = t[3]; }
    for (int row = row_begin; row < row_end; row += row_step) {
        const size_t off = (size_t)row * D + 16 * lane;
        const u32x4 f0 = *(const u32x4*)(OF + off), f1 = *(const u32x4*)(OF + off + 8);
        const u32x4 b0 = *(const u32x4*)(OB + off), b1 = *(const u32x4*)(OB + off + 8);
        const u32x4 s0 = *(const u32x4*)(SG + off), s1 = *(const u32x4*)(SG + off + 8);
        float o[16], sg[16];
#pragma unroll
        for (int j = 0; j < 4; ++j) {
            o[2 * j] = bflo(f0[j]) + bflo(b0[j]); o[2 * j + 1] = bfhi(f0[j]) + bfhi(b0[j]);
            o[8 + 2 * j] = bflo(f1[j]) + bflo(b1[j]); o[8 + 2 * j + 1] = bfhi(f1[j]) + bfhi(b1[j]);
            sg[2 * j] = bflo(s0[j]); sg[2 * j + 1] = bfhi(s0[j]); sg[8 + 2 * j] = bflo(s1[j]); sg[8 + 2 * j + 1] = bfhi(s1[j]);
        }
        float ss = 0.f;
#pragma unroll
        for (int j = 0; j < 16; ++j) ss += o[j] * o[j];
        ss += __shfl_xor(ss, 1); ss += __shfl_xor(ss, 2); ss += __shfl_xor(ss, 4);
        const float rinv = rsqrtf(ss * (1.0f / 128.0f) + EPS);
        float a[16];
#pragma unroll
        for (int j = 0; j < 16; ++j) a[j] = o[j] * rinv * gn[j] * sg[j];
        u32x4 w0, w1;
        w0.x = pk2(a[0], a[1]); w0.y = pk2(a[2], a[3]); w0.z = pk2(a[4], a[5]); w0.w = pk2(a[6], a[7]);
        w1.x = pk2(a[8], a[9]); w1.y = pk2(a[10], a[11]); w1.z = pk2(a[12], a[13]); w1.w = pk2(a[14], a[15]);
        *(u32x4*)(OF + off) = w0; *(u32x4*)(OF + off + 8) = w1;
    }
}

__device__ __forceinline__ void conv_items(LAS unsigned char* lds, int item_begin, int item_end, int item_step, const bf16* GLU, const float* wdw, const float* bdw, const float* lng, const float* lnb, bf16* BOP) {
    constexpr int TT = 16;
    LAS float* P1 = (LAS float*)lds;
    LAS float* P2 = (LAS float*)(lds + 65536);
    LAS float* ST = (LAS float*)(lds + 131072);
    const int tid = tid_opaque(), c = 2 * tid;
    f32x2 w2[31];
#pragma unroll
    for (int j = 0; j < 31; ++j) w2[j] = *(const f32x2*)(wdw + j * D + c);
    const f32x2 bd = *(const f32x2*)(bdw + c), g2 = *(const f32x2*)(lng + c), b2 = *(const f32x2*)(lnb + c);
    unsigned xw[TT + 30];
#define CONV_ISSUE(item_) do { const int b_ = (item_) / (SEQ / TT), t0_ = ((item_) % (SEQ / TT)) * TT; _Pragma("unroll") for (int r = 0; r < TT + 30; ++r) { \
        const int pos = t0_ - 15 + r; xw[r] = 0u; if (pos >= 0 && pos < SEQ) xw[r] = *(const unsigned*)(GLU + (size_t)(b_ * SEQ + pos) * D + c); } } while (0)
    if (item_begin < item_end) CONV_ISSUE(item_begin);
    for (int item = item_begin; item < item_end; item += item_step) {
        const int b = item / (SEQ / TT), t0 = (item % (SEQ / TT)) * TT;
        f32x2 xf[TT + 30];
#pragma unroll
        for (int r = 0; r < TT + 30; ++r) { xf[r].x = bflo(xw[r]); xf[r].y = bfhi(xw[r]); }
        if (item + item_step < item_end) CONV_ISSUE(item + item_step);
        f32x2 y[TT];
#pragma unroll
        for (int t = 0; t < TT; ++t) {
            f32x2 a2 = bd;
#pragma unroll
            for (int j = 0; j < 31; ++j) a2 = __builtin_elementwise_fma(xf[t + j], w2[j], a2);
            y[t] = a2;
        }
#pragma unroll
        for (int t = 0; t < TT; ++t) { const f32x2 q = y[t] * y[t]; P1[t * 512 + tid] = y[t].x + y[t].y; P2[t * 512 + tid] = q.x + q.y; }
        __syncthreads();
        {
            const int t = tid >> 5, part = tid & 31; float sm = 0.f, q = 0.f;
#pragma unroll
            for (int j = 0; j < 4; ++j) { const f32x4 a = *(const LAS f32x4*)(P1 + t * 512 + part * 16 + 4 * j), bq = *(const LAS f32x4*)(P2 + t * 512 + part * 16 + 4 * j);
                sm += (a[0] + a[1]) + (a[2] + a[3]); q += (bq[0] + bq[1]) + (bq[2] + bq[3]); }
#pragma unroll
            for (int o = 16; o >= 1; o >>= 1) { sm += __shfl_xor(sm, o); q += __shfl_xor(q, o); }
            if (part == 0) { const float mean = sm * (1.0f / D); const float var = fmaxf(q * (1.0f / D) - mean * mean, 0.f); ST[2 * t] = mean; ST[2 * t + 1] = rsqrtf(var + EPS); }
        }
        __syncthreads();
#pragma unroll
        for (int t = 0; t < TT; ++t) {
            const float mean = ST[2 * t], rstd = ST[2 * t + 1];
            const f32x2 v = (y[t] - mean) * (g2 * rstd) + b2;
            const f32x2 o = v * sig2_(v);
            *(unsigned*)(BOP + (size_t)(b * SEQ + t0 + t) * D + c) = pk2(o.x, o.y);
        }
        __syncthreads();
    }
#undef CONV_ISSUE
}

__device__ __forceinline__ size_t scan_rowbase(int ci, int t, int dir, int b) {
    const bool ctx = ci < 8; const int lc = ctx ? ci : ci - 8, nch = ctx ? 8 : 128;
    const int p0 = dir ? (nch - 1 - lc) * 32 : lc * 32; const int pos = dir ? p0 + 31 - t : p0 + t;
    return ctx ? (size_t)(ML + b * CTXL + pos) : (size_t)(b * SEQ + pos);
}
constexpr int S2_QS = 0, S2_KS = 26112, S2_KET = 43520, S2_VT = 74240, S2_DEC = 89600, S2_AS = 91136, S2_ST = 96256;
constexpr int QROW = 272, SROW = 80;
struct ScanRegs { u32x4 q, g, v; };
struct ScanCtx { const bf16* Q; const f16* G; const bf16* V; bf16* O; int b, h, dvh, dir, w, lane, l15, q4, tau, cg; };

__device__ __forceinline__ void scan_issue(const ScanCtx& c, int ci, ScanRegs& r) {
    const size_t row = scan_rowbase(ci, c.tau, c.dir, c.b);
    const size_t qrow = (ci >= 8) ? row : (size_t)(c.b * SEQ + c.tau);
    const int d0 = 16 * c.w + 8 * c.cg;
    r.g = *(const u32x4*)(c.G + row * D + c.h * 128 + d0);
    r.q = *(const u32x4*)(c.Q + qrow * D + c.h * 128 + d0);
    r.v = *(const u32x4*)(c.V + row * D + c.h * 128 + c.dvh * 64 + 8 * c.w);
}
template <int CTRL, int ROWMASK> __device__ __forceinline__ float dpp_mul_(float x) {
    const int y = __builtin_amdgcn_update_dpp(0x3f800000, __float_as_int(x), CTRL, ROWMASK, 0xF, false);
    return x * __int_as_float(y);
}
__device__ __forceinline__ void scan_E(LAS unsigned char* lds, const ScanCtx& c, int ci, const ScanRegs& r) {
    const bool lat = ci >= 8; const int s3 = ci % 3, s2 = ci & 1; const int tau = c.tau, d0 = 16 * c.w + 8 * c.cg;
    float f[8], P[8];
    { const f16x8 gh = __builtin_bit_cast(f16x8, r.g);
#pragma unroll
      for (int j = 0; j < 8; ++j) { P[j] = __builtin_amdgcn_exp2f((float)gh[j]); f[j] = 1.0f - P[j]; } }
#define DPP8(ctrl) "v_mul_f32_dpp %0, %0, %0 " ctrl "\n\tv_mul_f32_dpp %1, %1, %1 " ctrl "\n\tv_mul_f32_dpp %2, %2, %2 " ctrl "\n\tv_mul_f32_dpp %3, %3, %3 " ctrl "\n\t" \
                   "v_mul_f32_dpp %4, %4, %4 " ctrl "\n\tv_mul_f32_dpp %5, %5, %5 " ctrl "\n\tv_mul_f32_dpp %6, %6, %6 " ctrl "\n\tv_mul_f32_dpp %7, %7, %7 " ctrl "\n\t"
    asm volatile("s_nop 1\n\t"
                 DPP8("row_shr:1 row_mask:0xf bank_mask:0xf") DPP8("row_shr:2 row_mask:0xf bank_mask:0xf") DPP8("row_shr:4 row_mask:0xf bank_mask:0xf")
                 DPP8("row_shr:8 row_mask:0xf bank_mask:0xf") DPP8("row_bcast:15 row_mask:0xa bank_mask:0xf") "s_nop 1"
                 : "+v"(P[0]), "+v"(P[1]), "+v"(P[2]), "+v"(P[3]), "+v"(P[4]), "+v"(P[5]), "+v"(P[6]), "+v"(P[7]));
#undef DPP8
    float kt[8], qg[8];
    const unsigned qw[4] = {r.q.x, r.q.y, r.q.z, r.q.w};
#pragma unroll
    for (int j = 0; j < 8; ++j) {
        const float k = f[j];
        float pc; asm("v_max_f32 %0, %1, %2" : "=v"(pc) : "v"(P[j]), "v"(1e-30f));
        kt[j] = k * __builtin_amdgcn_rcpf(pc);
        const float qv = (j & 1) ? bfhi(qw[j >> 1]) : bflo(qw[j >> 1]);
        qg[j] = qv * P[j];
    }
    u32x4 wk; wk.x = pk2(kt[0], kt[1]); wk.y = pk2(kt[2], kt[3]); wk.z = pk2(kt[4], kt[5]); wk.w = pk2(kt[6], kt[7]);
    *(LAS u32x4*)(lds + S2_KS + s2 * 8704 + tau * QROW + d0 * 2) = wk;
    if (lat) { u32x4 wq; wq.x = pk2(qg[0], qg[1]); wq.y = pk2(qg[2], qg[3]); wq.z = pk2(qg[4], qg[5]); wq.w = pk2(qg[6], qg[7]);
        *(LAS u32x4*)(lds + S2_QS + s3 * 8704 + tau * QROW + d0 * 2) = wq; }
    { const unsigned kw[4] = {wk.x, wk.y, wk.z, wk.w};
#pragma unroll
      for (int j = 0; j < 4; ++j) {
        *(LAS unsigned short*)(lds + S2_KET + s3 * 10240 + (d0 + 2 * j) * SROW + tau * 2) = (unsigned short)(kw[j] & 0xffffu);
        *(LAS unsigned short*)(lds + S2_KET + s3 * 10240 + (d0 + 2 * j + 1) * SROW + tau * 2) = (unsigned short)(kw[j] >> 16); } }
    if (tau == 31) { LAS float* DC = (LAS float*)(lds + S2_DEC + s3 * 512);
        *(LAS f32x4*)(DC + d0) = (f32x4){P[0], P[1], P[2], P[3]};
        *(LAS f32x4*)(DC + d0 + 4) = (f32x4){P[4], P[5], P[6], P[7]}; }
    if (c.lane < 32) { const unsigned vw[4] = {r.v.x, r.v.y, r.v.z, r.v.w};
#pragma unroll
        for (int j = 0; j < 4; ++j) {
            *(LAS unsigned short*)(lds + S2_VT + s3 * 5120 + (8 * c.w + 2 * j) * SROW + tau * 2) = (unsigned short)(vw[j] & 0xffffu);
            *(LAS unsigned short*)(lds + S2_VT + s3 * 5120 + (8 * c.w + 2 * j + 1) * SROW + tau * 2) = (unsigned short)(vw[j] >> 16); } }
}
__device__ __forceinline__ void scan_A(LAS unsigned char* lds, const ScanCtx& c, int ci) {
    if (c.w >= 3) return;
    const int s3 = ci % 3, s2 = ci & 1; const int l15 = c.l15, q4 = c.q4;
    const LAS unsigned char* QS = lds + S2_QS + s3 * 8704; const LAS unsigned char* KS = lds + S2_KS + s2 * 8704;
    const int ti = (c.w == 0) ? 0 : 1, sj = (c.w == 2) ? 1 : 0;
    f32x4 a4 = (f32x4){0.f, 0.f, 0.f, 0.f};
#pragma unroll
    for (int kk = 0; kk < 4; ++kk) {
        const bf16x8 xa = *(const LAS bf16x8*)(KS + (sj * 16 + l15) * QROW + kk * 64 + q4 * 16);
        const bf16x8 yb = *(const LAS bf16x8*)(QS + (ti * 16 + l15) * QROW + kk * 64 + q4 * 16);
        a4 = __builtin_amdgcn_mfma_f32_16x16x32_bf16(xa, yb, a4, 0, 0, 0);
    }
    const int t = ti * 16 + l15, s0 = sj * 16 + 4 * q4;
    const float m0 = (s0 <= t) ? a4[0] : 0.f, m1 = (s0 + 1 <= t) ? a4[1] : 0.f, m2 = (s0 + 2 <= t) ? a4[2] : 0.f, m3 = (s0 + 3 <= t) ? a4[3] : 0.f;
    u32x2 wa; wa.x = pk2(m0, m1); wa.y = pk2(m2, m3);
    *(LAS u32x2*)(lds + S2_AS + s2 * 2560 + t * SROW + s0 * 2) = wa;
}
__device__ __forceinline__ void scan_M(LAS unsigned char* lds, const ScanCtx& c, int ci, f32x4 (&accS)[4]) {
    const bool lat = ci >= 8; const int s3 = ci % 3, s2 = ci & 1; const int l15 = c.l15, q4 = c.q4, w = c.w;
    const LAS unsigned char* QS = lds + S2_QS + s3 * 8704; const LAS unsigned char* KET = lds + S2_KET + s3 * 10240; const LAS unsigned char* VT = lds + S2_VT + s3 * 5120;
    const LAS unsigned char* STr = lds + S2_ST + s2 * 17408; LAS unsigned char* STw = lds + S2_ST + (s2 ^ 1) * 17408;
    const int tt = w >> 2, et = w & 3;
    if (lat) {
        f32x4 acco = (f32x4){0.f, 0.f, 0.f, 0.f};
#pragma unroll
        for (int kk = 0; kk < 4; ++kk) {
            const bf16x8 xa = *(const LAS bf16x8*)(STr + (et * 16 + l15) * QROW + kk * 64 + q4 * 16);
            const bf16x8 yb = *(const LAS bf16x8*)(QS + (tt * 16 + l15) * QROW + kk * 64 + q4 * 16);
            acco = __builtin_amdgcn_mfma_f32_16x16x32_bf16(xa, yb, acco, 0, 0, 0);
        }
        {
            const bf16x8 xa = *(const LAS bf16x8*)(VT + (et * 16 + l15) * SROW + q4 * 16);
            const bf16x8 yb = *(const LAS bf16x8*)(lds + S2_AS + s2 * 2560 + (tt * 16 + l15) * SROW + q4 * 16);
            acco = __builtin_amdgcn_mfma_f32_16x16x32_bf16(xa, yb, acco, 0, 0, 0);
        }
        const size_t r = scan_rowbase(ci, tt * 16 + l15, c.dir, c.b);
        u32x2 wo; wo.x = pk2(acco[0], acco[1]); wo.y = pk2(acco[2], acco[3]);
        { bf16* op = c.O + r * D + c.h * 128 + c.dvh * 64 + et * 16 + 4 * q4;
          asm volatile("global_store_dwordx2 %0, %1, off" :: "v"(op), "v"(wo) : "memory"); }
    }
    {
        const f32x4 dc = *(const LAS f32x4*)(lds + S2_DEC + s3 * 512 + (16 * w + 4 * q4) * 4);
        const bf16x8 xa = *(const LAS bf16x8*)(KET + (16 * w + l15) * SROW + q4 * 16);
#pragma unroll
        for (int i = 0; i < 4; ++i) {
            const bf16x8 yb = *(const LAS bf16x8*)(VT + (16 * i + l15) * SROW + q4 * 16);
            accS[i] = __builtin_amdgcn_mfma_f32_16x16x32_bf16(xa, yb, accS[i], 0, 0, 0) * dc;
        }
#pragma unroll
        for (int i = 0; i < 4; ++i) {
            u32x2 ws_; ws_.x = pk2(accS[i][0], accS[i][1]); ws_.y = pk2(accS[i][2], accS[i][3]);
            *(LAS u32x2*)(STw + (16 * i + l15) * QROW + (16 * w + 4 * q4) * 2) = ws_;
        }
    }
}
__device__ __forceinline__ void scan_item(LAS unsigned char* lds, int item, const bf16* Q, const f16* GF, const f16* GB, const bf16* V, bf16* OF, bf16* OB) {
    const int tid = tid_opaque(), lane = tid & 63;
    ScanCtx c;
    c.dvh = item & 1; c.dir = (item >> 1) & 1; c.h = (item >> 2) & 7; c.b = item >> 5;
    c.Q = Q; c.G = c.dir ? GB : GF; c.V = V; c.O = c.dir ? OB : OF;
    c.w = __builtin_amdgcn_readfirstlane(tid >> 6); c.lane = lane; c.l15 = lane & 15; c.q4 = lane >> 4; c.tau = lane & 31; c.cg = lane >> 5;
    for (int i = tid; i < (5120 + 34816) / 4; i += 512) ((LAS unsigned*)(lds + S2_AS))[i] = 0u;
    f32x4 accS[4];
#pragma unroll
    for (int i = 0; i < 4; ++i) accS[i] = (f32x4){0.f, 0.f, 0.f, 0.f};
    ScanRegs r0, r1, r2, r3;
    r0.q = r1.q = r2.q = r3.q = (u32x4){0u, 0u, 0u, 0u}; r0.v = r1.v = r2.v = r3.v = (u32x4){0u, 0u, 0u, 0u};
    scan_issue(c, 0, r0); scan_issue(c, 1, r1); scan_issue(c, 2, r2); scan_issue(c, 3, r3);
    __syncthreads();
#define SCAN_STEP(T_, R_) do { const int T = (T_); \
        __builtin_amdgcn_s_setprio(2); if (T >= 2) scan_M(lds, c, T - 2, accS); __builtin_amdgcn_s_setprio(0); \
        if (T >= 9) scan_A(lds, c, T - 1); \
        scan_E(lds, c, T, R_); { const int nx = (T + 4 < 136) ? T + 4 : 135; scan_issue(c, nx, R_); } \
        __syncthreads(); } while (0)
    for (int T0 = 0; T0 < 136; T0 += 4) { SCAN_STEP(T0, r0); SCAN_STEP(T0 + 1, r1); SCAN_STEP(T0 + 2, r2); SCAN_STEP(T0 + 3, r3); }
    scan_M(lds, c, 134, accS); scan_A(lds, c, 135); __syncthreads();
    scan_M(lds, c, 135, accS); __syncthreads();
    asm volatile("s_waitcnt vmcnt(0)" ::: "memory");
#undef SCAN_STEP
}

#define XB_TMO      128
#define XB_XCNT(j)  (256  + 64 * (j))
#define XB_XSUB(j)  (1280 + 64 * (j))
#define XB_XGEN(j)  (2304 + 64 * (j))
#define XB_TOP      3328
#define XB_TOPGEN   3392
#define XCD_BAR_WORDS 3456
#define XB_SPIN_CAP (1u << 18)

__device__ __forceinline__ unsigned xb_ld(unsigned* p)              { return __hip_atomic_load(p, __ATOMIC_RELAXED, __HIP_MEMORY_SCOPE_AGENT); }
__device__ __forceinline__ unsigned xb_add(unsigned* p, unsigned v) { return __hip_atomic_fetch_add(p, v, __ATOMIC_RELAXED, __HIP_MEMORY_SCOPE_AGENT); }
__device__ __forceinline__ unsigned xb_xcc_id() { return (unsigned)__builtin_amdgcn_s_getreg((3 << 11) | 20) & 0xFu; }
#define XB_SPIN(cond, bar) do { unsigned _sp = 0; while (cond) { __builtin_amdgcn_s_sleep(1); \
    if ((++_sp & 255u) == 0u) { if (xb_ld(&(bar)[XB_TMO])) break; if (_sp > XB_SPIN_CAP) { atomicAdd(&(bar)[XB_TMO], 1u); break; } } } } while (0)

struct XcdBarrier {
    unsigned* bar; unsigned x;
    volatile LAS unsigned* st;
};

__device__ __forceinline__ XcdBarrier xcd_barrier_post(unsigned* bar, volatile LAS unsigned* st) {
    XcdBarrier b; b.bar = bar; b.x = xb_xcc_id(); b.st = st;
    if (threadIdx.x == 0) (void)xb_add(&bar[XB_XCNT(b.x)], 1u);
    return b;
}
__device__ __forceinline__ void xcd_barrier_complete(unsigned* bar, unsigned x, unsigned& nloc, unsigned& nx) {
    const unsigned G = gridDim.x * gridDim.y * gridDim.z;
    unsigned sum, cnt, mine, sp = 0u;
    for (;;) {
        sum = 0u; cnt = 0u; mine = 0u;
#pragma unroll
        for (unsigned j = 0; j < 16; ++j) { const unsigned c = xb_ld(&bar[XB_XCNT(j)]); sum += c; cnt += (c > 0u) ? 1u : 0u; mine = (j == x) ? c : mine; }
        if (sum == G) break;
        __builtin_amdgcn_s_sleep(1);
        if ((++sp & 255u) == 0u) { if (xb_ld(&bar[XB_TMO])) break; if (sp > XB_SPIN_CAP) { atomicAdd(&bar[XB_TMO], 1u); break; } }
    }
    nloc = mine > 0u ? mine : 1u; nx = cnt > 0u ? cnt : 1u;
}

__device__ __forceinline__ void xcd_barrier(const XcdBarrier& b) {
    asm volatile("s_waitcnt vmcnt(0)" ::: "memory");
    __syncthreads();
    if (threadIdx.x == 0) {
        unsigned* bar = b.bar;
        __builtin_amdgcn_s_waitcnt(0);
        unsigned nloc = b.st[0], nx = b.st[1];
        if (nloc == 0u) { xcd_barrier_complete(bar, b.x, nloc, nx); b.st[0] = nloc; b.st[1] = nx; }
        const unsigned old = xb_add(&bar[XB_XSUB(b.x)], 1u);
        const unsigned gen = old / nloc;
        if (old + 1u == (gen + 1u) * nloc) {
            __builtin_amdgcn_fence(__ATOMIC_RELEASE, "agent");
            asm volatile("s_waitcnt vmcnt(0)" ::: "memory");
            const unsigned og = xb_add(&bar[XB_TOP], 1u);
            const unsigned tg = og / nx;
            if (og + 1u == (tg + 1u) * nx) xb_add(&bar[XB_TOPGEN], 1u);
            else XB_SPIN(xb_ld(&bar[XB_TOPGEN]) == tg, bar);
            __builtin_amdgcn_fence(__ATOMIC_ACQUIRE, "agent");
            xb_add(&bar[XB_XGEN(b.x)], 1u);
            asm volatile("s_waitcnt vmcnt(0)" ::: "memory");
        } else {
            XB_SPIN(xb_ld(&bar[XB_XGEN(b.x)]) == gen, bar);
            __builtin_amdgcn_fence(__ATOMIC_ACQUIRE, "agent");
            asm volatile("s_waitcnt vmcnt(0)" ::: "memory");
        }
    }
    __syncthreads();
}

__global__ void __launch_bounds__(512, 2) mega(Params P) {
    extern __shared__ __attribute__((aligned(16))) unsigned char lds_raw[];
    LAS unsigned char* lds = (LAS unsigned char*)lds_raw;
#define GRID_SYNC() xcd_barrier(xbar)
    if (threadIdx.x < 2) ((volatile LAS unsigned*)(lds + 131072 + 1024))[threadIdx.x] = 0u;
    __syncthreads();
    XcdBarrier xbar = xcd_barrier_post((unsigned*)(P.ws + WS_BAR), (volatile LAS unsigned*)(lds + 131072 + 1024));
    const int tid = threadIdx.x, G = gridDim.x, bid = blockIdx.x;
    unsigned char* ws = P.ws;
    bf16* WUP = (bf16*)(ws + WS_WUP); bf16* WDN = (bf16*)(ws + WS_WDN); bf16* WIN = (bf16*)(ws + WS_WIN);
    bf16* WPA = (bf16*)(ws + WS_WPA); bf16* WPB = (bf16*)(ws + WS_WPB); bf16* WO = (bf16*)(ws + WS_WO);
    float* MOD = (float*)(ws + WS_MOD); float* LBF = MOD + 9 * NMODC; float* LBB = LBF + 1024;
    bf16* U = (bf16*)(ws + WS_U);
    bf16* H = (bf16*)(ws + R_H); float* HC1 = (float*)(ws + R_HC1);
    bf16* Qb = (bf16*)(ws + R_Q); f16* GFb = (f16*)(ws + R_GF); f16* GBb = (f16*)(ws + R_GB); bf16* Vb = (bf16*)(ws + R_V);
    bf16* OFb = (bf16*)(ws + R_OF); bf16* OBb = (bf16*)(ws + R_OB);
    bf16* SGb = (bf16*)(ws + R_SG); bf16* GLUb = (bf16*)(ws + R_GLU); bf16* GATESb = (bf16*)(ws + R_GATES);
    bf16* BOP = U; bf16* Tb = OBb;
    bf16* H2B = OFb;
    bf16* DLT = (bf16*)(ws + WS_R + 192 * MiB);
    bf16* PART = (bf16*)(ws + WS_R + 192 * MiB);
    float* OUT = P.out;
    bf16* H1B = (bf16*)OUT;

    {
        if (bid < 144) {
            LAS float* SC = (LAS float*)lds;
            for (int i = tid; i < 9 * 1024; i += 512) { const float v = (i < 8192) ? P.in[I_C][i] : P.in[I_CCTX][i - 8192]; SC[i] = siluf_(v); }
            __syncthreads();
            for (int item = bid; item < 144; item += G) adaln_item(lds, item, P.in[I_WADA], P.in[I_BADA], MOD);
        }
        if (bid == G - 1) {
            const float* l = P.in[I_LBL];
            for (int d = tid; d < 1024; d += 512) { LBF[d] = 1.0f / (1.0f + __expf(l[2048 + d] - l[d])); LBB[d] = 1.0f / (1.0f + __expf(l[3072 + d] - l[1024 + d])); }
        }
        for (int it = (bid + 112) % G; it < 2592; it += G) {
            if (it < 704) conv_job_item(lds, it, P.in[I_W1U], 1024, 5632, WUP, 0, 0, 2816);
            else if (it < 1056) conv_job_item(lds, it - 704, P.in[I_W1D], 2816, 1024, WDN, 0, -1, 0);
            else if (it < 1952) conv_job_item(lds, it - 1056, P.in[I_WIN], 1024, 7168, WIN, 0, 5120, 1024);
            else if (it < 2208) conv_job_item(lds, it - 1952, P.in[I_WG], 1024, 2048, WIN, 7168, -1, 0);
            else if (it < 2336) conv_job_item(lds, it - 2208, P.in[I_WPA], 1024, 1024, WPA, 0, -1, 0);
            else if (it < 2464) conv_job_item(lds, it - 2336, P.in[I_WPB], 1024, 1024, WPB, 0, -1, 0);
            else conv_job_item(lds, it - 2464, P.in[I_WO], 1024, 1024, WO, 0, -1, 0);
        }
    }
    GRID_SYNC();
    normmod_phase<true, true>(P.in[I_X], P.in[I_CTX], MT, P.in[I_NF1], MOD, 0, 1, U, OUT);
    GRID_SYNC();
    { pg8::Gemm g{U, WUP, MT, 2 * FF, D, D}; pg8::StaticOrder S; S.init(MT, 2 * FF, G, bid); EpiSwiglu E{H, FF}; pg8::gemm_phase<EpiSwiglu, pg8::StaticOrder, GEMM_ALIGN, GEMM_SP2>(lds, g, S, E, nullptr); }
    GRID_SYNC();
    { pg8::Gemm g{H, WDN, ML, D, FF, FF}; pg8::StaticOrder S; S.init(ML, D, G, bid); EpiResB<false> E{P.in[I_X], H1B, MOD, 2, 0.5f}; pg8::gemm_phase<EpiResB<false>, pg8::StaticOrder, GEMM_ALIGN, GEMM_SP2>(lds, g, S, E, nullptr); }
    { pg8::Gemm g{H, WDN, MT, D, 256, FF}; KSplitOrder S{G, bid}; EpiPart E{PART}; pg8::gemm_phase<EpiPart, KSplitOrder, GEMM_ALIGN, GEMM_SP2>(lds, g, S, E, nullptr); }
    GRID_SYNC();
    normmod_phase<true, true, true, false, true>((const float*)H1B, P.in[I_CTX], MT, P.in[I_NMIX], MOD, 3, 4, U, OUT, PART, 2);
    GRID_SYNC();
    { pg8::Gemm g{U, WIN, MT, 4096, D, D}; pg8::StaticOrder S; S.init(MT, 4096, G, bid); EpiMix1 E{Qb, GFb, GBb, Vb, LBF, LBB}; pg8::gemm_phase<EpiMix1, pg8::StaticOrder, GEMM_ALIGN, GEMM_SP2>(lds, g, S, E, nullptr); }
    GRID_SYNC();
    for (int item = bid; item < 256; item += G) scan_item(lds, item, Qb, GFb, GBb, Vb, OFb, OBb);
    GRID_SYNC();
    { pg8::Gemm g{U, WIN + (size_t)4096 * D, ML, 5120, D, D}; pg8::StaticOrder S; S.init(ML, 5120, G, bid); EpiMix2 E{SGb, GLUb, GATESb, P.in[I_BG]}; pg8::gemm_phase<EpiMix2, pg8::StaticOrder, GEMM_ALIGN, GEMM_SP2>(lds, g, S, E, nullptr); }
    GRID_SYNC();
    {
        conv_items(lds, bid, 2048, G, GLUb, P.in[I_WDW], P.in[I_BDW], P.in[I_LNG], P.in[I_LNB], BOP);
        aop_rows(bid * 8 + (tid >> 6), ML, G * 8, OFb, OBb, SGb, P.in[I_HGN]);
        for (int it = bid; it < 1056; it += G) {
            if (it < 704) conv_job_item(lds, it, P.in[I_W2U], 1024, 5632, WUP, 0, 0, 2816);
            else conv_job_item(lds, it - 704, P.in[I_W2D], 2816, 1024, WDN, 0, -1, 0);
        }
    }
    GRID_SYNC();
    { pg8::Gemm g{OFb, WPA, ML, D, D, D}; pg8::StaticOrder S; S.init(ML, D, G, bid); EpiGate<0> E{GATESb, Tb, 0}; pg8::gemm_phase<EpiGate<0>, pg8::StaticOrder, GEMM_ALIGN, GEMM_SP2>(lds, g, S, E, nullptr); }
    GRID_SYNC();
    { pg8::Gemm g{BOP, WPB, ML, D, D, D}; pg8::StaticOrder S; S.init(ML, D, G, bid); EpiGate<1> E{GATESb, Tb, 1024}; pg8::gemm_phase<EpiGate<1>, pg8::StaticOrder, GEMM_ALIGN, GEMM_SP2>(lds, g, S, E, nullptr); }
    GRID_SYNC();
    { pg8::Gemm g{Tb, WO, ML, D, D, D}; pg8::StaticOrder S; S.init(ML, D, G, bid); EpiResB<true> E{(const float*)H1B, H2B, MOD, 5, 1.0f}; pg8::gemm_phase<EpiResB<true>, pg8::StaticOrder, GEMM_ALIGN, GEMM_SP2>(lds, g, S, E, nullptr); }
    GRID_SYNC();
    normmod_phase<true, true, false, false, true>((const float*)H2B, HC1, ML, P.in[I_NF2], MOD, 6, 7, U, OUT);
    GRID_SYNC();
    { pg8::Gemm g{U, WUP, ML, 2 * FF, D, D}; pg8::StaticOrder S; S.init(ML, 2 * FF, G, bid); EpiSwiglu E{H, FF}; pg8::gemm_phase<EpiSwiglu, pg8::StaticOrder, GEMM_ALIGN, GEMM_SP2>(lds, g, S, E, nullptr); }
    GRID_SYNC();
    { pg8::Gemm g{H, WDN, ML, D, FF, FF}; pg8::StaticOrder S; S.init(ML, D, G, bid); EpiDelta E{DLT, MOD, 8, 0.5f}; pg8::gemm_phase<EpiDelta, pg8::StaticOrder, GEMM_ALIGN, GEMM_SP2>(lds, g, S, E, nullptr); }
    GRID_SYNC();
    normmod_phase<false, false, false, true, true>((const float*)H2B, HC1, ML, P.in[I_FN], MOD, 0, 0, U, OUT, nullptr, 0, DLT);
}

extern "C" void kernel_launch(void* const* d_in, const int* in_sizes, int n_in, void* d_out, int out_size, void* d_ws, size_t ws_size, hipStream_t stream) {
    static int grid = 0;
    if (grid == 0) {
        if (n_in != 26 || ws_size < WS_NEED) { fprintf(stderr, "kernel_launch: n_in %d ws %zu (need %zu)\n", n_in, ws_size, (size_t)WS_NEED); grid = -1; return; }
        int dev = 0, cus = 0, per_cu = 0;
        hipGetDevice(&dev); hipDeviceGetAttribute(&cus, hipDeviceAttributeMultiprocessorCount, dev);
        if (hipFuncSetAttribute((const void*)mega, hipFuncAttributeMaxDynamicSharedMemorySize, LDS_BYTES) != hipSuccess) { fprintf(stderr, "hipFuncSetAttribute failed\n"); grid = -1; return; }
        if (hipOccupancyMaxActiveBlocksPerMultiprocessor(&per_cu, (const void*)mega, 512, LDS_BYTES) != hipSuccess || per_cu < 1) { fprintf(stderr, "occupancy query: %d\n", per_cu); grid = -1; return; }
        grid = cus;
    }
    if (grid < 0) return;
    if (hipMemsetAsync((char*)d_ws + WS_BAR, 0, XCD_BAR_WORDS * sizeof(unsigned), stream) != hipSuccess) { fprintf(stderr, "memset failed\n"); return; }
    Params p{};
    for (int i = 0; i < 26; ++i) p.in[i] = (const float*)d_in[i];
    p.out = (float*)d_out; p.ws = (unsigned char*)d_ws;
    void* args[] = {&p};
    hipError_t e = hipLaunchCooperativeKernel((const void*)mega, dim3(grid), dim3(512), args, LDS_BYTES, stream);
    if (e != hipSuccess) fprintf(stderr, "cooperative launch failed: %s (grid %d)\n", hipGetErrorString(e), grid);
}
```

```cpp
#include <hip/hip_runtime.h>
#include <cstdio>
#define GEMM_ALIGN true
#define GEMM_SP2 true
namespace pg8 {
#define PG8_LAS __attribute__((address_space(3)))
typedef unsigned short bf16_t;
typedef short bf16x8 __attribute__((ext_vector_type(8)));
typedef float f32x4 __attribute__((ext_vector_type(4)));
typedef unsigned u32x4 __attribute__((ext_vector_type(4)));
constexpr int BM = 256, BK = 64, HALF = 128, HTB = HALF * BK * 2  , STAGE_BYTES = 8 * HTB, NXCD = 8, WGM = 8;

__host__ __device__ __forceinline__ int lds_byte(int r, int c) { const int st = (r >> 4) * 2 + (c >> 5), rr = r & 15, cc = c & 31, ob = rr * 64 + cc * 2; return st * 1024 + (ob ^ (((ob >> 9) & 1) << 5)); }
__host__ __device__ __forceinline__ void stage_rc(int b, int& R, int& C) { const int st = b / 1024, sb = b % 1024, swz = sb ^ (((sb >> 9) & 1) << 5); R = (st >> 1) * 16 + swz / 64; C = (st & 1) * 32 + (swz % 64) / 2; }
__host__ __device__ __forceinline__ int perm32(int rho) { const int n = rho >> 4, i = rho & 15; return 8 * (i >> 2) + 4 * n + (i & 3); }

struct Unit { int pm, pn, pk; };
struct Gemm { const bf16_t* A; const bf16_t* Bt; int M, N, K, Kp; };

struct StaticOrder {
    int nM, nN, nwg, G, c;
    __host__ __device__ void init(int M, int N, int G_, int c_) { nM = M / BM; nN = N / BM; nwg = nM * nN; G = G_; c = c_; }
    __host__ __device__ bool next(int i, Unit& u) const {
        const long L = (long)i * G + c; if (L >= nwg) return false;
        int wgid = (int)L; { const int q = nwg / NXCD, r = nwg % NXCD, xcd = wgid % NXCD, off = wgid / NXCD; wgid = (xcd < r ? xcd * (q + 1) : r * (q + 1) + (xcd - r) * q) + off; }
        const int nig = WGM * nN, gid = wgid / nig, fm = gid * WGM, gsz = (nM - fm) < WGM ? (nM - fm) : WGM;
        u.pm = fm + ((wgid % nig) % gsz); u.pn = (wgid % nig) / gsz; u.pk = 0; return true;
    }
    __device__ __forceinline__ void a_ready(const Unit&) const {}
    __device__ __forceinline__ void done(const Unit&) const {}
};
__device__ __forceinline__ unsigned cvt_pk_bf16(float lo, float hi) { unsigned r; asm volatile("v_cvt_pk_bf16_f32 %0, %1, %2" : "=v"(r) : "v"(lo), "v"(hi)); return r; }
template <class Epi, class Sched, bool ALIGN_EPI = false, bool SP2 = false, bool STAMP = false>
__device__ __forceinline__ void gemm_phase(PG8_LAS unsigned char* lds, const Gemm g, const Sched& S, const Epi& E, unsigned long long* stamps) {
    int tid_ = threadIdx.x; asm volatile("" : "+v"(tid_));
    const int tid = tid_, wid = __builtin_amdgcn_readfirstlane(tid >> 6), lane = tid & 63, wr = wid >> 2, wc = wid & 3, fr = lane & 15, fq = lane >> 4;
    const int K = g.Kp, nt = g.K / BK;
    int ts_lo = 0, ts_hi = 0, nts = 0; const unsigned long long rt_entry = STAMP ? (unsigned long long)wall_clock64() : 0ull;
#define PG8_STAMP() do { if (STAMP && wid == 0 && nts < 64) { const unsigned long long _c = (unsigned long long)clock64(); \
        ts_lo = (lane == nts) ? (int)(unsigned)_c : ts_lo; ts_hi = (lane == nts) ? (int)(unsigned)(_c >> 32) : ts_hi; ++nts; } } while (0)
    PG8_STAMP();
    unsigned voffA[2], voffB[2];
#pragma unroll
    for (int i = 0; i < 2; ++i) { int R, C; stage_rc(tid * 16 + i * 8192, R, C); const int Rb = Epi::PERM ? ((R & ~31) + perm32(R & 31)) : R;
        voffA[i] = (unsigned)(R * K + C) * 2u; voffB[i] = (unsigned)(Rb * K + C) * 2u; }
    const size_t kstep = (size_t)(BK * 2);
    const size_t hstep = (size_t)HALF * K * 2;
    const size_t tstep = 2 * hstep;
    const unsigned ldsw = (unsigned)wid * 1024u;
    const int aoff = lds_byte(wr * 64 + fr, fq * 8), boff = lds_byte(wc * 32 + fr, fq * 8);
#define PG8_SA(b, h) (((b) * 2 + (h)) * HTB)
#define PG8_SB(b, h) ((4 + (b) * 2 + (h)) * HTB)
#define PG8_STAGE(bufoff, gbase, voff) do { _Pragma("unroll") for (int _i = 0; _i < 2; ++_i) \
        __builtin_amdgcn_global_load_lds((const unsigned*)((const char*)(gbase) + (voff)[_i]), (PG8_LAS unsigned*)(lds + (bufoff) + ldsw + _i * 8192), 16, 0, 0); } while (0)
#define PG8_LDA(dst, b, h) do { _Pragma("unroll") for (int m = 0; m < 4; ++m) _Pragma("unroll") for (int k = 0; k < 2; ++k) dst[m][k] = *(const PG8_LAS bf16x8*)(lds + PG8_SA(b, h) + aoff + m * 2048 + k * 1024); } while (0)
#define PG8_LDB(dst, b, h) do { _Pragma("unroll") for (int n = 0; n < 2; ++n) _Pragma("unroll") for (int k = 0; k < 2; ++k) dst[n][k] = *(const PG8_LAS bf16x8*)(lds + PG8_SB(b, h) + boff + n * 2048 + k * 1024); } while (0)
#define PG8_MMA(ai, bj, At, Bt) do { __builtin_amdgcn_s_setprio(1); _Pragma("unroll") for (int m = 0; m < 4; ++m) _Pragma("unroll") for (int n = 0; n < 2; ++n) _Pragma("unroll") for (int k = 0; k < 2; ++k) \
        acc[ai][bj][m][n] = __builtin_amdgcn_mfma_f32_16x16x32_bf16(Bt[n][k], At[m][k], acc[ai][bj][m][n], 0, 0, 0); __builtin_amdgcn_s_setprio(0); } while (0)
#define PG8_WAIT_V(n) asm volatile("s_waitcnt vmcnt(" #n ")" ::: "memory")
#define PG8_WAIT_L(n) asm volatile("s_waitcnt lgkmcnt(" #n ")" ::: "memory")
#define PG8_BAR __builtin_amdgcn_s_barrier()
#define PG8_SCHED __builtin_amdgcn_sched_barrier(0)
    Unit cur, nxt; int ui = 0;
    if (!S.next(0, cur)) return;
    f32x4 acc[2][2][4][2];
#pragma unroll
    for (int a = 0; a < 2; ++a)
#pragma unroll
        for (int b = 0; b < 2; ++b)
#pragma unroll
            for (int m = 0; m < 4; ++m)
#pragma unroll
                for (int n = 0; n < 2; ++n) acc[a][b][m][n] = (f32x4){0.f, 0.f, 0.f, 0.f};
    bf16x8 At[4][2], B0[2][2], B1[2][2];
    const size_t pstep = (size_t)g.K * 2;
    const char* cA = (const char*)g.A + (size_t)cur.pm * tstep + (size_t)cur.pk * pstep; const char* cB = (const char*)g.Bt + (size_t)cur.pn * tstep + (size_t)cur.pk * pstep;
    S.a_ready(cur);
    if constexpr (SP2) {
        PG8_STAGE(PG8_SB(0, 0), cB, voffB); PG8_STAGE(PG8_SB(0, 1), cB + hstep, voffB); PG8_STAGE(PG8_SA(0, 0), cA, voffA); PG8_STAGE(PG8_SA(0, 1), cA + hstep, voffA);
        if (wr == 1) PG8_BAR;
        PG8_WAIT_V(2); PG8_BAR;
    } else {
        PG8_STAGE(PG8_SB(0, 0), cB, voffB); PG8_STAGE(PG8_SA(0, 0), cA, voffA); PG8_STAGE(PG8_SB(0, 1), cB + hstep, voffB); PG8_STAGE(PG8_SA(0, 1), cA + hstep, voffA);
        if (wr == 1) PG8_BAR;
        PG8_WAIT_V(4); PG8_BAR;
    }
    PG8_STAGE(PG8_SB(1, 0), cB + kstep, voffB); PG8_STAGE(PG8_SA(1, 0), cA + kstep, voffA); PG8_STAGE(PG8_SB(1, 1), cB + hstep + kstep, voffB);
    PG8_WAIT_V(6); PG8_BAR;
    PG8_STAMP();
    for (;;) {
        const bool has_next = S.next(ui + 1, nxt);
        const char* nA = has_next ? (const char*)g.A + (size_t)nxt.pm * tstep + (size_t)nxt.pk * pstep : cA; const char* nB = has_next ? (const char*)g.Bt + (size_t)nxt.pn * tstep + (size_t)nxt.pk * pstep : cB;
        for (int t = 0; t < nt; t += 2) {
            const bool last = (t == nt - 2);
            const char* a1 = cA + (size_t)(t + 1) * kstep;
            const char* a2 = last ? nA : cA + (size_t)(t + 2) * kstep; const char* b2 = last ? nB : cB + (size_t)(t + 2) * kstep;
            const char* a3 = a2 + kstep; const char* b3 = b2 + kstep;
            if (last && has_next) S.a_ready(nxt);
            if constexpr (SP2) {
            PG8_LDB(B0, 0, 0); PG8_LDB(B1, 0, 1); PG8_SCHED; PG8_LDA(At, 0, 0); PG8_STAGE(PG8_SA(1, 1), a1 + hstep, voffA);
            PG8_WAIT_V(8); PG8_WAIT_L(0); PG8_BAR; PG8_MMA(0, 0, At, B0); PG8_MMA(0, 1, At, B1); PG8_BAR; PG8_SCHED;
            PG8_LDA(At, 0, 1); PG8_STAGE(PG8_SB(0, 0), b2, voffB); PG8_STAGE(PG8_SB(0, 1), b2 + hstep, voffB); PG8_STAGE(PG8_SA(0, 0), a2, voffA);
            PG8_WAIT_V(8); PG8_WAIT_L(0); PG8_BAR; PG8_MMA(1, 0, At, B0); PG8_MMA(1, 1, At, B1); PG8_BAR; PG8_SCHED;
            PG8_LDB(B0, 1, 0); PG8_LDB(B1, 1, 1); PG8_SCHED; PG8_LDA(At, 1, 0); PG8_STAGE(PG8_SA(0, 1), a2 + hstep, voffA);
            PG8_WAIT_V(8); PG8_WAIT_L(0); PG8_BAR; PG8_MMA(0, 0, At, B0); PG8_MMA(0, 1, At, B1); PG8_BAR; PG8_SCHED;
            PG8_LDA(At, 1, 1); PG8_STAGE(PG8_SB(1, 0), b3, voffB); PG8_STAGE(PG8_SB(1, 1), b3 + hstep, voffB); PG8_STAGE(PG8_SA(1, 0), a3, voffA);
            PG8_WAIT_V(8); PG8_WAIT_L(0); PG8_BAR; PG8_MMA(1, 0, At, B0); PG8_MMA(1, 1, At, B1); PG8_BAR; PG8_SCHED;
            } else {
            PG8_LDB(B0, 0, 0); PG8_SCHED; PG8_LDA(At, 0, 0); PG8_STAGE(PG8_SA(1, 1), a1 + hstep, voffA);
            PG8_WAIT_L(8); PG8_BAR; PG8_WAIT_L(0); PG8_MMA(0, 0, At, B0); PG8_BAR; PG8_SCHED;
            PG8_LDB(B1, 0, 1); PG8_STAGE(PG8_SB(0, 0), b2, voffB);
            PG8_BAR; PG8_WAIT_L(0); PG8_MMA(0, 1, At, B1); PG8_BAR;
            PG8_LDA(At, 0, 1); PG8_STAGE(PG8_SA(0, 0), a2, voffA);
            PG8_BAR; PG8_WAIT_L(0); PG8_MMA(1, 0, At, B0); PG8_BAR; PG8_SCHED;
            PG8_STAGE(PG8_SB(0, 1), b2 + hstep, voffB);
            PG8_WAIT_V(6); PG8_BAR; PG8_MMA(1, 1, At, B1); PG8_BAR;
            PG8_LDB(B0, 1, 0); PG8_SCHED; PG8_LDA(At, 1, 0); PG8_STAGE(PG8_SA(0, 1), a2 + hstep, voffA);
            PG8_WAIT_L(8); PG8_BAR; PG8_WAIT_L(0); PG8_MMA(0, 0, At, B0); PG8_BAR; PG8_SCHED;
            PG8_LDB(B1, 1, 1); PG8_STAGE(PG8_SB(1, 0), b3, voffB);
            PG8_BAR; PG8_WAIT_L(0); PG8_MMA(0, 1, At, B1); PG8_BAR;
            PG8_LDA(At, 1, 1); PG8_STAGE(PG8_SA(1, 0), a3, voffA);
            PG8_BAR; PG8_WAIT_L(0); PG8_MMA(1, 0, At, B0); PG8_BAR; PG8_SCHED;
            PG8_STAGE(PG8_SB(1, 1), b3 + hstep, voffB);
            PG8_WAIT_V(6); PG8_BAR; PG8_MMA(1, 1, At, B1); PG8_BAR;
            }
        }
        PG8_STAMP();
        if constexpr (ALIGN_EPI) { if (wr == 0) PG8_BAR; }
        if constexpr (!Epi::AFTER_DRAIN) { E(acc, cur, wr, wc, fr, fq); S.done(cur); }
        PG8_STAMP();
        if (!has_next) break;
#pragma unroll
        for (int a = 0; a < 2; ++a)
#pragma unroll
            for (int b = 0; b < 2; ++b)
#pragma unroll
                for (int m = 0; m < 4; ++m)
#pragma unroll
                    for (int n = 0; n < 2; ++n) acc[a][b][m][n] = (f32x4){0.f, 0.f, 0.f, 0.f};
        cur = nxt; cA = nA; cB = nB; ++ui;
        if constexpr (ALIGN_EPI) { if (wr == 1) PG8_BAR; }
    }
    PG8_WAIT_V(0);
    if constexpr (!ALIGN_EPI) { if (wr == 0) PG8_BAR; }
    PG8_BAR;
    if constexpr (Epi::AFTER_DRAIN) { E.fused(acc, cur, wr, wc, fr, fq, lds, wid, lane); S.done(cur); }
    PG8_STAMP();
    if (STAMP && wid == 0) { stamps[lane] = lane < nts ? (((unsigned long long)(unsigned)ts_hi << 32) | (unsigned)ts_lo) : 0ull;
        if (lane == 62) stamps[62] = rt_entry; if (lane == 63) stamps[63] = (unsigned long long)wall_clock64(); }
#undef PG8_STAMP
#undef PG8_SA
#undef PG8_SB
#undef PG8_STAGE
#undef PG8_LDA
#undef PG8_LDB
#undef PG8_MMA
#undef PG8_WAIT_V
#undef PG8_WAIT_L
#undef PG8_BAR
#undef PG8_SCHED
}
}

#define LAS __attribute__((address_space(3)))
typedef unsigned short bf16;
typedef _Float16 f16;
typedef pg8::f32x4 f32x4;
typedef pg8::u32x4 u32x4;
typedef pg8::bf16x8 bf16x8;
typedef unsigned u32x2 __attribute__((ext_vector_type(2)));
typedef _Float16 f16x8 __attribute__((ext_vector_type(8)));
typedef _Float16 f16x4 __attribute__((ext_vector_type(4)));

constexpr int D = 1024, NB = 8, SEQ = 4096, CTXL = 256, ML = NB * SEQ, MC = NB * CTXL, MT = ML + MC, FF = 2816, NMODC = 9 * D;
constexpr float EPS = 1e-6f;
constexpr size_t MiB = 1ull << 20;
constexpr size_t WS_WUP = 0, WS_WDN = 11 * MiB, WS_WIN = 17 * MiB, WS_WPA = 35 * MiB, WS_WPB = 37 * MiB, WS_WO = 39 * MiB, WS_MOD = 41 * MiB,
                 WS_U = 42 * MiB, WS_R = 110 * MiB, WS_BAR = 41 * MiB + 512 * 1024;
constexpr size_t R_H = WS_R, R_HC1 = WS_R + 187 * MiB;
constexpr size_t R_Q = WS_R, R_GF = WS_R + 64 * MiB, R_GB = WS_R + 132 * MiB, R_V = WS_R + 200 * MiB, R_OF = WS_R + 268 * MiB, R_OB = WS_R + 332 * MiB;
constexpr size_t R_SG = WS_R, R_GLU = WS_R + 64 * MiB, R_GATES = WS_R + 128 * MiB;
constexpr size_t WS_NEED = WS_R + 396 * MiB;
constexpr int LDS_BYTES = 131072 + 4096;

struct Params { const float* in[26]; float* out; unsigned char* ws; };
enum { I_X = 0, I_C, I_CTX, I_CCTX, I_WADA, I_BADA, I_NF1, I_W1U, I_W1D, I_NMIX, I_WIN, I_LBL, I_HGN, I_WDW, I_BDW, I_LNG, I_LNB, I_WPA, I_WPB, I_WG, I_BG, I_WO,
       I_NF2, I_W2U, I_W2D, I_FN };

__device__ __forceinline__ int tid_opaque() { int t = threadIdx.x; asm volatile("" : "+v"(t)); return t; }
__device__ __forceinline__ float bf2f(unsigned short b) { return __uint_as_float(((unsigned)b) << 16); }
__device__ __forceinline__ float bflo(unsigned w) { return __uint_as_float(w << 16); }
__device__ __forceinline__ float bfhi(unsigned w) { return __uint_as_float(w & 0xffff0000u); }
typedef __bf16 bf2_t __attribute__((ext_vector_type(2)));
__device__ __forceinline__ unsigned pk2(float lo, float hi) { bf2_t v; v.x = (__bf16)lo; v.y = (__bf16)hi; return __builtin_bit_cast(unsigned, v); }
__device__ __forceinline__ float sigmoidf_(float x) { return __builtin_amdgcn_rcpf(1.0f + __expf(-x)); }
__device__ __forceinline__ float siluf_(float x) { return x * __builtin_amdgcn_rcpf(1.0f + __expf(-x)); }
typedef float f32x2 __attribute__((ext_vector_type(2)));
__device__ __forceinline__ f32x2 sig2_(f32x2 x) { const f32x2 t = x * (-1.44269504f); f32x2 e; e.x = __builtin_amdgcn_exp2f(t.x); e.y = __builtin_amdgcn_exp2f(t.y); const f32x2 d = e + 1.0f; f32x2 r; r.x = __builtin_amdgcn_rcpf(d.x); r.y = __builtin_amdgcn_rcpf(d.y); return r; }
__device__ __forceinline__ f32x4 sig4_(f32x4 x) { const f32x2 lo = sig2_(__builtin_shufflevector(x, x, 0, 1)), hi = sig2_(__builtin_shufflevector(x, x, 2, 3)); return (f32x4){lo.x, lo.y, hi.x, hi.y}; }
__device__ __forceinline__ f32x4 silu4_(f32x4 x) { return x * sig4_(x); }
__device__ __forceinline__ u32x2 pk4(f32x4 v) { u32x2 w; w.x = pk2(v[0], v[1]); w.y = pk2(v[2], v[3]); return w; }

struct EpiSwiglu {
    static constexpr bool PERM = true, AFTER_DRAIN = false;
    bf16* H; int ldh;
    __device__ __forceinline__ void operator()(const f32x4 (&acc)[2][2][4][2], const pg8::Unit& u, int wr, int wc, int fr, int fq) const {
        const int row0 = u.pm * 256 + wr * 64 + fr, col0 = u.pn * 128 + wc * 32 + 8 * fq;
#pragma unroll
        for (int ai = 0; ai < 2; ++ai)
#pragma unroll
            for (int m = 0; m < 4; ++m) {
                bf16* rowp = H + (size_t)(row0 + ai * 128 + m * 16) * ldh + col0;
                const u32x2 w0 = pk4(silu4_(acc[ai][0][m][0]) * acc[ai][1][m][0]), w1 = pk4(silu4_(acc[ai][0][m][1]) * acc[ai][1][m][1]);
                *(u32x4*)rowp = (u32x4){w0.x, w0.y, w1.x, w1.y};
            }
    }
};

struct EpiRes {
    static constexpr bool PERM = false, AFTER_DRAIN = false;
    const float* baseL; float* outL; const float* baseC; float* outC; const float* mod; int gidx; float coef;
    __device__ __forceinline__ void operator()(const f32x4 (&acc)[2][2][4][2], const pg8::Unit& u, int wr, int wc, int fr, int fq) const {
        const bool lat = u.pm < 128;
        const int prow = (lat ? u.pm : u.pm - 128) * 256 + wr * 64 + fr;
        const float* base = lat ? baseL : baseC; float* out = lat ? outL : outC;
        const float* gate = mod + (size_t)(lat ? (u.pm >> 4) : 8) * NMODC + gidx * D;
        const int col0 = u.pn * 256 + wc * 32 + 4 * fq;
        f32x4 gv[2][2];
#pragma unroll
        for (int bj = 0; bj < 2; ++bj)
#pragma unroll
            for (int n = 0; n < 2; ++n) gv[bj][n] = *(const f32x4*)(gate + col0 + bj * 128 + n * 16) * coef;
#pragma unroll
        for (int ai = 0; ai < 2; ++ai)
#pragma unroll
            for (int m = 0; m < 4; ++m) {
                const size_t off = (size_t)(prow + ai * 128 + m * 16) * D + col0;
#pragma unroll
                for (int bj = 0; bj < 2; ++bj)
#pragma unroll
                    for (int n = 0; n < 2; ++n) {
                        const f32x4 bs = *(const f32x4*)(base + off + bj * 128 + n * 16);
                        *(f32x4*)(out + off + bj * 128 + n * 16) = bs + gv[bj][n] * acc[ai][bj][m][n];
                    }
            }
    }
};


template <bool BASEB> struct EpiResB {
    static constexpr bool PERM = true, AFTER_DRAIN = false;
    const float* base; bf16* outb; const float* mod; int gidx; float coef;
    __device__ __forceinline__ void operator()(const f32x4 (&acc)[2][2][4][2], const pg8::Unit& u, int wr, int wc, int fr, int fq) const {
        const int row0 = u.pm * 256 + wr * 64 + fr, col0 = u.pn * 256 + wc * 32 + 8 * fq;
        const float* gate = mod + (size_t)(u.pm >> 4) * NMODC + gidx * D;
#pragma unroll
        for (int bj = 0; bj < 2; ++bj) {
            const f32x4 g0 = *(const f32x4*)(gate + col0 + bj * 128) * coef, g1 = *(const f32x4*)(gate + col0 + bj * 128 + 4) * coef;
#pragma unroll
            for (int ai = 0; ai < 2; ++ai)
#pragma unroll
                for (int m = 0; m < 4; ++m) {
                    const size_t off = (size_t)(row0 + ai * 128 + m * 16) * D + col0 + bj * 128;
                    f32x4 b0, b1;
                    if constexpr (BASEB) { const u32x4 t = *(const u32x4*)((const bf16*)base + off); b0 = (f32x4){bflo(t.x), bfhi(t.x), bflo(t.y), bfhi(t.y)}; b1 = (f32x4){bflo(t.z), bfhi(t.z), bflo(t.w), bfhi(t.w)}; }
                    else { b0 = *(const f32x4*)(base + off); b1 = *(const f32x4*)(base + off + 4); }
                    const u32x2 w0 = pk4(b0 + g0 * acc[ai][bj][m][0]), w1 = pk4(b1 + g1 * acc[ai][bj][m][1]);
                    *(u32x4*)(outb + off) = (u32x4){w0.x, w0.y, w1.x, w1.y};
                }
        }
    }
};

struct EpiDelta {
    static constexpr bool PERM = true, AFTER_DRAIN = false;
    bf16* delta; const float* mod; int gidx; float coef;
    __device__ __forceinline__ void operator()(const f32x4 (&acc)[2][2][4][2], const pg8::Unit& u, int wr, int wc, int fr, int fq) const {
        const int row0 = u.pm * 256 + wr * 64 + fr, col0 = u.pn * 256 + wc * 32 + 8 * fq;
        const float* gate = mod + (size_t)(u.pm >> 4) * NMODC + gidx * D;
#pragma unroll
        for (int bj = 0; bj < 2; ++bj) {
            const f32x4 g0 = *(const f32x4*)(gate + col0 + bj * 128) * coef, g1 = *(const f32x4*)(gate + col0 + bj * 128 + 4) * coef;
#pragma unroll
            for (int ai = 0; ai < 2; ++ai)
#pragma unroll
                for (int m = 0; m < 4; ++m) {
                    const u32x2 w0 = pk4(acc[ai][bj][m][0] * g0), w1 = pk4(acc[ai][bj][m][1] * g1);
                    *(u32x4*)(delta + (size_t)(row0 + ai * 128 + m * 16) * D + col0 + bj * 128) = (u32x4){w0.x, w0.y, w1.x, w1.y};
                }
        }
    }
};

struct EpiMix1 {
    static constexpr bool PERM = true, AFTER_DRAIN = false;
    bf16* Q; f16* GF; f16* GB; bf16* V; const float* lbf; const float* lbb;
    __device__ __forceinline__ void operator()(const f32x4 (&acc)[2][2][4][2], const pg8::Unit& u, int wr, int wc, int fr, int fq) const {
        const int seg = u.pn >> 2;
        const int row0 = u.pm * 256 + wr * 64 + fr, col0 = (u.pn & 3) * 256 + wc * 32 + 8 * fq;
        if (seg == 0) {
            if (u.pm >= 128) return;
#pragma unroll
            for (int ai = 0; ai < 2; ++ai)
#pragma unroll
                for (int m = 0; m < 4; ++m)
#pragma unroll
                    for (int bj = 0; bj < 2; ++bj) {
                        const f32x4 a = acc[ai][bj][m][0], b = acc[ai][bj][m][1];
                        const u32x2 w0 = pk4(silu4_(a)), w1 = pk4(silu4_(b)); const u32x4 w = (u32x4){w0.x, w0.y, w1.x, w1.y};
                        *(u32x4*)(Q + (size_t)(row0 + ai * 128 + m * 16) * D + col0 + bj * 128) = w;
                    }
        } else if (seg == 3) {
#pragma unroll
            for (int ai = 0; ai < 2; ++ai)
#pragma unroll
                for (int m = 0; m < 4; ++m)
#pragma unroll
                    for (int bj = 0; bj < 2; ++bj) {
                        const f32x4 a = acc[ai][bj][m][0], b = acc[ai][bj][m][1];
                        u32x4 w; w.x = pk2(a[0], a[1]); w.y = pk2(a[2], a[3]); w.z = pk2(b[0], b[1]); w.w = pk2(b[2], b[3]);
                        *(u32x4*)(V + (size_t)(row0 + ai * 128 + m * 16) * D + col0 + bj * 128) = w;
                    }
        } else {
            const float* lb = (seg == 1) ? lbf : lbb; f16* G = (seg == 1) ? GF : GB;
#pragma unroll
            for (int bj = 0; bj < 2; ++bj) {
                const f32x4 l0 = *(const f32x4*)(lb + col0 + bj * 128), l1 = *(const f32x4*)(lb + col0 + bj * 128 + 4);
#pragma unroll
                for (int ai = 0; ai < 2; ++ai)
#pragma unroll
                    for (int m = 0; m < 4; ++m) {
                        const f32x4 a = acc[ai][bj][m][0], b = acc[ai][bj][m][1];
                        f16x8 w;
                        const f32x4 fa = l0 + (1.0f - l0) * sig4_(a), fb = l1 + (1.0f - l1) * sig4_(b);
#pragma unroll
                        for (int j = 0; j < 4; ++j) { w[j] = (f16)__builtin_amdgcn_logf(fa[j]); w[4 + j] = (f16)__builtin_amdgcn_logf(fb[j]); }
                        *(f16x8*)(G + (size_t)(row0 + ai * 128 + m * 16) * D + col0 + bj * 128) = w;
                    }
            }
        }
    }
};

struct EpiMix2 {
    static constexpr bool PERM = true, AFTER_DRAIN = false;
    bf16* SG; bf16* GLU; bf16* GATES; const float* bgate;
    __device__ __forceinline__ void operator()(const f32x4 (&acc)[2][2][4][2], const pg8::Unit& u, int wr, int wc, int fr, int fq) const {
        const int row0 = u.pm * 256 + wr * 64 + fr, cw = wc * 32 + 8 * fq;
        if (u.pn < 4) {
#pragma unroll
            for (int ai = 0; ai < 2; ++ai)
#pragma unroll
                for (int m = 0; m < 4; ++m)
#pragma unroll
                    for (int bj = 0; bj < 2; ++bj) {
                        const f32x4 a = acc[ai][bj][m][0], b = acc[ai][bj][m][1];
                        const u32x2 w0 = pk4(silu4_(a)), w1 = pk4(silu4_(b)); const u32x4 w = (u32x4){w0.x, w0.y, w1.x, w1.y};
                        *(u32x4*)(SG + (size_t)(row0 + ai * 128 + m * 16) * D + u.pn * 256 + bj * 128 + cw) = w;
                    }
        } else if (u.pn < 12) {
            const int c0 = (u.pn - 4) * 128 + cw;
#pragma unroll
            for (int ai = 0; ai < 2; ++ai)
#pragma unroll
                for (int m = 0; m < 4; ++m) {
                    const u32x2 w0 = pk4(acc[ai][0][m][0] * sig4_(acc[ai][1][m][0])), w1 = pk4(acc[ai][0][m][1] * sig4_(acc[ai][1][m][1])); const u32x4 w = (u32x4){w0.x, w0.y, w1.x, w1.y};
                    *(u32x4*)(GLU + (size_t)(row0 + ai * 128 + m * 16) * D + c0) = w;
                }
        } else {
            const int c0 = (u.pn - 12) * 256 + cw;
#pragma unroll
            for (int bj = 0; bj < 2; ++bj) {
                const f32x4 b0 = *(const f32x4*)(bgate + c0 + bj * 128), b1 = *(const f32x4*)(bgate + c0 + bj * 128 + 4);
#pragma unroll
                for (int ai = 0; ai < 2; ++ai)
#pragma unroll
                    for (int m = 0; m < 4; ++m) {
                        const f32x4 a = acc[ai][bj][m][0] + b0, b = acc[ai][bj][m][1] + b1;
                        const u32x2 w0 = pk4(sig4_(a)), w1 = pk4(sig4_(b)); const u32x4 w = (u32x4){w0.x, w0.y, w1.x, w1.y};
                        *(u32x4*)(GATES + (size_t)(row0 + ai * 128 + m * 16) * 2048 + c0 + bj * 128) = w;
                    }
            }
        }
    }
};

template <int ADD> struct EpiGate {
    static constexpr bool PERM = true, AFTER_DRAIN = false;
    const bf16* GATES; bf16* T; int goff;
    __device__ __forceinline__ void operator()(const f32x4 (&acc)[2][2][4][2], const pg8::Unit& u, int wr, int wc, int fr, int fq) const {
        const int row0 = u.pm * 256 + wr * 64 + fr, col0 = u.pn * 256 + wc * 32 + 8 * fq;
#pragma unroll
        for (int ai = 0; ai < 2; ++ai)
#pragma unroll
            for (int m = 0; m < 4; ++m)
#pragma unroll
                for (int bj = 0; bj < 2; ++bj) {
                    const size_t r = (size_t)(row0 + ai * 128 + m * 16);
                    const u32x4 g = *(const u32x4*)(GATES + r * 2048 + goff + col0 + bj * 128);
                    bf16* tp = T + r * D + col0 + bj * 128;
                    const f32x4 a = acc[ai][bj][m][0], b = acc[ai][bj][m][1];
                    float o[8];
                    o[0] = bflo(g.x) * a[0]; o[1] = bfhi(g.x) * a[1]; o[2] = bflo(g.y) * a[2]; o[3] = bfhi(g.y) * a[3];
                    o[4] = bflo(g.z) * b[0]; o[5] = bfhi(g.z) * b[1]; o[6] = bflo(g.w) * b[2]; o[7] = bfhi(g.w) * b[3];
                    if (ADD) { const u32x4 t = *(const u32x4*)tp;
                        o[0] += bflo(t.x); o[1] += bfhi(t.x); o[2] += bflo(t.y); o[3] += bfhi(t.y); o[4] += bflo(t.z); o[5] += bfhi(t.z); o[6] += bflo(t.w); o[7] += bfhi(t.w); }
                    u32x4 w; w.x = pk2(o[0], o[1]); w.y = pk2(o[2], o[3]); w.z = pk2(o[4], o[5]); w.w = pk2(o[6], o[7]);
                    *(u32x4*)tp = w;
                }
    }
};


struct KSplitOrder {
    int G, c;
    __device__ bool next(int i, pg8::Unit& u) const { const int L = i * G + c; if (L >= 352) return false; u.pk = L >> 5; u.pm = 128 + ((L & 31) >> 2); u.pn = L & 3; return true; }
    __device__ __forceinline__ void a_ready(const pg8::Unit&) const {}
    __device__ __forceinline__ void done(const pg8::Unit&) const {}
};
struct EpiPart {
    static constexpr bool PERM = false, AFTER_DRAIN = false;
    bf16* part;
    __device__ __forceinline__ void operator()(const f32x4 (&acc)[2][2][4][2], const pg8::Unit& u, int wr, int wc, int fr, int fq) const {
        const int prow = (u.pm - 128) * 256 + wr * 64 + fr, col0 = u.pn * 256 + wc * 32 + 4 * fq;
        bf16* base = part + ((size_t)u.pk * MC + prow) * D + col0;
#pragma unroll
        for (int ai = 0; ai < 2; ++ai)
#pragma unroll
            for (int m = 0; m < 4; ++m)
#pragma unroll
                for (int bj = 0; bj < 2; ++bj)
#pragma unroll
                    for (int n = 0; n < 2; ++n) *(u32x2*)(base + (size_t)(ai * 128 + m * 16) * D + bj * 128 + n * 16) = pk4(acc[ai][bj][m][n]);
    }
};

__device__ __forceinline__ void conv_tile(LAS unsigned char* lds, const float* src, int srcN, int k0, int n0, bf16* dst, int dstK, int drow0) {
    LAS float* T = (LAS float*)lds;
    const int tid = tid_opaque();
#pragma unroll
    for (int i = 0; i < 4; ++i) {
        const int kk = (tid >> 5) + 16 * i, n4 = tid & 31;
        const f32x4 v = *(const f32x4*)(src + (size_t)(k0 + kk) * srcN + n0 + 4 * n4);
#pragma unroll
        for (int j = 0; j < 4; ++j) T[kk * 129 + 4 * n4 + j] = v[j];
    }
    __syncthreads();
    {
        const int nn = tid >> 2, kq = tid & 3;
        float f[16];
#pragma unroll
        for (int j = 0; j < 16; ++j) f[j] = T[(16 * kq + j) * 129 + nn];
        u32x4 w0, w1;
        w0.x = pk2(f[0], f[1]); w0.y = pk2(f[2], f[3]); w0.z = pk2(f[4], f[5]); w0.w = pk2(f[6], f[7]);
        w1.x = pk2(f[8], f[9]); w1.y = pk2(f[10], f[11]); w1.z = pk2(f[12], f[13]); w1.w = pk2(f[14], f[15]);
        bf16* dp = dst + (size_t)(drow0 + nn) * dstK + k0 + 16 * kq;
        *(u32x4*)dp = w0; *(u32x4*)(dp + 8) = w1;
    }
    __syncthreads();
}
__device__ __forceinline__ void conv_job_item(LAS unsigned char* lds, int it, const float* src, int K, int N, bf16* dst, int roff, int pair_from, int NH) {
    const int nt = N / 128; const int kt = it / nt, ntile = it % nt; const int n0 = ntile * 128;
    int drow0;
    if (pair_from < 0 || n0 < pair_from) drow0 = roff + n0;
    else { const int n1 = n0 - pair_from; drow0 = roff + pair_from + ((n1 < NH) ? 256 * (n1 / 128) : 256 * ((n1 - NH) / 128) + 128); }
    conv_tile(lds, src, N, kt * 64, n0, dst, K, drow0);
}

template <bool MODU, bool OUT_BF16, bool CPART = false, bool ADDD = false, bool SRCB = false>
__device__ __forceinline__ void normmod_phase(const float* srcL, const float* srcC, int nrows, const float* gain, const float* mod, int ishift, int iscale, bf16* ub, float* of, const bf16* part = nullptr, int igate = 0, const bf16* dlt = nullptr) {
    const int tido = tid_opaque(); const int lane = tido & 63, wv = tido >> 6;
    f32x4 gn[4];
#pragma unroll
    for (int j = 0; j < 4; ++j) gn[j] = *(const f32x4*)(gain + 256 * j + 4 * lane);
    for (int row = blockIdx.x * 8 + wv; row < nrows; row += gridDim.x * 8) {
        const float* src = (row < ML) ? srcL + (size_t)row * D : srcC + (size_t)(row - ML) * D;
        f32x4 x[4]; float ss = 0.f;
#pragma unroll
        for (int j = 0; j < 4; ++j) {
            if (SRCB && row < ML) { const u32x2 t = *(const u32x2*)((const bf16*)srcL + (size_t)row * D + 256 * j + 4 * lane); x[j] = (f32x4){bflo(t.x), bfhi(t.x), bflo(t.y), bfhi(t.y)}; }
            else x[j] = *(const f32x4*)(src + 256 * j + 4 * lane);
            if constexpr (ADDD) { const u32x2 t = *(const u32x2*)(dlt + (size_t)row * D + 256 * j + 4 * lane); x[j] += (f32x4){bflo(t.x), bfhi(t.x), bflo(t.y), bfhi(t.y)}; }
            if constexpr (CPART) { if (row >= ML) {
                f32x4 sp = (f32x4){0.f, 0.f, 0.f, 0.f};
#pragma unroll
                for (int pk = 0; pk < 11; ++pk) { const u32x2 t = *(const u32x2*)(part + ((size_t)pk * MC + (row - ML)) * D + 256 * j + 4 * lane); sp += (f32x4){bflo(t.x), bfhi(t.x), bflo(t.y), bfhi(t.y)}; }
                x[j] += sp * (*(const f32x4*)(mod + (size_t)8 * NMODC + igate * D + 256 * j + 4 * lane) * 0.5f); } }
            ss += x[j][0] * x[j][0] + x[j][1] * x[j][1] + x[j][2] * x[j][2] + x[j][3] * x[j][3]; }
#pragma unroll
        for (int o = 32; o >= 1; o >>= 1) ss += __shfl_xor(ss, o);
        const float rinv = rsqrtf(ss * (1.0f / D) + EPS);
        const int mrow = (row < ML) ? (row >> 12) : 8;
#pragma unroll
        for (int j = 0; j < 4; ++j) {
            f32x4 y = x[j] * rinv * gn[j];
            if constexpr (MODU) { const f32x4 sh = *(const f32x4*)(mod + (size_t)mrow * NMODC + ishift * D + 256 * j + 4 * lane), sc = *(const f32x4*)(mod + (size_t)mrow * NMODC + iscale * D + 256 * j + 4 * lane);
                y = y * (sc + 1.0f) + sh; }
            if constexpr (OUT_BF16) { u32x2 w; w.x = pk2(y[0], y[1]); w.y = pk2(y[2], y[3]); *(u32x2*)(ub + (size_t)row * D + 256 * j + 4 * lane) = w; }
            else *(f32x4*)(of + (size_t)row * D + 256 * j + 4 * lane) = y;
        }
    }
}

__device__ __forceinline__ void adaln_item(LAS unsigned char* lds, int item, const float* wada, const float* bada, float* MOD) {
    LAS float* SC = (LAS float*)lds;
    LAS float* RED = (LAS float*)(lds + 36864);
    const int tid = threadIdx.x, col = tid & 63, kg = tid >> 6, n0 = item * 64;
    float acc[9];
#pragma unroll
    for (int r = 0; r < 9; ++r) acc[r] = 0.f;
    for (int k0 = kg * 128; k0 < kg * 128 + 128; k0 += 16) {
        float wv[16];
#pragma unroll
        for (int i = 0; i < 16; ++i) wv[i] = wada[(size_t)(k0 + i) * NMODC + n0 + col];
#pragma unroll
        for (int i = 0; i < 16; i += 4) {
#pragma unroll
            for (int r = 0; r < 9; ++r) { const f32x4 sc = *(const LAS f32x4*)(SC + r * 1024 + k0 + i); acc[r] += (sc[0] * wv[i] + sc[1] * wv[i + 1]) + (sc[2] * wv[i + 2] + sc[3] * wv[i + 3]); }
        }
    }
#pragma unroll
    for (int r = 0; r < 9; ++r) RED[(kg * 9 + r) * 64 + col] = acc[r];
    __syncthreads();
    for (int idx = tid; idx < 576; idx += 512) {
        const int r = idx >> 6, c = idx & 63; float s = bada[n0 + c];
#pragma unroll
        for (int g = 0; g < 8; ++g) s += RED[(g * 9 + r) * 64 + c];
        MOD[(size_t)r * NMODC + n0 + c] = s;
    }
    __syncthreads();
}

__device__ __forceinline__ void aop_rows(int row_begin, int row_end, int row_step, bf16* OF, const bf16* OB, const bf16* SG, const float* hgn) {
    const int lane = tid_opaque() & 63;
    float gn[16];
#pragma unroll
    for (int j = 0; j < 4; ++j) { const f32x4 t = *(const f32x4*)(hgn + (lane & 7) * 16 + 4 * j); gn[4 * j] = t[0]; gn[4 * j + 1] = t[1]; gn[4 * j + 2] = t[2]; gn[4 * j + 3] = t[3]; }
    for (int row = row_begin; row < row_end; row += row_step) {
        const size_t off = (size_t)row * D + 16 * lane;
        const u32x4 f0 = *(const u32x4*)(OF + off), f1 = *(const u32x4*)(OF + off + 8);
        const u32x4 b0 = *(const u32x4*)(OB + off), b1 = *(const u32x4*)(OB + off + 8);
        const u32x4 s0 = *(const u32x4*)(SG + off), s1 = *(const u32x4*)(SG + off + 8);
        float o[16], sg[16];
#pragma unroll
        for (int j = 0; j < 4; ++j) {
            o[2 * j] = bflo(f0[j]) + bflo(b0[j]); o[2 * j + 1] = bfhi(f0[j]) + bfhi(b0[j]);
            o[8 + 2 * j] = bflo(f1[j]) + bflo(b1[j]); o[8 + 2 * j + 1] = bfhi(f1[j]) + bfhi(b1[j]);
            sg[2 * j] = bflo(s0[j]); sg[2 * j + 1] = bfhi(s0[j]); sg[8 + 2 * j] = bflo(s1[j]); sg[8 + 2 * j + 1] = bfhi(s1[j]);
        }
        float ss = 0.f;
#pragma unroll
        for (int j = 0; j < 16; ++j) ss += o[j] * o[j];
        ss += __shfl_xor(ss, 1); ss += __shfl_xor(ss, 2); ss += __shfl_xor(ss, 4);
        const float rinv = rsqrtf(ss * (1.0f / 128.0f) + EPS);
        float a[16];
#pragma unroll
        for (int j = 0; j < 16; ++j) a[j] = o[j] * rinv * gn[j] * sg[j];
        u32x4 w0, w1;
        w0.x = pk2(a[0], a[1]); w0.y = pk2(a[2], a[3]); w0.z = pk2(a[4], a[5]); w0.w = pk2(a[6], a[7]);
        w1.x = pk2(a[8], a[9]); w1.y = pk2(a[10], a[11]); w1.z = pk2(a[12], a[13]); w1.w = pk2(a[14], a[15]);
        *(u32x4*)(OF + off) = w0; *(u32x4*)(OF + off + 8) = w1;
    }
}

__device__ __forceinline__ void conv_items(LAS unsigned char* lds, int item_begin, int item_end, int item_step, const bf16* GLU, const float* wdw, const float* bdw, const float* lng, const float* lnb, bf16* BOP) {
    constexpr int TT = 16;
    LAS float* P1 = (LAS float*)lds;
    LAS float* P2 = (LAS float*)(lds + 65536);
    LAS float* ST = (LAS float*)(lds + 131072);
    const int tid = tid_opaque(), c = 2 * tid;
    f32x2 w2[31];
#pragma unroll
    for (int j = 0; j < 31; ++j) w2[j] = *(const f32x2*)(wdw + j * D + c);
    const f32x2 bd = *(const f32x2*)(bdw + c), g2 = *(const f32x2*)(lng + c), b2 = *(const f32x2*)(lnb + c);
    unsigned xw[TT + 30];
#define CONV_ISSUE(item_) do { const int b_ = (item_) / (SEQ / TT), t0_ = ((item_) % (SEQ / TT)) * TT; _Pragma("unroll") for (int r = 0; r < TT + 30; ++r) { \
        const int pos = t0_ - 15 + r; xw[r] = 0u; if (pos >= 0 && pos < SEQ) xw[r] = *(const unsigned*)(GLU + (size_t)(b_ * SEQ + pos) * D + c); } } while (0)
    if (item_begin < item_end) CONV_ISSUE(item_begin);
    for (int item = item_begin; item < item_end; item += item_step) {
        const int b = item / (SEQ / TT), t0 = (item % (SEQ / TT)) * TT;
        f32x2 xf[TT + 30];
#pragma unroll
        for (int r = 0; r < TT + 30; ++r) { xf[r].x = bflo(xw[r]); xf[r].y = bfhi(xw[r]); }
        if (item + item_step < item_end) CONV_ISSUE(item + item_step);
        f32x2 y[TT];
#pragma unroll
        for (int t = 0; t < TT; ++t) {
            f32x2 a2 = bd;
#pragma unroll
            for (int j = 0; j < 31; ++j) a2 = __builtin_elementwise_fma(xf[t + j], w2[j], a2);
            y[t] = a2;
        }
#pragma unroll
        for (int t = 0; t < TT; ++t) { const f32x2 q = y[t] * y[t]; P1[t * 512 + tid] = y[t].x + y[t].y; P2[t * 512 + tid] = q.x + q.y; }
        __syncthreads();
        {
            const int t = tid >> 5, part = tid & 31; float sm = 0.f, q = 0.f;
#pragma unroll
            for (int j = 0; j < 4; ++j) { const f32x4 a = *(const LAS f32x4*)(P1 + t * 512 + part * 16 + 4 * j), bq = *(const LAS f32x4*)(P2 + t * 512 + part * 16 + 4 * j);
                sm += (a[0] + a[1]) + (a[2] + a[3]); q += (bq[0] + bq[1]) + (bq[2] + bq[3]); }
#pragma unroll
            for (int o = 16; o >= 1; o >>= 1) { sm += __shfl_xor(sm, o); q += __shfl_xor(q, o); }
            if (part == 0) { const float mean = sm * (1.0f / D); const float var = fmaxf(q * (1.0f / D) - mean * mean, 0.f); ST[2 * t] = mean; ST[2 * t + 1] = rsqrtf(var + EPS); }
        }
        __syncthreads();
#pragma unroll
        for (int t = 0; t < TT; ++t) {
            const float mean = ST[2 * t], rstd = ST[2 * t + 1];
            const f32x2 v = (y[t] - mean) * (g2 * rstd) + b2;
            const f32x2 o = v * sig2_(v);
            *(unsigned*)(BOP + (size_t)(b * SEQ + t0 + t) * D + c) = pk2(o.x, o.y);
        }
        __syncthreads();
    }
#undef CONV_ISSUE
}

__device__ __forceinline__ size_t scan_rowbase(int ci, int t, int dir, int b) {
    const bool ctx = ci < 8; const int lc = ctx ? ci : ci - 8, nch = ctx ? 8 : 128;
    const int p0 = dir ? (nch - 1 - lc) * 32 : lc * 32; const int pos = dir ? p0 + 31 - t : p0 + t;
    return ctx ? (size_t)(ML + b * CTXL + pos) : (size_t)(b * SEQ + pos);
}
constexpr int S2_QS = 0, S2_KS = 26112, S2_KET = 43520, S2_VT = 74240, S2_DEC = 89600, S2_AS = 91136, S2_ST = 96256;
constexpr int QROW = 272, SROW = 80;
struct ScanRegs { u32x4 q, g, v; };
struct ScanCtx { const bf16* Q; const f16* G; const bf16* V; bf16* O; int b, h, dvh, dir, w, lane, l15, q4, tau, cg; };

__device__ __forceinline__ void scan_issue(const ScanCtx& c, int ci, ScanRegs& r) {
    const size_t row = scan_rowbase(ci, c.tau, c.dir, c.b);
    const size_t qrow = (ci >= 8) ? row : (size_t)(c.b * SEQ + c.tau);
    const int d0 = 16 * c.w + 8 * c.cg;
    r.g = *(const u32x4*)(c.G + row * D + c.h * 128 + d0);
    r.q = *(const u32x4*)(c.Q + qrow * D + c.h * 128 + d0);
    r.v = *(const u32x4*)(c.V + row * D + c.h * 128 + c.dvh * 64 + 8 * c.w);
}
template <int CTRL, int ROWMASK> __device__ __forceinline__ float dpp_mul_(float x) {
    const int y = __builtin_amdgcn_update_dpp(0x3f800000, __float_as_int(x), CTRL, ROWMASK, 0xF, false);
    return x * __int_as_float(y);
}
__device__ __forceinline__ void scan_E(LAS unsigned char* lds, const ScanCtx& c, int ci, const ScanRegs& r) {
    const bool lat = ci >= 8; const int s3 = ci % 3, s2 = ci & 1; const int tau = c.tau, d0 = 16 * c.w + 8 * c.cg;
    float f[8], P[8];
    { const f16x8 gh = __builtin_bit_cast(f16x8, r.g);
#pragma unroll
      for (int j = 0; j < 8; ++j) { P[j] = __builtin_amdgcn_exp2f((float)gh[j]); f[j] = 1.0f - P[j]; } }
#define DPP8(ctrl) "v_mul_f32_dpp %0, %0, %0 " ctrl "\n\tv_mul_f32_dpp %1, %1, %1 " ctrl "\n\tv_mul_f32_dpp %2, %2, %2 " ctrl "\n\tv_mul_f32_dpp %3, %3, %3 " ctrl "\n\t" \
                   "v_mul_f32_dpp %4, %4, %4 " ctrl "\n\tv_mul_f32_dpp %5, %5, %5 " ctrl "\n\tv_mul_f32_dpp %6, %6, %6 " ctrl "\n\tv_mul_f32_dpp %7, %7, %7 " ctrl "\n\t"
    asm volatile("s_nop 1\n\t"
                 DPP8("row_shr:1 row_mask:0xf bank_mask:0xf") DPP8("row_shr:2 row_mask:0xf bank_mask:0xf") DPP8("row_shr:4 row_mask:0xf bank_mask:0xf")
                 DPP8("row_shr:8 row_mask:0xf bank_mask:0xf") DPP8("row_bcast:15 row_mask:0xa bank_mask:0xf") "s_nop 1"
                 : "+v"(P[0]), "+v"(P[1]), "+v"(P[2]), "+v"(P[3]), "+v"(P[4]), "+v"(P[5]), "+v"(P[6]), "+v"(P[7]));
#undef DPP8
    float kt[8], qg[8];
    const unsigned qw[4] = {r.q.x, r.q.y, r.q.z, r.q.w};
#pragma unroll
    for (int j = 0; j < 8; ++j) {
        const float k = f[j];
        float pc; asm("v_max_f32 %0, %1, %2" : "=v"(pc) : "v"(P[j]), "v"(1e-30f));
        kt[j] = k * __builtin_amdgcn_rcpf(pc);
        const float qv = (j & 1) ? bfhi(qw[j >> 1]) : bflo(qw[j >> 1]);
        qg[j] = qv * P[j];
    }
    u32x4 wk; wk.x = pk2(kt[0], kt[1]); wk.y = pk2(kt[2], kt[3]); wk.z = pk2(kt[4], kt[5]); wk.w = pk2(kt[6], kt[7]);
    *(LAS u32x4*)(lds + S2_KS + s2 * 8704 + tau * QROW + d0 * 2) = wk;
    if (lat) { u32x4 wq; wq.x = pk2(qg[0], qg[1]); wq.y = pk2(qg[2], qg[3]); wq.z = pk2(qg[4], qg[5]); wq.w = pk2(qg[6], qg[7]);
        *(LAS u32x4*)(lds + S2_QS + s3 * 8704 + tau * QROW + d0 * 2) = wq; }
    { const unsigned kw[4] = {wk.x, wk.y, wk.z, wk.w};
#pragma unroll
      for (int j = 0; j < 4; ++j) {
        *(LAS unsigned short*)(lds + S2_KET + s3 * 10240 + (d0 + 2 * j) * SROW + tau * 2) = (unsigned short)(kw[j] & 0xffffu);
        *(LAS unsigned short*)(lds + S2_KET + s3 * 10240 + (d0 + 2 * j + 1) * SROW + tau * 2) = (unsigned short)(kw[j] >> 16); } }
    if (tau == 31) { LAS float* DC = (LAS float*)(lds + S2_DEC + s3 * 512);
        *(LAS f32x4*)(DC + d0) = (f32x4){P[0], P[1], P[2], P[3]};
        *(LAS f32x4*)(DC + d0 + 4) = (f32x4){P[4], P[5], P[6], P[7]}; }
    if (c.lane < 32) { const unsigned vw[4] = {r.v.x, r.v.y, r.v.z, r.v.w};
#pragma unroll
        for (int j = 0; j < 4; ++j) {
            *(LAS unsigned short*)(lds + S2_VT + s3 * 5120 + (8 * c.w + 2 * j) * SROW + tau * 2) = (unsigned short)(vw[j] & 0xffffu);
            *(LAS unsigned short*)(lds + S2_VT + s3 * 5120 + (8 * c.w + 2 * j + 1) * SROW + tau * 2) = (unsigned short)(vw[j] >> 16); } }
}
__device__ __forceinline__ void scan_A(LAS unsigned char* lds, const ScanCtx& c, int ci) {
    if (c.w >= 3) return;
    const int s3 = ci % 3, s2 = ci & 1; const int l15 = c.l15, q4 = c.q4;
    const LAS unsigned char* QS = lds + S2_QS + s3 * 8704; const LAS unsigned char* KS = lds + S2_KS + s2 * 8704;
    const int ti = (c.w == 0) ? 0 : 1, sj = (c.w == 2) ? 1 : 0;
    f32x4 a4 = (f32x4){0.f, 0.f, 0.f, 0.f};
#pragma unroll
    for (int kk = 0; kk < 4; ++kk) {
        const bf16x8 xa = *(const LAS bf16x8*)(KS + (sj * 16 + l15) * QROW + kk * 64 + q4 * 16);
        const bf16x8 yb = *(const LAS bf16x8*)(QS + (ti * 16 + l15) * QROW + kk * 64 + q4 * 16);
        a4 = __builtin_amdgcn_mfma_f32_16x16x32_bf16(xa, yb, a4, 0, 0, 0);
    }
    const int t = ti * 16 + l15, s0 = sj * 16 + 4 * q4;
    const float m0 = (s0 <= t) ? a4[0] : 0.f, m1 = (s0 + 1 <= t) ? a4[1] : 0.f, m2 = (s0 + 2 <= t) ? a4[2] : 0.f, m3 = (s0 + 3 <= t) ? a4[3] : 0.f;
    u32x2 wa; wa.x = pk2(m0, m1); wa.y = pk2(m2, m3);
    *(LAS u32x2*)(lds + S2_AS + s2 * 2560 + t * SROW + s0 * 2) = wa;
}
__device__ __forceinline__ void scan_M(LAS unsigned char* lds, const ScanCtx& c, int ci, f32x4 (&accS)[4]) {
    const bool lat = ci >= 8; const int s3 = ci % 3, s2 = ci & 1; const int l15 = c.l15, q4 = c.q4, w = c.w;
    const LAS unsigned char* QS = lds + S2_QS + s3 * 8704; const LAS unsigned char* KET = lds + S2_KET + s3 * 10240; const LAS unsigned char* VT = lds + S2_VT + s3 * 5120;
    const LAS unsigned char* STr = lds + S2_ST + s2 * 17408; LAS unsigned char* STw = lds + S2_ST + (s2 ^ 1) * 17408;
    const int tt = w >> 2, et = w & 3;
    if (lat) {
        f32x4 acco = (f32x4){0.f, 0.f, 0.f, 0.f};
#pragma unroll
        for (int kk = 0; kk < 4; ++kk) {
            const bf16x8 xa = *(const LAS bf16x8*)(STr + (et * 16 + l15) * QROW + kk * 64 + q4 * 16);
            const bf16x8 yb = *(const LAS bf16x8*)(QS + (tt * 16 + l15) * QROW + kk * 64 + q4 * 16);
            acco = __builtin_amdgcn_mfma_f32_16x16x32_bf16(xa, yb, acco, 0, 0, 0);
        }
        {
            const bf16x8 xa = *(const LAS bf16x8*)(VT + (et * 16 + l15) * SROW + q4 * 16);
            const bf16x8 yb = *(const LAS bf16x8*)(lds + S2_AS + s2 * 2560 + (tt * 16 + l15) * SROW + q4 * 16);
            acco = __builtin_amdgcn_mfma_f32_16x16x32_bf16(xa, yb, acco, 0, 0, 0);
        }
        const size_t r = scan_rowbase(ci, tt * 16 + l15, c.dir, c.b);
        u32x2 wo; wo.x = pk2(acco[0], acco[1]); wo.y = pk2(acco[2], acco[3]);
        { bf16* op = c.O + r * D + c.h * 128 + c.dvh * 64 + et * 16 + 4 * q4;
          asm volatile("global_store_dwordx2 %0, %1, off" :: "v"(op), "v"(wo) : "memory"); }
    }
    {
        const f32x4 dc = *(const LAS f32x4*)(lds + S2_DEC + s3 * 512 + (16 * w + 4 * q4) * 4);
        const bf16x8 xa = *(const LAS bf16x8*)(KET + (16 * w + l15) * SROW + q4 * 16);
#pragma unroll
        for (int i = 0; i < 4; ++i) {
            const bf16x8 yb = *(const LAS bf16x8*)(VT + (16 * i + l15) * SROW + q4 * 16);
            accS[i] = __builtin_amdgcn_mfma_f32_16x16x32_bf16(xa, yb, accS[i], 0, 0, 0) * dc;
        }
#pragma unroll
        for (int i = 0; i < 4; ++i) {
            u32x2 ws_; ws_.x = pk2(accS[i][0], accS[i][1]); ws_.y = pk2(accS[i][2], accS[i][3]);
            *(LAS u32x2*)(STw + (16 * i + l15) * QROW + (16 * w + 4 * q4) * 2) = ws_;
        }
    }
}
__device__ __forceinline__ void scan_item(LAS unsigned char* lds, int item, const bf16* Q, const f16* GF, const f16* GB, const bf16* V, bf16* OF, bf16* OB) {
    const int tid = tid_opaque(), lane = tid & 63;
    ScanCtx c;
    c.dvh = item & 1; c.dir = (item >> 1) & 1; c.h = (item >> 2) & 7; c.b = item >> 5;
    c.Q = Q; c.G = c.dir ? GB : GF; c.V = V; c.O = c.dir ? OB : OF;
    c.w = __builtin_amdgcn_readfirstlane(tid >> 6); c.lane = lane; c.l15 = lane & 15; c.q4 = lane >> 4; c.tau = lane & 31; c.cg = lane >> 5;
    for (int i = tid; i < (5120 + 34816) / 4; i += 512) ((LAS unsigned*)(lds + S2_AS))[i] = 0u;
    f32x4 accS[4];
#pragma unroll
    for (int i = 0; i < 4; ++i) accS[i] = (f32x4){0.f, 0.f, 0.f, 0.f};
    ScanRegs r0, r1, r2, r3;
    r0.q = r1.q = r2.q = r3.q = (u32x4){0u, 0u, 0u, 0u}; r0.v = r1.v = r2.v = r3.v = (u32x4){0u, 0u, 0u, 0u};
    scan_issue(c, 0, r0); scan_issue(c, 1, r1); scan_issue(c, 2, r2); scan_issue(c, 3, r3);
    __syncthreads();
#define SCAN_STEP(T_, R_) do { const int T = (T_); \
        __builtin_amdgcn_s_setprio(2); if (T >= 2) scan_M(lds, c, T - 2, accS); __builtin_amdgcn_s_setprio(0); \
        if (T >= 9) scan_A(lds, c, T - 1); \
        scan_E(lds, c, T, R_); { const int nx = (T + 4 < 136) ? T + 4 : 135; scan_issue(c, nx, R_); } \
        __syncthreads(); } while (0)
    for (int T0 = 0; T0 < 136; T0 += 4) { SCAN_STEP(T0, r0); SCAN_STEP(T0 + 1, r1); SCAN_STEP(T0 + 2, r2); SCAN_STEP(T0 + 3, r3); }
    scan_M(lds, c, 134, accS); scan_A(lds, c, 135); __syncthreads();
    scan_M(lds, c, 135, accS); __syncthreads();
    asm volatile("s_waitcnt vmcnt(0)" ::: "memory");
#undef SCAN_STEP
}

#define XB_TMO      128
#define XB_XCNT(j)  (256  + 64 * (j))
#define XB_XSUB(j)  (1280 + 64 * (j))
#define XB_XGEN(j)  (2304 + 64 * (j))
#define XB_TOP      3328
#define XB_TOPGEN   3392
#define XCD_BAR_WORDS 3456
#define XB_SPIN_CAP (1u << 18)

__device__ __forceinline__ unsigned xb_ld(unsigned* p)              { return __hip_atomic_load(p, __ATOMIC_RELAXED, __HIP_MEMORY_SCOPE_AGENT); }
__device__ __forceinline__ unsigned xb_add(unsigned* p, unsigned v) { return __hip_atomic_fetch_add(p, v, __ATOMIC_RELAXED, __HIP_MEMORY_SCOPE_AGENT); }
__device__ __forceinline__ unsigned xb_xcc_id() { return (unsigned)__builtin_amdgcn_s_getreg((3 << 11) | 20) & 0xFu; }
#define XB_SPIN(cond, bar) do { unsigned _sp = 0; while (cond) { __builtin_amdgcn_s_sleep(1); \
    if ((++_sp & 255u) == 0u) { if (xb_ld(&(bar)[XB_TMO])) break; if (_sp > XB_SPIN_CAP) { atomicAdd(&(bar)[XB_TMO], 1u); break; } } } } while (0)

struct XcdBarrier {
    unsigned* bar; unsigned x;
    volatile LAS unsigned* st;
};

__device__ __forceinline__ XcdBarrier xcd_barrier_post(unsigned* bar, volatile LAS unsigned* st) {
    XcdBarrier b; b.bar = bar; b.x = xb_xcc_id(); b.st = st;
    if (threadIdx.x == 0) (void)xb_add(&bar[XB_XCNT(b.x)], 1u);
    return b;
}
__device__ __forceinline__ void xcd_barrier_complete(unsigned* bar, unsigned x, unsigned& nloc, unsigned& nx) {
    const unsigned G = gridDim.x * gridDim.y * gridDim.z;
    unsigned sum, cnt, mine, sp = 0u;
    for (;;) {
        sum = 0u; cnt = 0u; mine = 0u;
#pragma unroll
        for (unsigned j = 0; j < 16; ++j) { const unsigned c = xb_ld(&bar[XB_XCNT(j)]); sum += c; cnt += (c > 0u) ? 1u : 0u; mine = (j == x) ? c : mine; }
        if (sum == G) break;
        __builtin_amdgcn_s_sleep(1);
        if ((++sp & 255u) == 0u) { if (xb_ld(&bar[XB_TMO])) break; if (sp > XB_SPIN_CAP) { atomicAdd(&bar[XB_TMO], 1u); break; } }
    }
    nloc = mine > 0u ? mine : 1u; nx = cnt > 0u ? cnt : 1u;
}

__device__ __forceinline__ void xcd_barrier(const XcdBarrier& b) {
    asm volatile("s_waitcnt vmcnt(0)" ::: "memory");
    __syncthreads();
    if (threadIdx.x == 0) {
        unsigned* bar = b.bar;
        __builtin_amdgcn_s_waitcnt(0);
        unsigned nloc = b.st[0], nx = b.st[1];
        if (nloc == 0u) { xcd_barrier_complete(bar, b.x, nloc, nx); b.st[0] = nloc; b.st[1] = nx; }
        const unsigned old = xb_add(&bar[XB_XSUB(b.x)], 1u);
        const unsigned gen = old / nloc;
        if (old + 1u == (gen + 1u) * nloc) {
            __builtin_amdgcn_fence(__ATOMIC_RELEASE, "agent");
            asm volatile("s_waitcnt vmcnt(0)" ::: "memory");
            const unsigned og = xb_add(&bar[XB_TOP], 1u);
            const unsigned tg = og / nx;
            if (og + 1u == (tg + 1u) * nx) xb_add(&bar[XB_TOPGEN], 1u);
            else XB_SPIN(xb_ld(&bar[XB_TOPGEN]) == tg, bar);
            __builtin_amdgcn_fence(__ATOMIC_ACQUIRE, "agent");
            xb_add(&bar[XB_XGEN(b.x)], 1u);
            asm volatile("s_waitcnt vmcnt(0)" ::: "memory");
        } else {
            XB_SPIN(xb_ld(&bar[XB_XGEN(b.x)]) == gen, bar);
            __builtin_amdgcn_fence(__ATOMIC_ACQUIRE, "agent");
            asm volatile("s_waitcnt vmcnt(0)" ::: "memory");
        }
    }
    __syncthreads();
}

__global__ void __launch_bounds__(512, 2) mega(Params P) {
    extern __shared__ __attribute__((aligned(16))) unsigned char lds_raw[];
    LAS unsigned char* lds = (LAS unsigned char*)lds_raw;
#define GRID_SYNC() xcd_barrier(xbar)
    if (threadIdx.x < 2) ((volatile LAS unsigned*)(lds + 131072 + 1024))[threadIdx.x] = 0u;
    __syncthreads();
    XcdBarrier xbar = xcd_barrier_post((unsigned*)(P.ws + WS_BAR), (volatile LAS unsigned*)(lds + 131072 + 1024));
    const int tid = threadIdx.x, G = gridDim.x, bid = blockIdx.x;
    unsigned char* ws = P.ws;
    bf16* WUP = (bf16*)(ws + WS_WUP); bf16* WDN = (bf16*)(ws + WS_WDN); bf16* WIN = (bf16*)(ws + WS_WIN);
    bf16* WPA = (bf16*)(ws + WS_WPA); bf16* WPB = (bf16*)(ws + WS_WPB); bf16* WO = (bf16*)(ws + WS_WO);
    float* MOD = (float*)(ws + WS_MOD); float* LBF = MOD + 9 * NMODC; float* LBB = LBF + 1024;
    bf16* U = (bf16*)(ws + WS_U);
    bf16* H = (bf16*)(ws + R_H); float* HC1 = (float*)(ws + R_HC1);
    bf16* Qb = (bf16*)(ws + R_Q); f16* GFb = (f16*)(ws + R_GF); f16* GBb = (f16*)(ws + R_GB); bf16* Vb = (bf16*)(ws + R_V);
    bf16* OFb = (bf16*)(ws + R_OF); bf16* OBb = (bf16*)(ws + R_OB);
    bf16* SGb = (bf16*)(ws + R_SG); bf16* GLUb = (bf16*)(ws + R_GLU); bf16* GATESb = (bf16*)(ws + R_GATES);
    bf16* BOP = U; bf16* Tb = OBb;
    bf16* H2B = OFb;
    bf16* DLT = (bf16*)(ws + WS_R + 192 * MiB);
    bf16* PART = (bf16*)(ws + WS_R + 192 * MiB);
    float* OUT = P.out;
    bf16* H1B = (bf16*)OUT;

    {
        if (bid < 144) {
            LAS float* SC = (LAS float*)lds;
            for (int i = tid; i < 9 * 1024; i += 512) { const float v = (i < 8192) ? P.in[I_C][i] : P.in[I_CCTX][i - 8192]; SC[i] = siluf_(v); }
            __syncthreads();
            for (int item = bid; item < 144; item += G) adaln_item(lds, item, P.in[I_WADA], P.in[I_BADA], MOD);
        }
        if (bid == G - 1) {
            const float* l = P.in[I_LBL];
            for (int d = tid; d < 1024; d += 512) { LBF[d] = 1.0f / (1.0f + __expf(l[2048 + d] - l[d])); LBB[d] = 1.0f / (1.0f + __expf(l[3072 + d] - l[1024 + d])); }
        }
        for (int it = (bid + 112) % G; it < 2592; it += G) {
            if (it < 704) conv_job_item(lds, it, P.in[I_W1U], 1024, 5632, WUP, 0, 0, 2816);
            else if (it < 1056) conv_job_item(lds, it - 704, P.in[I_W1D], 2816, 1024, WDN, 0, -1, 0);
            else if (it < 1952) conv_job_item(lds, it - 1056, P.in[I_WIN], 1024, 7168, WIN, 0, 5120, 1024);
            else if (it < 2208) conv_job_item(lds, it - 1952, P.in[I_WG], 1024, 2048, WIN, 7168, -1, 0);
            else if (it < 2336) conv_job_item(lds, it - 2208, P.in[I_WPA], 1024, 1024, WPA, 0, -1, 0);
            else if (it < 2464) conv_job_item(lds, it - 2336, P.in[I_WPB], 1024, 1024, WPB, 0, -1, 0);
            else conv_job_item(lds, it - 2464, P.in[I_WO], 1024, 1024, WO, 0, -1, 0);
        }
    }
    GRID_SYNC();
    normmod_phase<true, true>(P.in[I_X], P.in[I_CTX], MT, P.in[I_NF1], MOD, 0, 1, U, OUT);
    GRID_SYNC();
    { pg8::Gemm g{U, WUP, MT, 2 * FF, D, D}; pg8::StaticOrder S; S.init(MT, 2 * FF, G, bid); EpiSwiglu E{H, FF}; pg8::gemm_phase<EpiSwiglu, pg8::StaticOrder, GEMM_ALIGN, GEMM_SP2>(lds, g, S, E, nullptr); }
    GRID_SYNC();
    { pg8::Gemm g{H, WDN, ML, D, FF, FF}; pg8::StaticOrder S; S.init(ML, D, G, bid); EpiResB<false> E{P.in[I_X], H1B, MOD, 2, 0.5f}; pg8::gemm_phase<EpiResB<false>, pg8::StaticOrder, GEMM_ALIGN, GEMM_SP2>(lds, g, S, E, nullptr); }
    { pg8::Gemm g{H, WDN, MT, D, 256, FF}; KSplitOrder S{G, bid}; EpiPart E{PART}; pg8::gemm_phase<EpiPart, KSplitOrder, GEMM_ALIGN, GEMM_SP2>(lds, g, S, E, nullptr); }
    GRID_SYNC();
    normmod_phase<true, true, true, false, true>((const float*)H1B, P.in[I_CTX], MT, P.in[I_NMIX], MOD, 3, 4, U, OUT, PART, 2);
    GRID_SYNC();
    { pg8::Gemm g{U, WIN, MT, 4096, D, D}; pg8::StaticOrder S; S.init(MT, 4096, G, bid); EpiMix1 E{Qb, GFb, GBb, Vb, LBF, LBB}; pg8::gemm_phase<EpiMix1, pg8::StaticOrder, GEMM_ALIGN, GEMM_SP2>(lds, g, S, E, nullptr); }
    GRID_SYNC();
    for (int item = bid; item < 256; item += G) scan_item(lds, item, Qb, GFb, GBb, Vb, OFb, OBb);
    GRID_SYNC();
    { pg8::Gemm g{U, WIN + (size_t)4096 * D, ML, 5120, D, D}; pg8::StaticOrder S; S.init(ML, 5120, G, bid); EpiMix2 E{SGb, GLUb, GATESb, P.in[I_BG]}; pg8::gemm_phase<EpiMix2, pg8::StaticOrder, GEMM_ALIGN, GEMM_SP2>(lds, g, S, E, nullptr); }
    GRID_SYNC();
    {
        conv_items(lds, bid, 2048, G, GLUb, P.in[I_WDW], P.in[I_BDW], P.in[I_LNG], P.in[I_LNB], BOP);
        aop_rows(bid * 8 + (tid >> 6), ML, G * 8, OFb, OBb, SGb, P.in[I_HGN]);
        for (int it = bid; it < 1056; it += G) {
            if (it < 704) conv_job_item(lds, it, P.in[I_W2U], 1024, 5632, WUP, 0, 0, 2816);
            else conv_job_item(lds, it - 704, P.in[I_W2D], 2816, 1024, WDN, 0, -1, 0);
        }
    }
    GRID_SYNC();
    { pg8::Gemm g{OFb, WPA, ML, D, D, D}; pg8::StaticOrder S; S.init(ML, D, G, bid); EpiGate<0> E{GATESb, Tb, 0}; pg8::gemm_phase<EpiGate<0>, pg8::StaticOrder, GEMM_ALIGN, GEMM_SP2>(lds, g, S, E, nullptr); }
    GRID_SYNC();
    { pg8::Gemm g{BOP, WPB, ML, D, D, D}; pg8::StaticOrder S; S.init(ML, D, G, bid); EpiGate<1> E{GATESb, Tb, 1024}; pg8::gemm_phase<EpiGate<1>, pg8::StaticOrder, GEMM_ALIGN, GEMM_SP2>(lds, g, S, E, nullptr); }
    GRID_SYNC();
    { pg8::Gemm g{Tb, WO, ML, D, D, D}; pg8::StaticOrder S; S.init(ML, D, G, bid); EpiResB<true> E{(const float*)H1B, H2B, MOD, 5, 1.0f}; pg8::gemm_phase<EpiResB<true>, pg8::StaticOrder, GEMM_ALIGN, GEMM_SP2>(lds, g, S, E, nullptr); }
    GRID_SYNC();
    normmod_phase<true, true, false, false, true>((const float*)H2B, HC1, ML, P.in[I_NF2], MOD, 6, 7, U, OUT);
    GRID_SYNC();
    { pg8::Gemm g{U, WUP, ML, 2 * FF, D, D}; pg8::StaticOrder S; S.init(ML, 2 * FF, G, bid); EpiSwiglu E{H, FF}; pg8::gemm_phase<EpiSwiglu, pg8::StaticOrder, GEMM_ALIGN, GEMM_SP2>(lds, g, S, E, nullptr); }
    GRID_SYNC();
    { pg8::Gemm g{H, WDN, ML, D, FF, FF}; pg8::StaticOrder S; S.init(ML, D, G, bid); EpiDelta E{DLT, MOD, 8, 0.5f}; pg8::gemm_phase<EpiDelta, pg8::StaticOrder, GEMM_ALIGN, GEMM_SP2>(lds, g, S, E, nullptr); }
    GRID_SYNC();
    normmod_phase<false, false, false, true, true>((const float*)H2B, HC1, ML, P.in[I_FN], MOD, 0, 0, U, OUT, nullptr, 0, DLT);
}

extern "C" void kernel_launch(void* const* d_in, const int* in_sizes, int n_in, void* d_out, int out_size, void* d_ws, size_t ws_size, hipStream_t stream) {
    static int grid = 0;
    if (grid == 0) {
        if (n_in != 26 || ws_size < WS_NEED) { fprintf(stderr, "kernel_launch: n_in %d ws %zu (need %zu)\n", n_in, ws_size, (size_t)WS_NEED); grid = -1; return; }
        int dev = 0, cus = 0, per_cu = 0;
        hipGetDevice(&dev); hipDeviceGetAttribute(&cus, hipDeviceAttributeMultiprocessorCount, dev);
        if (hipFuncSetAttribute((const void*)mega, hipFuncAttributeMaxDynamicSharedMemorySize, LDS_BYTES) != hipSuccess) { fprintf(stderr, "hipFuncSetAttribute failed\n"); grid = -1; return; }
        if (hipOccupancyMaxActiveBlocksPerMultiprocessor(&per_cu, (const void*)mega, 512, LDS_BYTES) != hipSuccess || per_cu < 1) { fprintf(stderr, "occupancy query: %d\n", per_cu); grid = -1; return; }
        grid = cus;
    }
    if (grid < 0) return;
    if (hipMemsetAsync((char*)d_ws + WS_BAR, 0, XCD_BAR_WORDS * sizeof(unsigned), stream) != hipSuccess) { fprintf(stderr, "memset failed\n"); return; }
    Params p{};
    for (int i = 0; i < 26; ++i) p.in[i] = (const float*)d_in[i];
    p.out = (float*)d_out; p.ws = (unsigned char*)d_ws;
    void* args[] = {&p};
    hipError_t e = hipLaunchCooperativeKernel((const void*)mega, dim3(grid), dim3(512), args, LDS_BYTES, stream);
    if (e != hipSuccess) fprintf(stderr, "cooperative launch failed: %s (grid %d)\n", hipGetErrorString(e), grid);
}
```
